# Optimizing an MI355X kernel written in HIP

```python
import jax, jax.numpy as jnp
from jax import lax
import numpy as np

D_MODEL = 2048
BATCH = 2
SEQ = 8192
DEPTH = 4

A_HEADS = 8
A_HEAD_DIM = 128
A_WIDTH = A_HEADS * A_HEAD_DIM
MOBA_BLOCK = 256
MOBA_TOPK = 3
MOBA_QBLOCK = 64
R_HEADS = 4
R_QK_DIM = 256
R_V_DIM = 512
R_QK_WIDTH = R_HEADS * R_QK_DIM
R_V_WIDTH = R_HEADS * R_V_DIM
R_CHUNK = 256
_FF_RAW = -(-8 * D_MODEL // 3)
D_FF = -(-_FF_RAW // 256) * 256
EPS = 1e-6
SEQ_ALIGN = 256

kernel_name = "moba_retention_gated_hybrid"


def _split_points():
    sizes = [A_WIDTH] * 3 + [R_QK_WIDTH] * 2 + [R_V_WIDTH] * 2 + [D_MODEL] * 2
    pts, acc = [], 0
    for s in sizes[:-1]:
        acc += s
        pts.append(acc)
    return pts, acc + sizes[-1]


def rms_norm(x, g):
    xf = x.astype(jnp.float32)
    y = xf * lax.rsqrt(jnp.mean(xf * xf, axis=-1, keepdims=True) + EPS)
    return (y * g.astype(jnp.float32)).astype(x.dtype)


def head_group_norm(y):
    yf = y.astype(jnp.float32)
    mu = jnp.mean(yf, axis=-1, keepdims=True)
    var = jnp.mean(jnp.square(yf - mu), axis=-1, keepdims=True)
    return ((yf - mu) * lax.rsqrt(var + EPS)).astype(y.dtype)


def alibi_slopes(n):
    start = 2.0 ** (-8.0 / n)
    return jnp.array([start ** (i + 1) for i in range(n)], dtype=jnp.float32)


def moba_attention(q, k, v):
    B, H, S, d = q.shape
    nb = S // MOBA_BLOCK
    topk = min(MOBA_TOPK, nb)
    kb = k.reshape(B, H, nb, MOBA_BLOCK, d)
    vb = v.reshape(B, H, nb, MOBA_BLOCK, d)
    kmean = jnp.mean(kb.astype(jnp.float32), axis=3).astype(k.dtype)
    slopes = alibi_slopes(H)[None, :, None, None]
    scale = d ** -0.5
    blk_ids = jnp.arange(nb)
    offs = jnp.arange(MOBA_BLOCK)
    gather = jax.vmap(jax.vmap(lambda blocks, idx: blocks[idx]))

    def one_qblock(c):
        start = c * MOBA_QBLOCK
        qc = lax.dynamic_slice_in_dim(q, start, MOBA_QBLOCK, axis=2)
        t = start + jnp.arange(MOBA_QBLOCK)
        cur = start // MOBA_BLOCK
        gate = jnp.einsum('bhqd,bhnd->bhqn', qc, kmean).astype(jnp.float32)
        gate = jnp.where(blk_ids < cur, gate, -jnp.inf)
        _, sel = lax.top_k(gate, topk)
        valid = sel < cur
        kg = gather(kb, sel)
        vg = gather(vb, sel)
        s_past = jnp.einsum('bhqd,bhqjsd->bhqjs', qc, kg).astype(jnp.float32) * scale
        kpos_past = sel[..., None] * MOBA_BLOCK + offs
        s_past = s_past - slopes[..., None] * (t[:, None, None] - kpos_past).astype(jnp.float32)
        s_past = jnp.where(valid[..., None], s_past, -jnp.inf).reshape(B, H, MOBA_QBLOCK, topk * MOBA_BLOCK)
        k_own = lax.dynamic_slice_in_dim(kb, cur, 1, axis=2)[:, :, 0]
        v_own = lax.dynamic_slice_in_dim(vb, cur, 1, axis=2)[:, :, 0]
        kpos_own = cur * MOBA_BLOCK + offs
        rel = (t[:, None] - kpos_own[None, :])
        s_own = jnp.einsum('bhqd,bhsd->bhqs', qc, k_own).astype(jnp.float32) * scale
        s_own = s_own - slopes * rel.astype(jnp.float32)
        s_own = jnp.where(rel >= 0, s_own, -jnp.inf)
        p = jax.nn.softmax(jnp.concatenate([s_past, s_own], axis=-1), axis=-1).astype(v.dtype)
        p_past = p[..., :topk * MOBA_BLOCK].reshape(B, H, MOBA_QBLOCK, topk, MOBA_BLOCK)
        p_own = p[..., topk * MOBA_BLOCK:]
        return (jnp.einsum('bhqjs,bhqjsd->bhqd', p_past, vg)
                + jnp.einsum('bhqs,bhsd->bhqd', p_own, v_own))

    out = lax.map(one_qblock, jnp.arange(S // MOBA_QBLOCK))
    return out.transpose(1, 2, 0, 3, 4).reshape(B, H, S, d)


def retention(q, k, v):
    B, H, S, dk = q.shape
    dv = v.shape[-1]
    C = R_CHUNK
    n = S // C
    dt = v.dtype
    log_g = jnp.log(1.0 - jnp.exp2(-5.0 - jnp.arange(H, dtype=jnp.float32)))
    i = jnp.arange(C, dtype=jnp.float32)
    diff = i[:, None] - i[None, :]
    decay_mask = jnp.where(diff >= 0, jnp.exp(log_g[:, None, None] * jnp.maximum(diff, 0.0)), 0.0).astype(dt)
    qc = q.reshape(B, H, n, C, dk)
    kc = (k * (dk ** -0.5)).reshape(B, H, n, C, dk)
    vc = v.reshape(B, H, n, C, dv)
    inner = jnp.einsum('bhnid,bhnjd->bhnij', qc, kc) * decay_mask[:, None]
    inner_out = jnp.einsum('bhnij,bhnje->bhnie', inner, vc)
    k_dec = jnp.exp(log_g[:, None] * (C - 1.0 - i)).astype(dt)
    chunk_kv = jnp.einsum('bhnjd,bhnje->nbhde', kc * k_dec[:, None, :, None], vc)
    chunk_decay = jnp.exp(log_g * C).astype(dt)[None, :, None, None]

    def step(state, kv):
        return state * chunk_decay + kv, state

    _, states = lax.scan(step, jnp.zeros((B, H, dk, dv), dt), chunk_kv)
    q_dec = jnp.exp(log_g[:, None] * (i + 1.0)).astype(dt)
    cross = jnp.einsum('bhnid,nbhde->bhnie', qc * q_dec[:, None, :, None], states)
    return (inner_out + cross).reshape(B, H, S, dv)


def hybrid_layer(x, w_in, w_o_attn, w_o_ret, w_out, q_gain, k_gain, g_mix, g_ffn, w_ffn_in, w_ffn_out):
    B, S, _ = x.shape
    pts, _ = _split_points()
    h = rms_norm(x, g_mix)
    proj = h @ w_in
    qa, ka, va, qr, kr, vr, gr, gate_a, gate_r = jnp.split(proj, pts, axis=-1)

    def heads(t, nh):
        return t.reshape(B, S, nh, -1).transpose(0, 2, 1, 3)

    oa = moba_attention(rms_norm(heads(qa, A_HEADS), q_gain),
                        rms_norm(heads(ka, A_HEADS), k_gain),
                        heads(va, A_HEADS))
    oa = oa.transpose(0, 2, 1, 3).reshape(B, S, A_WIDTH)
    orr = retention(heads(qr, R_HEADS), heads(kr, R_HEADS), heads(vr, R_HEADS))
    orr = head_group_norm(orr).transpose(0, 2, 1, 3).reshape(B, S, R_V_WIDTH) * jax.nn.silu(gr)
    merged = jax.nn.sigmoid(gate_a) * (oa @ w_o_attn) + jax.nn.sigmoid(gate_r) * (orr @ w_o_ret)
    x = x + merged @ w_out
    h2 = rms_norm(x, g_ffn)
    g, u = jnp.split(h2 @ w_ffn_in, 2, axis=-1)
    return x + (jax.nn.silu(g) * u) @ w_ffn_out


def setup_inputs(seed: int = 0) -> dict:
    key = jax.random.key(seed)
    ks = jax.random.split(key, 12)
    _, in_cols = _split_points()
    f32 = jnp.float32

    def w(k, shape, fan_in):
        return jax.random.normal(k, shape, f32) * (fan_in ** -0.5)

    def gain(k, shape):
        return 1.0 + 0.02 * jax.random.normal(k, shape, f32)

    return {
        "x": jax.random.normal(ks[0], (BATCH, SEQ, D_MODEL), f32),
        "w_in": w(ks[1], (DEPTH, D_MODEL, in_cols), D_MODEL),
        "w_o_attn": w(ks[2], (DEPTH, A_WIDTH, D_MODEL), A_WIDTH),
        "w_o_ret": w(ks[3], (DEPTH, R_V_WIDTH, D_MODEL), R_V_WIDTH),
        "w_out": w(ks[4], (DEPTH, D_MODEL, D_MODEL), D_MODEL),
        "q_norm": gain(ks[5], (DEPTH, A_HEAD_DIM)),
        "k_norm": gain(ks[6], (DEPTH, A_HEAD_DIM)),
        "norm_mix": gain(ks[7], (DEPTH, D_MODEL)),
        "norm_ffn": gain(ks[8], (DEPTH, D_MODEL)),
        "w_ffn_in": w(ks[9], (DEPTH, D_MODEL, 2 * D_FF), D_MODEL),
        "w_ffn_out": w(ks[10], (DEPTH, D_FF, D_MODEL), D_FF),
    }


def reference(x, w_in, w_o_attn, w_o_ret, w_out, q_norm, k_norm, norm_mix, norm_ffn, w_ffn_in, w_ffn_out):
    S = x.shape[1]
    s_pad = -(-S // SEQ_ALIGN) * SEQ_ALIGN
    h = jnp.pad(x, ((0, 0), (0, s_pad - S), (0, 0)))
    for l in range(DEPTH):
        h = hybrid_layer(h, w_in[l], w_o_attn[l], w_o_ret[l], w_out[l], q_norm[l], k_norm[l],
                         norm_mix[l], norm_ffn[l], w_ffn_in[l], w_ffn_out[l])
    return h[:, :S]
```

```cpp
#include <hip/hip_runtime.h>
#include <cstdio>
#include <cstdint>
namespace pg8 {
#define PG8_LAS __attribute__((address_space(3)))
typedef unsigned short bf16_t;
typedef short bf16x8 __attribute__((ext_vector_type(8)));
typedef float f32x4 __attribute__((ext_vector_type(4)));
typedef unsigned u32x4 __attribute__((ext_vector_type(4)));
constexpr int BM = 256, BK = 64, HALF = 128, HTB = HALF * BK * 2  , STAGE_BYTES = 8 * HTB, NXCD = 8, WGM = 8;

__host__ __device__ __forceinline__ int lds_byte(int r, int c) { const int st = (r >> 4) * 2 + (c >> 5), rr = r & 15, cc = c & 31, ob = rr * 64 + cc * 2; return st * 1024 + (ob ^ (((ob >> 9) & 1) << 5)); }
__host__ __device__ __forceinline__ void stage_rc(int b, int& R, int& C) { const int st = b / 1024, sb = b % 1024, swz = sb ^ (((sb >> 9) & 1) << 5); R = (st >> 1) * 16 + swz / 64; C = (st & 1) * 32 + (swz % 64) / 2; }
__host__ __device__ __forceinline__ int perm32(int rho) { const int n = rho >> 4, i = rho & 15; return 8 * (i >> 2) + 4 * n + (i & 3); }

struct Unit { int pm, pn; };
struct Gemm { const bf16_t* A; const bf16_t* Bt; int M, N, K; };

struct StaticOrder {
    int nM, nN, nwg, G, c;
    __host__ __device__ void init(int M, int N, int G_, int c_) { nM = M / BM; nN = N / BM; nwg = nM * nN; G = G_; c = c_; }
    __host__ __device__ bool next(int i, Unit& u) const {
        const long L = (long)i * G + c; if (L >= nwg) return false;
        int wgid = (int)L; { const int q = nwg / NXCD, r = nwg % NXCD, xcd = wgid % NXCD, off = wgid / NXCD; wgid = (xcd < r ? xcd * (q + 1) : r * (q + 1) + (xcd - r) * q) + off; }
        const int nig = WGM * nN, gid = wgid / nig, fm = gid * WGM, gsz = (nM - fm) < WGM ? (nM - fm) : WGM;
        u.pm = fm + ((wgid % nig) % gsz); u.pn = (wgid % nig) / gsz; return true;
    }
    __device__ __forceinline__ void a_ready(const Unit&) const {}
    __device__ __forceinline__ void done(const Unit&) const {}
};

__device__ __forceinline__ unsigned cvt_pk_bf16(float lo, float hi) { unsigned r; asm volatile("v_cvt_pk_bf16_f32 %0, %1, %2" : "=v"(r) : "v"(lo), "v"(hi)); return r; }
__device__ __forceinline__ float bflo(unsigned w) { return __uint_as_float(w << 16); }
__device__ __forceinline__ float bfhi(unsigned w) { return __uint_as_float(w & 0xffff0000u); }
__device__ __forceinline__ float sigmoidf_(float x) { return __builtin_amdgcn_rcpf(1.0f + __expf(-x)); }
__device__ __forceinline__ float siluf_(float x) { return x * sigmoidf_(x); }
typedef unsigned u32x2 __attribute__((ext_vector_type(2)));

struct EpiProj {
    static constexpr bool PERM = true, AFTER_DRAIN = false;
    bf16_t* O; int ldc;
    __device__ __forceinline__ void operator()(const f32x4 (&acc)[2][2][4][2], const Unit& u, int wr, int wc, int fr, int fq) const {
        const int row0 = u.pm * BM + wr * 64 + fr, col0 = u.pn * BM + wc * 32 + 8 * fq;
#pragma unroll
        for (int ai = 0; ai < 2; ++ai)
#pragma unroll
            for (int m = 0; m < 4; ++m) { bf16_t* rowp = O + (size_t)(row0 + ai * HALF + m * 16) * ldc + col0;
#pragma unroll
                for (int bj = 0; bj < 2; ++bj) { const f32x4 v0 = acc[ai][bj][m][0], v1 = acc[ai][bj][m][1];
                    u32x4 w; w.x = cvt_pk_bf16(v0[0], v0[1]); w.y = cvt_pk_bf16(v0[2], v0[3]); w.z = cvt_pk_bf16(v1[0], v1[1]); w.w = cvt_pk_bf16(v1[2], v1[3]);
                    *(u32x4*)(rowp + bj * HALF) = w; } }
    }
};
struct EpiSigMulF32 {
    static constexpr bool PERM = false, AFTER_DRAIN = false;
    const bf16_t* gate; int ldg; float* T; int ldc;
    __device__ __forceinline__ void operator()(const f32x4 (&acc)[2][2][4][2], const Unit& u, int wr, int wc, int fr, int fq) const {
        const int row0 = u.pm * BM + wr * 64 + fr, col0 = u.pn * BM + wc * 32 + 4 * fq;
#pragma unroll
        for (int ai = 0; ai < 2; ++ai)
#pragma unroll
            for (int m = 0; m < 4; ++m) { const size_t r = (size_t)(row0 + ai * HALF + m * 16);
#pragma unroll
                for (int bj = 0; bj < 2; ++bj)
#pragma unroll
                    for (int n = 0; n < 2; ++n) { const int c = col0 + bj * HALF + n * 16;
                        const u32x2 gw = *(const u32x2*)(gate + r * ldg + c);
                        f32x4 s; s[0] = sigmoidf_(bflo(gw.x)); s[1] = sigmoidf_(bfhi(gw.x)); s[2] = sigmoidf_(bflo(gw.y)); s[3] = sigmoidf_(bfhi(gw.y));
                        *(f32x4*)(T + r * ldc + c) = acc[ai][bj][m][n] * s; } }
    }
};
struct EpiMerge {
    static constexpr bool PERM = true, AFTER_DRAIN = false;
    const float* T; int ldt; const bf16_t* gate; int ldg; bf16_t* O; int ldc;
    __device__ __forceinline__ void operator()(const f32x4 (&acc)[2][2][4][2], const Unit& u, int wr, int wc, int fr, int fq) const {
        const int row0 = u.pm * BM + wr * 64 + fr, col0 = u.pn * BM + wc * 32 + 8 * fq;
#pragma unroll
        for (int ai = 0; ai < 2; ++ai)
#pragma unroll
            for (int m = 0; m < 4; ++m) { const size_t r = (size_t)(row0 + ai * HALF + m * 16);
#pragma unroll
                for (int bj = 0; bj < 2; ++bj) { const int c = col0 + bj * HALF;
                    const u32x4 gw = *(const u32x4*)(gate + r * ldg + c);
                    const f32x4 t0 = *(const f32x4*)(T + r * ldt + c), t1 = *(const f32x4*)(T + r * ldt + c + 4);
                    f32x4 s0, s1; s0[0] = sigmoidf_(bflo(gw.x)); s0[1] = sigmoidf_(bfhi(gw.x)); s0[2] = sigmoidf_(bflo(gw.y)); s0[3] = sigmoidf_(bfhi(gw.y));
                    s1[0] = sigmoidf_(bflo(gw.z)); s1[1] = sigmoidf_(bfhi(gw.z)); s1[2] = sigmoidf_(bflo(gw.w)); s1[3] = sigmoidf_(bfhi(gw.w));
                    const f32x4 v0 = t0 + s0 * acc[ai][bj][m][0], v1 = t1 + s1 * acc[ai][bj][m][1];
                    u32x4 w; w.x = cvt_pk_bf16(v0[0], v0[1]); w.y = cvt_pk_bf16(v0[2], v0[3]); w.z = cvt_pk_bf16(v1[0], v1[1]); w.w = cvt_pk_bf16(v1[2], v1[3]);
                    *(u32x4*)(O + r * ldc + c) = w; } }
    }
};
struct EpiResF32 {
    static constexpr bool PERM = false, AFTER_DRAIN = false;
    const float* base; float* out; int ldc;
    __device__ __forceinline__ void operator()(const f32x4 (&acc)[2][2][4][2], const Unit& u, int wr, int wc, int fr, int fq) const {
        const int row0 = u.pm * BM + wr * 64 + fr, col0 = u.pn * BM + wc * 32 + 4 * fq;
#pragma unroll
        for (int ai = 0; ai < 2; ++ai)
#pragma unroll
            for (int m = 0; m < 4; ++m) { const size_t off = (size_t)(row0 + ai * HALF + m * 16) * ldc + col0;
#pragma unroll
                for (int bj = 0; bj < 2; ++bj)
#pragma unroll
                    for (int n = 0; n < 2; ++n) { const f32x4 bs = *(const f32x4*)(base + off + bj * HALF + n * 16); *(f32x4*)(out + off + bj * HALF + n * 16) = bs + acc[ai][bj][m][n]; } }
    }
};
struct EpiSwiGLU {
    static constexpr bool PERM = true, AFTER_DRAIN = false;
    bf16_t* O; int ldc;
    __device__ __forceinline__ void operator()(const f32x4 (&acc)[2][2][4][2], const Unit& u, int wr, int wc, int fr, int fq) const {
        const int row0 = u.pm * BM + wr * 64 + fr, col0 = u.pn * HALF + wc * 32 + 8 * fq;
#pragma unroll
        for (int ai = 0; ai < 2; ++ai)
#pragma unroll
            for (int m = 0; m < 4; ++m) { bf16_t* rowp = O + (size_t)(row0 + ai * HALF + m * 16) * ldc + col0;
                const f32x4 g0 = acc[ai][0][m][0], g1 = acc[ai][0][m][1], u0 = acc[ai][1][m][0], u1 = acc[ai][1][m][1];
                f32x4 v0, v1;
#pragma unroll
                for (int j = 0; j < 4; ++j) { v0[j] = siluf_(g0[j]) * u0[j]; v1[j] = siluf_(g1[j]) * u1[j]; }
                u32x4 w; w.x = cvt_pk_bf16(v0[0], v0[1]); w.y = cvt_pk_bf16(v0[2], v0[3]); w.z = cvt_pk_bf16(v1[0], v1[1]); w.w = cvt_pk_bf16(v1[2], v1[3]);
                *(u32x4*)rowp = w; }
    }
};

template <class Epi, class Sched, bool ALIGN_EPI = false, bool SP2 = false>
__device__ __forceinline__ void gemm_phase(PG8_LAS unsigned char* lds, const Gemm g, const Sched& S, const Epi& E, const int tid) {
    const int wid = __builtin_amdgcn_readfirstlane(tid >> 6), lane = tid & 63, wr = wid >> 2, wc = wid & 3, fr = lane & 15, fq = lane >> 4;
    const int K = g.K, nt = K / BK;
    unsigned voffA[2], voffB[2];
#pragma unroll
    for (int i = 0; i < 2; ++i) { int R, C; stage_rc(tid * 16 + i * 8192, R, C); const int Rb = Epi::PERM ? ((R & ~31) + perm32(R & 31)) : R;
        voffA[i] = (unsigned)(R * K + C) * 2u; voffB[i] = (unsigned)(Rb * K + C) * 2u; }
    const size_t kstep = (size_t)(BK * 2);
    const size_t hstep = (size_t)HALF * K * 2;
    const size_t tstep = 2 * hstep;
    const unsigned ldsw = (unsigned)wid * 1024u;
    const int aoff = lds_byte(wr * 64 + fr, fq * 8), boff = lds_byte(wc * 32 + fr, fq * 8);
#define PG8_SA(b, h) (((b) * 2 + (h)) * HTB)
#define PG8_SB(b, h) ((4 + (b) * 2 + (h)) * HTB)
#define PG8_STAGE(bufoff, gbase, voff) do { _Pragma("unroll") for (int _i = 0; _i < 2; ++_i) \
        __builtin_amdgcn_global_load_lds((const unsigned*)((const char*)(gbase) + (voff)[_i]), (PG8_LAS unsigned*)(lds + (bufoff) + ldsw + _i * 8192), 16, 0, 0); } while (0)
#define PG8_LDA(dst, b, h) do { _Pragma("unroll") for (int m = 0; m < 4; ++m) _Pragma("unroll") for (int k = 0; k < 2; ++k) dst[m][k] = *(const PG8_LAS bf16x8*)(lds + PG8_SA(b, h) + aoff + m * 2048 + k * 1024); } while (0)
#define PG8_LDB(dst, b, h) do { _Pragma("unroll") for (int n = 0; n < 2; ++n) _Pragma("unroll") for (int k = 0; k < 2; ++k) dst[n][k] = *(const PG8_LAS bf16x8*)(lds + PG8_SB(b, h) + boff + n * 2048 + k * 1024); } while (0)
#define PG8_MMA(ai, bj, At, Bt) do { __builtin_amdgcn_s_setprio(1); _Pragma("unroll") for (int m = 0; m < 4; ++m) _Pragma("unroll") for (int n = 0; n < 2; ++n) _Pragma("unroll") for (int k = 0; k < 2; ++k) \
        acc[ai][bj][m][n] = __builtin_amdgcn_mfma_f32_16x16x32_bf16(Bt[n][k], At[m][k], acc[ai][bj][m][n], 0, 0, 0); __builtin_amdgcn_s_setprio(0); } while (0)
#define PG8_WAIT_V(n) asm volatile("s_waitcnt vmcnt(" #n ")" ::: "memory")
#define PG8_WAIT_L(n) asm volatile("s_waitcnt lgkmcnt(" #n ")" ::: "memory")
#define PG8_BAR __builtin_amdgcn_s_barrier()
#define PG8_SCHED __builtin_amdgcn_sched_barrier(0)
    Unit cur, nxt; int ui = 0;
    if (!S.next(0, cur)) return;
    f32x4 acc[2][2][4][2];
#pragma unroll
    for (int a = 0; a < 2; ++a)
#pragma unroll
        for (int b = 0; b < 2; ++b)
#pragma unroll
            for (int m = 0; m < 4; ++m)
#pragma unroll
                for (int n = 0; n < 2; ++n) acc[a][b][m][n] = (f32x4){0.f, 0.f, 0.f, 0.f};
    bf16x8 At[4][2], B0[2][2], B1[2][2];
    const char* cA = (const char*)g.A + (size_t)cur.pm * tstep; const char* cB = (const char*)g.Bt + (size_t)cur.pn * tstep;
    S.a_ready(cur);
    if constexpr (SP2) {
        PG8_STAGE(PG8_SB(0, 0), cB, voffB); PG8_STAGE(PG8_SB(0, 1), cB + hstep, voffB); PG8_STAGE(PG8_SA(0, 0), cA, voffA); PG8_STAGE(PG8_SA(0, 1), cA + hstep, voffA);
        if (wr == 1) PG8_BAR;
        PG8_WAIT_V(2); PG8_BAR;
        PG8_STAGE(PG8_SB(1, 0), cB + kstep, voffB); PG8_STAGE(PG8_SA(1, 0), cA + kstep, voffA); PG8_STAGE(PG8_SB(1, 1), cB + hstep + kstep, voffB);
        PG8_WAIT_V(6); PG8_BAR;
    } else {
        PG8_STAGE(PG8_SB(0, 0), cB, voffB); PG8_STAGE(PG8_SA(0, 0), cA, voffA); PG8_STAGE(PG8_SB(0, 1), cB + hstep, voffB); PG8_STAGE(PG8_SA(0, 1), cA + hstep, voffA);
        if (wr == 1) PG8_BAR;
        PG8_WAIT_V(4); PG8_BAR;
        PG8_STAGE(PG8_SB(1, 0), cB + kstep, voffB); PG8_STAGE(PG8_SA(1, 0), cA + kstep, voffA); PG8_STAGE(PG8_SB(1, 1), cB + hstep + kstep, voffB);
        PG8_WAIT_V(6); PG8_BAR;
    }
    for (;;) {
        const bool has_next = S.next(ui + 1, nxt);
        const char* nA = has_next ? (const char*)g.A + (size_t)nxt.pm * tstep : cA; const char* nB = has_next ? (const char*)g.Bt + (size_t)nxt.pn * tstep : cB;
        for (int t = 0; t < nt; t += 2) {
            const bool last = (t == nt - 2);
            const char* a1 = cA + (size_t)(t + 1) * kstep;
            const char* a2 = last ? nA : cA + (size_t)(t + 2) * kstep; const char* b2 = last ? nB : cB + (size_t)(t + 2) * kstep;
            const char* a3 = a2 + kstep; const char* b3 = b2 + kstep;
            if (last && has_next) S.a_ready(nxt);
            if constexpr (SP2) {
            PG8_LDB(B0, 0, 0); PG8_LDB(B1, 0, 1); PG8_SCHED; PG8_LDA(At, 0, 0); PG8_STAGE(PG8_SA(1, 1), a1 + hstep, voffA);
            PG8_WAIT_V(8); PG8_WAIT_L(0); PG8_BAR; PG8_MMA(0, 0, At, B0); PG8_MMA(0, 1, At, B1); PG8_BAR; PG8_SCHED;
            PG8_LDA(At, 0, 1); PG8_STAGE(PG8_SB(0, 0), b2, voffB); PG8_STAGE(PG8_SB(0, 1), b2 + hstep, voffB); PG8_STAGE(PG8_SA(0, 0), a2, voffA);
            PG8_WAIT_V(8); PG8_WAIT_L(0); PG8_BAR; PG8_MMA(1, 0, At, B0); PG8_MMA(1, 1, At, B1); PG8_BAR; PG8_SCHED;
            PG8_LDB(B0, 1, 0); PG8_LDB(B1, 1, 1); PG8_SCHED; PG8_LDA(At, 1, 0); PG8_STAGE(PG8_SA(0, 1), a2 + hstep, voffA);
            PG8_WAIT_V(8); PG8_WAIT_L(0); PG8_BAR; PG8_MMA(0, 0, At, B0); PG8_MMA(0, 1, At, B1); PG8_BAR; PG8_SCHED;
            PG8_LDA(At, 1, 1); PG8_STAGE(PG8_SB(1, 0), b3, voffB); PG8_STAGE(PG8_SB(1, 1), b3 + hstep, voffB); PG8_STAGE(PG8_SA(1, 0), a3, voffA);
            PG8_WAIT_V(8); PG8_WAIT_L(0); PG8_BAR; PG8_MMA(1, 0, At, B0); PG8_MMA(1, 1, At, B1); PG8_BAR; PG8_SCHED;
            } else {
            PG8_LDB(B0, 0, 0); PG8_SCHED; PG8_LDA(At, 0, 0); PG8_STAGE(PG8_SA(1, 1), a1 + hstep, voffA);
            PG8_WAIT_L(8); PG8_BAR; PG8_WAIT_L(0); PG8_MMA(0, 0, At, B0); PG8_BAR; PG8_SCHED;
            PG8_LDB(B1, 0, 1); PG8_STAGE(PG8_SB(0, 0), b2, voffB);
            PG8_BAR; PG8_WAIT_L(0); PG8_MMA(0, 1, At, B1); PG8_BAR;
            PG8_LDA(At, 0, 1); PG8_STAGE(PG8_SA(0, 0), a2, voffA);
            PG8_BAR; PG8_WAIT_L(0); PG8_MMA(1, 0, At, B0); PG8_BAR; PG8_SCHED;
            PG8_STAGE(PG8_SB(0, 1), b2 + hstep, voffB);
            PG8_WAIT_V(6); PG8_BAR; PG8_MMA(1, 1, At, B1); PG8_BAR;
            PG8_LDB(B0, 1, 0); PG8_SCHED; PG8_LDA(At, 1, 0); PG8_STAGE(PG8_SA(0, 1), a2 + hstep, voffA);
            PG8_WAIT_L(8); PG8_BAR; PG8_WAIT_L(0); PG8_MMA(0, 0, At, B0); PG8_BAR; PG8_SCHED;
            PG8_LDB(B1, 1, 1); PG8_STAGE(PG8_SB(1, 0), b3, voffB);
            PG8_BAR; PG8_WAIT_L(0); PG8_MMA(0, 1, At, B1); PG8_BAR;
            PG8_LDA(At, 1, 1); PG8_STAGE(PG8_SA(1, 0), a3, voffA);
            PG8_BAR; PG8_WAIT_L(0); PG8_MMA(1, 0, At, B0); PG8_BAR; PG8_SCHED;
            PG8_STAGE(PG8_SB(1, 1), b3 + hstep, voffB);
            PG8_WAIT_V(6); PG8_BAR; PG8_MMA(1, 1, At, B1); PG8_BAR;
            }
        }
        if constexpr (ALIGN_EPI) { if (wr == 0) PG8_BAR; }
        if constexpr (!Epi::AFTER_DRAIN) { E(acc, cur, wr, wc, fr, fq); S.done(cur); }
        if (!has_next) break;
#pragma unroll
        for (int a = 0; a < 2; ++a)
#pragma unroll
            for (int b = 0; b < 2; ++b)
#pragma unroll
                for (int m = 0; m < 4; ++m)
#pragma unroll
                    for (int n = 0; n < 2; ++n) acc[a][b][m][n] = (f32x4){0.f, 0.f, 0.f, 0.f};
        cur = nxt; cA = nA; cB = nB; ++ui;
        if constexpr (ALIGN_EPI) { if (wr == 1) PG8_BAR; }
    }
    PG8_WAIT_V(0);
    if constexpr (!ALIGN_EPI) { if (wr == 0) PG8_BAR; }
    PG8_BAR;
    if constexpr (Epi::AFTER_DRAIN) { E.fused(acc, cur, wr, wc, fr, fq, lds, wid, lane); S.done(cur); }
#undef PG8_SA
#undef PG8_SB
#undef PG8_STAGE
#undef PG8_LDA
#undef PG8_LDB
#undef PG8_MMA
#undef PG8_WAIT_V
#undef PG8_WAIT_L
#undef PG8_BAR
#undef PG8_SCHED
}
}

#ifndef MK_ONE_LAUNCH
#define MK_ONE_LAUNCH 1
#endif
#ifndef PG8_SP2
#define PG8_SP2 true
#endif
#ifndef PG8_ALIGN
#define PG8_ALIGN true
#endif
constexpr int NWAVES = 8;
constexpr int BATCH = 2, SEQ = 8192, DM = 2048, DEPTH = 4;
constexpr int M = BATCH * SEQ;
constexpr int AH = 8, AD = 128, AW = 1024, MB = 256, NBLK = SEQ / MB;
constexpr int RH = 4, RDK = 256, RDV = 512;
constexpr int DFF = 5632, NIN = 13312;
constexpr int C_QA = 0, C_KA = 1024, C_VA = 2048, C_QR = 3072, C_KR = 4096, C_VR = 5120, C_GR = 7168, C_GA = 9216, C_GT = 11264;
constexpr float EPS = 1e-6f;
constexpr int NPH = 12;
constexpr int NPHASES = DEPTH * NPH;

constexpr size_t MiB = 1u << 20;
constexpr size_t WS_CTL = 0, CTL_ZERO_BYTES = 1 * MiB;
constexpr size_t WS_KMEAN = 1 * MiB;
constexpr size_t WS_WIN = 2 * MiB, WS_WOA = 54 * MiB, WS_WOR = 58 * MiB, WS_WOUT = 66 * MiB, WS_WFI = 74 * MiB, WS_WFO = 118 * MiB;
constexpr size_t WS_H = 140 * MiB;
constexpr size_t WS_PROJ = 204 * MiB;
constexpr size_t WS_OA = 620 * MiB, WS_ORR = 652 * MiB, WS_MRG = 716 * MiB, WS_T = 780 * MiB, WS_RET = 908 * MiB, WS_END = 1036 * MiB;
constexpr int CW_BAR = 4096;

constexpr int RING_OFF = 0, RING_BYTES = 131072;
constexpr int LDSCTL_OFF = RING_BYTES, MISC_OFF = LDSCTL_OFF + 320;
constexpr int LDS_BYTES = 147456;

#define GAS __attribute__((address_space(1)))
#define LAS __attribute__((address_space(3)))
typedef unsigned short bf16;
typedef unsigned v4u __attribute__((ext_vector_type(4)));
typedef float f32x4 __attribute__((ext_vector_type(4)));
typedef short bf16x8 __attribute__((ext_vector_type(8)));
typedef GAS unsigned gu32;
typedef GAS unsigned long long gu64;
#define RLX_AGENT __ATOMIC_RELAXED, __HIP_MEMORY_SCOPE_AGENT
#define LDS_WAIT() asm volatile("s_waitcnt lgkmcnt(0)" ::: "memory")
#define VM_WAIT() asm volatile("s_waitcnt vmcnt(0)" ::: "memory")
__device__ __forceinline__ unsigned long long rt() { return __builtin_amdgcn_s_memrealtime(); }
__device__ __forceinline__ unsigned f2bf(float f) { unsigned u = __builtin_bit_cast(unsigned, f); return (u + 0x7fffu + ((u >> 16) & 1u)) >> 16; }
__device__ __forceinline__ unsigned pk2(float lo, float hi) { return f2bf(lo) | (f2bf(hi) << 16); }

#define XB_TMO      128
#define XB_XCNT(j)  (256  + 64 * (j))
#define XB_XSUB(j)  (1280 + 64 * (j))
#define XB_XGEN(j)  (2304 + 64 * (j))
#define XB_TOP      3328
#define XB_TOPGEN   3392
#define XCD_BAR_WORDS 3456
#define XB_SPIN_CAP (1u << 22)

__device__ __forceinline__ unsigned xb_ld(unsigned* p)              { return __hip_atomic_load(p, __ATOMIC_RELAXED, __HIP_MEMORY_SCOPE_AGENT); }
__device__ __forceinline__ unsigned xb_add(unsigned* p, unsigned v) { return __hip_atomic_fetch_add(p, v, __ATOMIC_RELAXED, __HIP_MEMORY_SCOPE_AGENT); }
__device__ __forceinline__ unsigned xb_xcc_id() { return (unsigned)__builtin_amdgcn_s_getreg((3 << 11) | 20) & 0xFu; }
#define XB_SPIN(cond, bar) do { unsigned _sp = 0; while (cond) { __builtin_amdgcn_s_sleep(1); \
    if ((++_sp & 255u) == 0u) { if (xb_ld(&(bar)[XB_TMO])) break; if (_sp > XB_SPIN_CAP) { atomicAdd(&(bar)[XB_TMO], 1u); break; } } } } while (0)

struct XcdBarrier {
    unsigned* bar; unsigned x;
    volatile LAS unsigned* st;
};

__device__ __forceinline__ XcdBarrier xcd_barrier_post(unsigned* bar, volatile LAS unsigned* st) {
    XcdBarrier b; b.bar = bar; b.x = xb_xcc_id(); b.st = st;
    if (threadIdx.x == 0) (void)xb_add(&bar[XB_XCNT(b.x)], 1u);
    return b;
}
__device__ __forceinline__ void xcd_barrier_complete(unsigned* bar, unsigned x, unsigned& nloc, unsigned& nx) {
    const unsigned G = gridDim.x * gridDim.y * gridDim.z;
    unsigned sum, cnt, mine, sp = 0u;
    for (;;) {
        sum = 0u; cnt = 0u; mine = 0u;
#pragma unroll
        for (unsigned j = 0; j < 16; ++j) { const unsigned c = xb_ld(&bar[XB_XCNT(j)]); sum += c; cnt += (c > 0u) ? 1u : 0u; mine = (j == x) ? c : mine; }
        if (sum == G) break;
        __builtin_amdgcn_s_sleep(1);
        if ((++sp & 255u) == 0u) { if (xb_ld(&bar[XB_TMO])) break; if (sp > XB_SPIN_CAP) { atomicAdd(&bar[XB_TMO], 1u); break; } }
    }
    nloc = mine > 0u ? mine : 1u; nx = cnt > 0u ? cnt : 1u;
}

__device__ __forceinline__ void xcd_barrier(const XcdBarrier& b) {
    asm volatile("s_waitcnt vmcnt(0)" ::: "memory");
    __syncthreads();
    if (threadIdx.x == 0) {
        unsigned* bar = b.bar;
        __builtin_amdgcn_s_waitcnt(0);
        unsigned nloc = b.st[0], nx = b.st[1];
        if (nloc == 0u) { xcd_barrier_complete(bar, b.x, nloc, nx); b.st[0] = nloc; b.st[1] = nx; }
        const unsigned old = xb_add(&bar[XB_XSUB(b.x)], 1u);
        const unsigned gen = old / nloc;
        if (old + 1u == (gen + 1u) * nloc) {
            __builtin_amdgcn_fence(__ATOMIC_RELEASE, "agent");
            asm volatile("s_waitcnt vmcnt(0)" ::: "memory");
            const unsigned og = xb_add(&bar[XB_TOP], 1u);
            const unsigned tg = og / nx;
            if (og + 1u == (tg + 1u) * nx) xb_add(&bar[XB_TOPGEN], 1u);
            else XB_SPIN(xb_ld(&bar[XB_TOPGEN]) == tg, bar);
            __builtin_amdgcn_fence(__ATOMIC_ACQUIRE, "agent");
            xb_add(&bar[XB_XGEN(b.x)], 1u);
            asm volatile("s_waitcnt vmcnt(0)" ::: "memory");
        } else {
            XB_SPIN(xb_ld(&bar[XB_XGEN(b.x)]) == gen, bar);
            __builtin_amdgcn_fence(__ATOMIC_ACQUIRE, "agent");
            asm volatile("s_waitcnt vmcnt(0)" ::: "memory");
        }
    }
    __syncthreads();
}

struct Frame {
    LAS unsigned char* lds;
    volatile LAS unsigned* MISC;
    gu32* ctl;
    int tid, lane, wave;
    int vcu, G;
};
__device__ __forceinline__ float wave_sum(float v) {
#pragma unroll
    for (int o = 1; o < 64; o <<= 1) v += __shfl_xor(v, o);
    return v;
}
__device__ __forceinline__ float wave_max(float v) {
#pragma unroll
    for (int o = 1; o < 64; o <<= 1) v = fmaxf(v, __shfl_xor(v, o));
    return v;
}
__device__ __forceinline__ float bf2f(bf16 b) { return __uint_as_float(((unsigned)b) << 16); }
__device__ __forceinline__ float blo(unsigned w) { return __uint_as_float(w << 16); }
__device__ __forceinline__ float bhi(unsigned w) { return __uint_as_float(w & 0xffff0000u); }

__device__ __forceinline__ void transpose_item(const float* W, int K, int N, int k0, int n0, bf16* WT, int dst_row0, LAS float* scr, int lane) {
#pragma unroll 8
    for (int i = 0; i < 32; ++i) { const int kk = 2 * i + (lane >> 5); scr[kk * 33 + (lane & 31)] = W[(size_t)(k0 + kk) * N + n0 + (lane & 31)]; }
    LDS_WAIT(); asm volatile("" ::: "memory");
    const int c = lane & 7;
#pragma unroll
    for (int j = 0; j < 4; ++j) { const int n = (lane >> 3) + 8 * j; const LAS float* s = scr + (8 * c) * 33 + n;
        v4u o; o.x = pk2(s[0 * 33], s[1 * 33]); o.y = pk2(s[2 * 33], s[3 * 33]); o.z = pk2(s[4 * 33], s[5 * 33]); o.w = pk2(s[6 * 33], s[7 * 33]);
        *(GAS v4u*)(WT + (size_t)(dst_row0 + n) * K + k0 + 8 * c) = o; }
    LDS_WAIT(); asm volatile("" ::: "memory");
}
template <int MODE> __device__ __forceinline__ void convert_matrix(Frame& F, const float* W, int K, int N, bf16* WT, int& it0) {
    LAS float* scr = (LAS float*)(F.lds + RING_OFF + F.wave * 16384);
    const int gw = F.vcu * NWAVES + F.wave, NGW = F.G * NWAVES;
    const int nblk = N / 32, nitems = (K / 64) * nblk;
    int first = (gw - it0 % NGW + NGW) % NGW;
    for (int it = first; it < nitems; it += NGW) {
        const int kb = it / nblk, nb = it % nblk, k0 = 64 * kb, n0 = 32 * nb;
        int dst = n0;
        if (MODE == 1) { const int half = DFF; const int isu = n0 >= half ? 1 : 0; const int j = n0 - isu * half; dst = (j / 128) * 256 + isu * 128 + (j % 128); }
        transpose_item(W, K, N, k0, n0, WT, dst, scr, F.lane);
    }
    it0 += nitems;
}
__device__ __forceinline__ void rmsnorm_phase(Frame& F, const float* x, const float* g, bf16* out) {
    const int gw = F.vcu * NWAVES + F.wave, NGW = F.G * NWAVES;
    for (int m = gw; m < M; m += NGW) {
        const GAS f32x4* xr = (const GAS f32x4*)(x + (size_t)m * DM) + F.lane;
        f32x4 v[8]; float s = 0.f;
#pragma unroll
        for (int j = 0; j < 8; ++j) { v[j] = xr[64 * j]; s += (v[j].x * v[j].x + v[j].y * v[j].y) + (v[j].z * v[j].z + v[j].w * v[j].w); }
        const float rstd = 1.0f / sqrtf(wave_sum(s) * (1.f / DM) + EPS);
        GAS unsigned long long* o8 = (GAS unsigned long long*)(out + (size_t)m * DM) + F.lane;
#pragma unroll
        for (int j = 0; j < 8; ++j) { const f32x4 gg = ((const GAS f32x4*)g)[F.lane + 64 * j];
            o8[64 * j] = (unsigned long long)pk2(v[j].x * rstd * gg.x, v[j].y * rstd * gg.y) | ((unsigned long long)pk2(v[j].z * rstd * gg.z, v[j].w * rstd * gg.w) << 32); }
    }
}
__device__ __forceinline__ void qknorm_phase(Frame& F, bf16* PROJ, const float* qg, const float* kg, float* kmean) {
    LAS float* red = (LAS float*)(F.lds + RING_OFF);
    const int nunits = 2 * BATCH * AH * NBLK;
    for (int u = F.vcu; u < nunits; u += F.G) {
        const int isk = u & 1, r = u >> 1, n = r % NBLK, bh = r / NBLK, h = bh % AH, b = bh / AH;
        const float* gain = isk ? kg : qg;
        const float g0 = gain[2 * F.lane], g1 = gain[2 * F.lane + 1];
        float a0 = 0.f, a1 = 0.f;
        for (int i = F.wave; i < MB; i += NWAVES) {
            unsigned* p = (unsigned*)(PROJ + (size_t)(b * SEQ + n * MB + i) * NIN + (isk ? C_KA : C_QA) + h * AD) + F.lane;
            const unsigned w = *p; const float x0 = blo(w), x1 = bhi(w);
            const float rstd = 1.0f / sqrtf(wave_sum(x0 * x0 + x1 * x1) * (1.f / AD) + EPS);
            const unsigned o = pk2(x0 * rstd * g0, x1 * rstd * g1);
            *p = o; a0 += blo(o); a1 += bhi(o);
        }
        if (isk) {
            __syncthreads();
            red[F.wave * 128 + 2 * F.lane] = a0; red[F.wave * 128 + 2 * F.lane + 1] = a1;
            __syncthreads();
            if (F.tid < 128) { float s = 0.f;
#pragma unroll
                for (int w = 0; w < 8; ++w) s += red[w * 128 + F.tid];
                kmean[(size_t)(bh * NBLK + n) * AD + F.tid] = s * (1.f / MB); }
        }
    }
}
__device__ __forceinline__ void attn_naive_phase(Frame& F, const bf16* PROJ, const float* kmean, bf16* OA, int wg_lo) {
    LAS float* qf = (LAS float*)(F.lds + RING_OFF + F.wave * 8192);
    LAS float* pb = qf + 128;
    const int lane = F.lane;
    const int nw = (F.G - wg_lo) * NWAVES, w0 = ((int)blockIdx.x - wg_lo) * NWAVES + F.wave;
    const float scale = 0.08838834764831845f;
    for (int u = w0; u < BATCH * AH * SEQ; u += nw) {
        const int t = u % SEQ, bh = u / SEQ, h = bh % AH, b = bh / AH, cur = t >> 8;
        const size_t m = (size_t)b * SEQ + t;
        const float slope = exp2f(-(float)(h + 1));
        { const unsigned qw = *((const unsigned*)(PROJ + m * NIN + C_QA + h * AD) + lane); qf[2 * lane] = blo(qw); qf[2 * lane + 1] = bhi(qw); }
        LDS_WAIT(); asm volatile("" ::: "memory");
        float g = -INFINITY;
        if (lane < cur) { const float* km = kmean + (size_t)(bh * NBLK + lane) * AD; float a = 0.f;
            for (int d = 0; d < AD; d += 4) { const f32x4 kv = *(const f32x4*)(km + d); a += qf[d] * kv.x + qf[d + 1] * kv.y + qf[d + 2] * kv.z + qf[d + 3] * kv.w; }
            g = a; }
        int sel0 = 0, sel1 = 0, sel2 = 0; bool val0 = false, val1 = false, val2 = false;
#pragma unroll
        for (int j = 0; j < 3; ++j) {
            const float mx = wave_max(g); const bool v = mx > -INFINITY;
            const unsigned long long bal = __ballot(g == mx);
            const int ln = v ? (__ffsll((long long)bal) - 1) : 0;
            if (v && lane == ln) g = -INFINITY;
            if (j == 0) { sel0 = ln; val0 = v; } else if (j == 1) { sel1 = ln; val1 = v; } else { sel2 = ln; val2 = v; }
        }
        float sc[4][4]; float mx = -INFINITY;
#pragma unroll
        for (int jb = 0; jb < 4; ++jb) {
            const bool v = jb == 0 ? val0 : jb == 1 ? val1 : jb == 2 ? val2 : true;
            const int blk = jb == 0 ? sel0 : jb == 1 ? sel1 : jb == 2 ? sel2 : cur;
#pragma unroll
            for (int i = 0; i < 4; ++i) {
                float s = -INFINITY;
                if (v) {
                    const int kpos = blk * MB + i * 64 + lane;
                    const bf16* krow = PROJ + ((size_t)b * SEQ + kpos) * NIN + C_KA + h * AD;
                    float a = 0.f;
                    for (int d8 = 0; d8 < 16; ++d8) { const v4u kk = *(const v4u*)(krow + d8 * 8); const LAS float* q8 = qf + d8 * 8;
                        a += q8[0] * blo(kk.x) + q8[1] * bhi(kk.x) + q8[2] * blo(kk.y) + q8[3] * bhi(kk.y) + q8[4] * blo(kk.z) + q8[5] * bhi(kk.z) + q8[6] * blo(kk.w) + q8[7] * bhi(kk.w); }
                    s = a * scale - slope * (float)(t - kpos);
                    if (jb == 3 && kpos > t) s = -INFINITY;
                }
                sc[jb][i] = s; mx = fmaxf(mx, s);
            }
        }
        mx = wave_max(mx);
        float sum = 0.f;
#pragma unroll
        for (int jb = 0; jb < 4; ++jb)
#pragma unroll
            for (int i = 0; i < 4; ++i) { const float p = __expf(sc[jb][i] - mx); sum += p; pb[jb * 256 + i * 64 + lane] = p; }
        sum = wave_sum(sum);
        LDS_WAIT(); asm volatile("" ::: "memory");
        float o0 = 0.f, o1 = 0.f;
#pragma unroll
        for (int jb = 0; jb < 4; ++jb) {
            const bool v = jb == 0 ? val0 : jb == 1 ? val1 : jb == 2 ? val2 : true;
            const int blk = jb == 0 ? sel0 : jb == 1 ? sel1 : jb == 2 ? sel2 : cur;
            if (v) {
                const int nk = jb == 3 ? (t - cur * MB + 1) : MB;
                const bf16* vb = PROJ + ((size_t)b * SEQ + blk * MB) * NIN + C_VA + h * AD;
                for (int kk = 0; kk < nk; ++kk) { const float p = pb[jb * 256 + kk]; const unsigned vw = *((const unsigned*)(vb + (size_t)kk * NIN) + lane); o0 += p * blo(vw); o1 += p * bhi(vw); }
            }
        }
        const float inv = 1.0f / sum;
        *((unsigned*)(OA + m * AW + h * AD) + lane) = pk2(o0 * inv, o1 * inv);
        LDS_WAIT(); asm volatile("" ::: "memory");
    }
}
__device__ __forceinline__ void retention_naive_phase(Frame& F, const bf16* PROJ, float* RET) {
    constexpr int TB = 16;
    const int g = blockIdx.x, bh = g >> 2, b = bh >> 2, h = bh & 3, e = (g & 3) * 128 + (F.tid >> 2), seg = F.tid & 3;
    const float gamma = 1.0f - exp2f(-5.0f - (float)h);
    float st[64];
#pragma unroll
    for (int d = 0; d < 64; ++d) st[d] = 0.f;
    LAS float* Ls = (LAS float*)(F.lds + RING_OFF);
    for (int t0 = 0; t0 < SEQ; t0 += TB) {
        __syncthreads();
        for (int idx = F.tid; idx < TB * 512; idx += 512) { const int s_ = idx >> 9, c = idx & 511, isk = c >> 8, d = c & 255;
            const bf16 v = PROJ[((size_t)b * SEQ + t0 + s_) * NIN + (isk ? C_KR : C_QR) + h * RDK + d];
            Ls[((s_ * 2 + isk) * 4 + (d >> 6)) * 68 + (d & 63)] = bf2f(v) * (isk ? 0.0625f : 1.0f); }
        __syncthreads();
        for (int s_ = 0; s_ < TB; ++s_) {
            const size_t m = (size_t)b * SEQ + t0 + s_;
            const float v = bf2f(PROJ[m * NIN + C_VR + h * RDV + e]);
            const LAS float* qs = Ls + ((s_ * 2 + 0) * 4 + seg) * 68; const LAS float* ks = Ls + ((s_ * 2 + 1) * 4 + seg) * 68;
            float o = 0.f;
#pragma unroll
            for (int d4 = 0; d4 < 16; ++d4) { const f32x4 kq = *(const LAS f32x4*)(ks + 4 * d4), qq = *(const LAS f32x4*)(qs + 4 * d4);
                st[4 * d4 + 0] = st[4 * d4 + 0] * gamma + kq.x * v; o += qq.x * st[4 * d4 + 0];
                st[4 * d4 + 1] = st[4 * d4 + 1] * gamma + kq.y * v; o += qq.y * st[4 * d4 + 1];
                st[4 * d4 + 2] = st[4 * d4 + 2] * gamma + kq.z * v; o += qq.z * st[4 * d4 + 2];
                st[4 * d4 + 3] = st[4 * d4 + 3] * gamma + kq.w * v; o += qq.w * st[4 * d4 + 3]; }
            o += __shfl_xor(o, 1); o += __shfl_xor(o, 2);
            if (seg == 0) RET[m * (RH * RDV) + h * RDV + e] = o;
        }
    }
}
__device__ __forceinline__ void groupnorm_phase(Frame& F, const float* RET, const bf16* PROJ, bf16* ORR) {
    const int gw = F.vcu * NWAVES + F.wave, NGW = F.G * NWAVES;
    for (int u = gw; u < M * RH; u += NGW) {
        const size_t m = u >> 2; const int h = u & 3;
        const f32x4 a = ((const f32x4*)(RET + m * 2048 + h * RDV))[F.lane], c = ((const f32x4*)(RET + m * 2048 + h * RDV))[64 + F.lane];
        const float mean = wave_sum((a.x + a.y) + (a.z + a.w) + (c.x + c.y) + (c.z + c.w)) * (1.f / RDV);
        const f32x4 da = a - mean, dc = c - mean;
        const float var = wave_sum((da.x * da.x + da.y * da.y) + (da.z * da.z + da.w * da.w) + (dc.x * dc.x + dc.y * dc.y) + (dc.z * dc.z + dc.w * dc.w)) * (1.f / RDV);
        const float rstd = 1.0f / sqrtf(var + EPS);
        const bf16* grp = PROJ + m * NIN + C_GR + h * RDV;
        const unsigned long long g0 = ((const unsigned long long*)grp)[F.lane], g1 = ((const unsigned long long*)grp)[64 + F.lane];
        const unsigned g0l = (unsigned)g0, g0h = (unsigned)(g0 >> 32), g1l = (unsigned)g1, g1h = (unsigned)(g1 >> 32);
        bf16* op = ORR + m * 2048 + h * RDV;
        ((unsigned long long*)op)[F.lane] = (unsigned long long)pk2(da.x * rstd * pg8::siluf_(blo(g0l)), da.y * rstd * pg8::siluf_(bhi(g0l))) | ((unsigned long long)pk2(da.z * rstd * pg8::siluf_(blo(g0h)), da.w * rstd * pg8::siluf_(bhi(g0h))) << 32);
        ((unsigned long long*)op)[64 + F.lane] = (unsigned long long)pk2(dc.x * rstd * pg8::siluf_(blo(g1l)), dc.y * rstd * pg8::siluf_(bhi(g1l))) | ((unsigned long long)pk2(dc.z * rstd * pg8::siluf_(blo(g1h)), dc.w * rstd * pg8::siluf_(bhi(g1h))) << 32);
    }
}

struct Args { const float* in[11]; float* out; unsigned char* ws; int ph_lo, ph_hi; };
__global__ void __launch_bounds__(NWAVES * 64, 2) hybrid_fwd(Args args) {
    extern __shared__ __attribute__((aligned(16))) unsigned char lds[];
    Frame F;
    F.lds = (LAS unsigned char*)lds;
    F.MISC = (volatile LAS unsigned*)(F.lds + MISC_OFF);
    F.tid = threadIdx.x; F.lane = F.tid & 63; F.wave = __builtin_amdgcn_readfirstlane(F.tid >> 6);
    F.G = gridDim.x; { const int bx = blockIdx.x; F.vcu = (F.G % 8 == 0) ? (bx % 8) * (F.G / 8) + bx / 8 : bx; }
    unsigned char* ws = args.ws;
    F.ctl = (gu32*)(ws + WS_CTL);
    for (int u = F.tid; u < (LDS_BYTES - LDSCTL_OFF) / 4; u += NWAVES * 64) ((LAS unsigned*)(F.lds + LDSCTL_OFF))[u] = 0u;
    __syncthreads();
    XcdBarrier bar; bar.bar = (unsigned*)(F.ctl + CW_BAR); bar.x = 0; bar.st = nullptr;
    if (MK_ONE_LAUNCH) bar = xcd_barrier_post((unsigned*)(F.ctl + CW_BAR), F.MISC + 8);
    const int lo = args.ph_lo, hi = args.ph_hi;
#define IN(k) (lo <= (k) && (k) < hi)
#define SEAM(k) do { if (MK_ONE_LAUNCH && IN((k) + 1)) xcd_barrier(bar); } while (0)
    const float* x_in = args.in[0];
    float* xres = args.out;
    float* kmean = (float*)(ws + WS_KMEAN);
    bf16 *Win_t = (bf16*)(ws + WS_WIN), *Woa_t = (bf16*)(ws + WS_WOA), *Wor_t = (bf16*)(ws + WS_WOR), *Wout_t = (bf16*)(ws + WS_WOUT), *Wfi_t = (bf16*)(ws + WS_WFI), *Wfo_t = (bf16*)(ws + WS_WFO);
    bf16 *H = (bf16*)(ws + WS_H), *PROJ = (bf16*)(ws + WS_PROJ), *ACT = (bf16*)(ws + WS_PROJ), *OA = (bf16*)(ws + WS_OA), *ORR = (bf16*)(ws + WS_ORR), *MRG = (bf16*)(ws + WS_MRG);
    float *T = (float*)(ws + WS_T), *RET = (float*)(ws + WS_RET);

    for (int l = 0; l < DEPTH; ++l) {
        const int pb = l * NPH;
        { int tl = threadIdx.x; asm volatile("" : "+v"(tl)); F.tid = tl; F.lane = tl & 63; F.wave = __builtin_amdgcn_readfirstlane(tl >> 6); }
        const float* xcur = (l == 0) ? x_in : (const float*)xres;
        if (IN(pb + 0)) {
            int it0 = 0;
            convert_matrix<0>(F, args.in[1] + (size_t)l * DM * NIN, DM, NIN, Win_t, it0);
            convert_matrix<0>(F, args.in[2] + (size_t)l * AW * DM, AW, DM, Woa_t, it0);
            convert_matrix<0>(F, args.in[3] + (size_t)l * 2048 * DM, 2048, DM, Wor_t, it0);
            convert_matrix<0>(F, args.in[4] + (size_t)l * DM * DM, DM, DM, Wout_t, it0);
            convert_matrix<1>(F, args.in[9] + (size_t)l * DM * 2 * DFF, DM, 2 * DFF, Wfi_t, it0);
            convert_matrix<0>(F, args.in[10] + (size_t)l * DFF * DM, DFF, DM, Wfo_t, it0);
            SEAM(pb + 0);
        }
        if (IN(pb + 1)) { rmsnorm_phase(F, xcur, args.in[7] + (size_t)l * DM, H); SEAM(pb + 1); }
        if (IN(pb + 2)) {
            pg8::Gemm g{H, Win_t, M, NIN, DM}; pg8::StaticOrder S; S.init(M, NIN, F.G, (int)blockIdx.x);
            pg8::EpiProj E{PROJ, NIN};
            pg8::gemm_phase<pg8::EpiProj, pg8::StaticOrder, PG8_ALIGN, PG8_SP2>(F.lds + RING_OFF, g, S, E, F.tid);
            SEAM(pb + 2);
        }
        if (IN(pb + 3)) { qknorm_phase(F, PROJ, args.in[5] + (size_t)l * AD, args.in[6] + (size_t)l * AD, kmean); SEAM(pb + 3); }
        if (IN(pb + 4)) {
            if ((int)blockIdx.x < 32) retention_naive_phase(F, PROJ, RET); else attn_naive_phase(F, PROJ, kmean, OA, 32);
            SEAM(pb + 4);
        }
        if (IN(pb + 5)) { groupnorm_phase(F, RET, PROJ, ORR); SEAM(pb + 5); }
        if (IN(pb + 6)) {
            pg8::Gemm g{OA, Woa_t, M, DM, AW}; pg8::StaticOrder S; S.init(M, DM, F.G, (int)blockIdx.x);
            pg8::EpiSigMulF32 E{PROJ + C_GA, NIN, T, DM};
            pg8::gemm_phase<pg8::EpiSigMulF32, pg8::StaticOrder, PG8_ALIGN, PG8_SP2>(F.lds + RING_OFF, g, S, E, F.tid);
            SEAM(pb + 6);
        }
        if (IN(pb + 7)) {
            pg8::Gemm g{ORR, Wor_t, M, DM, 2048}; pg8::StaticOrder S; S.init(M, DM, F.G, (int)blockIdx.x);
            pg8::EpiMerge E{T, DM, PROJ + C_GT, NIN, MRG, DM};
            pg8::gemm_phase<pg8::EpiMerge, pg8::StaticOrder, PG8_ALIGN, PG8_SP2>(F.lds + RING_OFF, g, S, E, F.tid);
            SEAM(pb + 7);
        }
        if (IN(pb + 8)) {
            pg8::Gemm g{MRG, Wout_t, M, DM, DM}; pg8::StaticOrder S; S.init(M, DM, F.G, (int)blockIdx.x);
            pg8::EpiResF32 E{xcur, xres, DM};
            pg8::gemm_phase<pg8::EpiResF32, pg8::StaticOrder, PG8_ALIGN, PG8_SP2>(F.lds + RING_OFF, g, S, E, F.tid);
            SEAM(pb + 8);
        }
        if (IN(pb + 9)) { rmsnorm_phase(F, xres, args.in[8] + (size_t)l * DM, H); SEAM(pb + 9); }
        if (IN(pb + 10)) {
            pg8::Gemm g{H, Wfi_t, M, 2 * DFF, DM}; pg8::StaticOrder S; S.init(M, 2 * DFF, F.G, (int)blockIdx.x);
            pg8::EpiSwiGLU E{ACT, DFF};
            pg8::gemm_phase<pg8::EpiSwiGLU, pg8::StaticOrder, PG8_ALIGN, PG8_SP2>(F.lds + RING_OFF, g, S, E, F.tid);
            SEAM(pb + 10);
        }
        if (IN(pb + 11)) {
            pg8::Gemm g{ACT, Wfo_t, M, DM, DFF}; pg8::StaticOrder S; S.init(M, DM, F.G, (int)blockIdx.x);
            pg8::EpiResF32 E{xres, xres, DM};
            pg8::gemm_phase<pg8::EpiResF32, pg8::StaticOrder, PG8_ALIGN, PG8_SP2>(F.lds + RING_OFF, g, S, E, F.tid);
            SEAM(pb + 11);
        }
    }
#undef IN
#undef SEAM
}

extern "C" void kernel_launch(void* const* d_in, const int* in_sizes, int n_in, void* d_out, int out_size, void* d_ws, size_t ws_size, hipStream_t stream) {
    static int grid = 0;
    if (grid == 0) {
        if (n_in != 11 || in_sizes[0] != M * DM || out_size != M * DM || ws_size < WS_END) { fprintf(stderr, "kernel_launch: shape/workspace mismatch: n_in %d in0 %d out %d ws %zu (need %zu)\n", n_in, n_in > 0 ? in_sizes[0] : -1, out_size, ws_size, (size_t)WS_END); grid = -1; return; }
        int dev = 0, cus = 0, per_cu = 0;
        if (hipGetDevice(&dev) != hipSuccess || hipDeviceGetAttribute(&cus, hipDeviceAttributeMultiprocessorCount, dev) != hipSuccess) { grid = -1; return; }
        if (hipFuncSetAttribute((const void*)hybrid_fwd, hipFuncAttributeMaxDynamicSharedMemorySize, LDS_BYTES) != hipSuccess) { fprintf(stderr, "kernel_launch: hipFuncSetAttribute failed\n"); grid = -1; return; }
        if (hipOccupancyMaxActiveBlocksPerMultiprocessor(&per_cu, (const void*)hybrid_fwd, NWAVES * 64, LDS_BYTES) != hipSuccess || per_cu < 1)
            fprintf(stderr, "kernel_launch: note: occupancy query reports %d workgroups per CU\n", per_cu);
        (void)hipGetLastError();
        grid = cus;
    }
    if (grid < 0) return;
    if (hipMemsetAsync((char*)d_ws + WS_CTL, 0, CTL_ZERO_BYTES, stream) != hipSuccess) return;
    Args a{};
    for (int i = 0; i < 11; ++i) a.in[i] = (const float*)d_in[i];
    a.out = (float*)d_out; a.ws = (unsigned char*)d_ws;
#if MK_ONE_LAUNCH
    a.ph_lo = 0; a.ph_hi = NPHASES;
    hipLaunchKernelGGL(hybrid_fwd, dim3(grid), dim3(NWAVES * 64), LDS_BYTES, stream, a);
#else
    for (int p = 0; p < NPHASES; ++p) { a.ph_lo = p; a.ph_hi = p + 1; hipLaunchKernelGGL(hybrid_fwd, dim3(grid), dim3(NWAVES * 64), LDS_BYTES, stream, a); }
#endif
    const hipError_t le = hipPeekAtLastError();
    if (le != hipSuccess) fprintf(stderr, "kernel_launch: launch failed: %s\n", hipGetErrorName(le));
}
```

```cpp
#include <hip/hip_runtime.h>
#include <cstdio>
#include <cstdint>
#include <type_traits>
namespace pg8 {
#define PG8_LAS __attribute__((address_space(3)))
#define PG8_GAS __attribute__((address_space(1)))
typedef unsigned short bf16_t;
typedef short bf16x8 __attribute__((ext_vector_type(8)));
typedef float f32x4 __attribute__((ext_vector_type(4)));
typedef unsigned u32x4 __attribute__((ext_vector_type(4)));
constexpr int BM = 256, BK = 64, HALF = 128, HTB = HALF * BK * 2  , STAGE_BYTES = 8 * HTB, NXCD = 8, WGM = 8;

__host__ __device__ __forceinline__ int lds_byte(int r, int c) { const int st = (r >> 4) * 2 + (c >> 5), rr = r & 15, cc = c & 31, ob = rr * 64 + cc * 2; return st * 1024 + (ob ^ (((ob >> 9) & 1) << 5)); }
__host__ __device__ __forceinline__ void stage_rc(int b, int& R, int& C) { const int st = b / 1024, sb = b % 1024, swz = sb ^ (((sb >> 9) & 1) << 5); R = (st >> 1) * 16 + swz / 64; C = (st & 1) * 32 + (swz % 64) / 2; }
__host__ __device__ __forceinline__ int perm32(int rho) { const int n = rho >> 4, i = rho & 15; return 8 * (i >> 2) + 4 * n + (i & 3); }

struct Unit { int pm, pn; };
struct StaticOrder {
    int nM, nN, nwg, G, c; bool sw;
    __host__ __device__ void init(int M, int N, int G_, int c_, bool sw_ = false) { nM = M / BM; nN = N / BM; nwg = nM * nN; G = G_; c = c_; sw = sw_ && (nwg % NXCD == 0) && (nN % NXCD == 0); }
    __host__ __device__ bool next(int i, Unit& u) const {
        const long L = (long)i * G + c; if (L >= nwg) return false;
        int wgid = (int)L; { const int q = nwg / NXCD, r = nwg % NXCD, xcd = wgid % NXCD, off = wgid / NXCD; wgid = (xcd < r ? xcd * (q + 1) : r * (q + 1) + (xcd - r) * q) + off; }
        if (sw) { const int q = nwg / NXCD, per = nN / NXCD, xcd = wgid / q, off = wgid % q; u.pm = off / per; u.pn = xcd * per + off % per; return true; }
        const int nig = WGM * nN, gid = wgid / nig, fm = gid * WGM, gsz = (nM - fm) < WGM ? (nM - fm) : WGM;
        u.pm = fm + ((wgid % nig) % gsz); u.pn = (wgid % nig) / gsz; return true;
    }
};
struct PlainDesc {
    const PG8_GAS bf16_t* A; const PG8_GAS bf16_t* Bt; int K, lda, ldb; StaticOrder O;
    __device__ __forceinline__ bool next(int i, Unit& u) const { return O.next(i, u); }
    __device__ __forceinline__ const PG8_GAS bf16_t* a_ptr(const Unit& u) const { return A + (size_t)u.pm * BM * lda; }
    __device__ __forceinline__ const PG8_GAS bf16_t* b_ptr(const Unit& u) const { return Bt + (size_t)u.pn * BM * ldb; }
    __device__ __forceinline__ void a_ready(const Unit&) const {}
    __device__ __forceinline__ void done(const Unit&) const {}
};
struct BatchDesc {
    const PG8_GAS bf16_t* A; const PG8_GAS bf16_t* Bt; int K, lda, ldb; size_t sA, sB, tA, tB; int nunits, ntile, G, c, own_batches;
    __device__ __forceinline__ bool next(int i, Unit& u) const {
        if (own_batches) { u.pm = c + (i / ntile) * G; u.pn = i % ntile; return u.pm * ntile < nunits; }
        const int L = i * G + c; if (L >= nunits) return false; u.pm = L / ntile; u.pn = L % ntile; return true; }
    __device__ __forceinline__ const PG8_GAS bf16_t* a_ptr(const Unit& u) const { return A + (size_t)u.pm * sA + (size_t)u.pn * tA; }
    __device__ __forceinline__ const PG8_GAS bf16_t* b_ptr(const Unit& u) const { return Bt + (size_t)u.pm * sB + (size_t)u.pn * tB; }
    __device__ __forceinline__ void a_ready(const Unit&) const {}
    __device__ __forceinline__ void done(const Unit&) const {}
};

constexpr int SWP_MARK = 4096;
struct ProjDesc {
    const PG8_GAS bf16_t* H; const PG8_GAS bf16_t* Wnat; const PG8_GAS bf16_t* Wswp; int K, lda, ldb; StaticOrder On, Os; int nnat;
    __device__ __forceinline__ bool next(int i, Unit& u) const {
        if (i < nnat) return On.next(i, u);
        if (!Os.next(i - nnat, u)) return false;
        u.pn += SWP_MARK; return true; }
    __device__ __forceinline__ const PG8_GAS bf16_t* a_ptr(const Unit& u) const { return u.pn >= SWP_MARK ? Wswp + (size_t)u.pm * BM * lda : H + (size_t)u.pm * BM * lda; }
    __device__ __forceinline__ const PG8_GAS bf16_t* b_ptr(const Unit& u) const { return u.pn >= SWP_MARK ? H + (size_t)(u.pn - SWP_MARK) * BM * ldb : Wnat + (size_t)u.pn * BM * ldb; }
    __device__ __forceinline__ void a_ready(const Unit&) const {}
    __device__ __forceinline__ void done(const Unit&) const {}
};

struct RetDesc {
    const PG8_GAS bf16_t* AQq; const PG8_GAS bf16_t* KB; const PG8_GAS bf16_t* BQ; const PG8_GAS bf16_t* KTB; int K, lda, ldb, G, c, ns;
    __device__ __forceinline__ bool next(int i, Unit& u) const {
        if (i < ns) { u.pm = i * G + c; u.pn = SWP_MARK; return true; }
        const int L = (i - ns) * G + c; if (L >= 512) return false; u.pm = L >> 1; u.pn = L & 1; return true; }
    __device__ __forceinline__ const PG8_GAS bf16_t* a_ptr(const Unit& u) const { return u.pn >= SWP_MARK ? AQq + (size_t)u.pm * 131072 : BQ + (size_t)u.pm * 262144 + (size_t)u.pn * 131072; }
    __device__ __forceinline__ const PG8_GAS bf16_t* b_ptr(const Unit& u) const { return u.pn >= SWP_MARK ? KB + (size_t)u.pm * 65536 : KTB + (size_t)u.pm * 65536; }
    __device__ __forceinline__ void a_ready(const Unit&) const {}
    __device__ __forceinline__ void done(const Unit&) const {}
};

__device__ __forceinline__ unsigned cvt_pk_bf16(float lo, float hi) { unsigned r; asm volatile("v_cvt_pk_bf16_f32 %0, %1, %2" : "=v"(r) : "v"(lo), "v"(hi)); return r; }
__device__ __forceinline__ float bflo(unsigned w) { return __uint_as_float(w << 16); }
__device__ __forceinline__ float bfhi(unsigned w) { return __uint_as_float(w & 0xffff0000u); }
__device__ __forceinline__ float sigmoidf_(float x) { return __builtin_amdgcn_rcpf(1.0f + __expf(-x)); }
__device__ __forceinline__ float siluf_(float x) { return x * sigmoidf_(x); }
typedef unsigned u32x2 __attribute__((ext_vector_type(2)));

struct EpiProj {
    static constexpr bool PERM = true, AFTER_DRAIN = false; static constexpr int MID_T = 0;
    PG8_GAS bf16_t* O; int ldc;
    __device__ __forceinline__ void operator()(const f32x4 (&acc)[2][2][4][2], const Unit& u, int wr, int wc, int fr, int fq) const {
        const int row0 = u.pm * BM + wr * 64 + fr, col0 = u.pn * BM + wc * 32 + 8 * fq;
#pragma unroll
        for (int ai = 0; ai < 2; ++ai)
#pragma unroll
            for (int m = 0; m < 4; ++m) { PG8_GAS bf16_t* rowp = O + (size_t)(row0 + ai * HALF + m * 16) * ldc + col0;
#pragma unroll
                for (int bj = 0; bj < 2; ++bj) { const f32x4 v0 = acc[ai][bj][m][0], v1 = acc[ai][bj][m][1];
                    u32x4 w; w.x = cvt_pk_bf16(v0[0], v0[1]); w.y = cvt_pk_bf16(v0[2], v0[3]); w.z = cvt_pk_bf16(v1[0], v1[1]); w.w = cvt_pk_bf16(v1[2], v1[3]);
                    *(PG8_GAS u32x4*)(rowp + bj * HALF) = w; } }
    }
};
struct EpiSigMulF32 {
    static constexpr bool PERM = false, AFTER_DRAIN = false; static constexpr int MID_T = 0;
    const PG8_GAS bf16_t* gate; int ldg; PG8_GAS float* T; int ldc;
    __device__ __forceinline__ void operator()(const f32x4 (&acc)[2][2][4][2], const Unit& u, int wr, int wc, int fr, int fq) const {
        const int row0 = u.pm * BM + wr * 64 + fr, col0 = u.pn * BM + wc * 32 + 4 * fq;
#pragma unroll
        for (int ai = 0; ai < 2; ++ai)
#pragma unroll
            for (int m = 0; m < 4; ++m) { const size_t r = (size_t)(row0 + ai * HALF + m * 16);
#pragma unroll
                for (int bj = 0; bj < 2; ++bj)
#pragma unroll
                    for (int n = 0; n < 2; ++n) { const int c = col0 + bj * HALF + n * 16;
                        const u32x2 gw = *(const PG8_GAS u32x2*)(gate + r * ldg + c);
                        f32x4 s; s[0] = sigmoidf_(bflo(gw.x)); s[1] = sigmoidf_(bfhi(gw.x)); s[2] = sigmoidf_(bflo(gw.y)); s[3] = sigmoidf_(bfhi(gw.y));
                        *(PG8_GAS f32x4*)(T + r * ldc + c) = acc[ai][bj][m][n] * s; } }
    }
};
struct EpiMerge {
    static constexpr bool PERM = true, AFTER_DRAIN = false; static constexpr int MID_T = 0;
    const PG8_GAS float* T; int ldt; const PG8_GAS bf16_t* gate; int ldg; PG8_GAS bf16_t* O; int ldc;
    __device__ __forceinline__ void operator()(const f32x4 (&acc)[2][2][4][2], const Unit& u, int wr, int wc, int fr, int fq) const {
        const int row0 = u.pm * BM + wr * 64 + fr, col0 = u.pn * BM + wc * 32 + 8 * fq;
#pragma unroll
        for (int ai = 0; ai < 2; ++ai)
#pragma unroll
            for (int m = 0; m < 4; ++m) { const size_t r = (size_t)(row0 + ai * HALF + m * 16);
#pragma unroll
                for (int bj = 0; bj < 2; ++bj) { const int c = col0 + bj * HALF;
                    const u32x4 gw = *(const PG8_GAS u32x4*)(gate + r * ldg + c);
                    const f32x4 t0 = *(const PG8_GAS f32x4*)(T + r * ldt + c), t1 = *(const PG8_GAS f32x4*)(T + r * ldt + c + 4);
                    f32x4 s0, s1; s0[0] = sigmoidf_(bflo(gw.x)); s0[1] = sigmoidf_(bfhi(gw.x)); s0[2] = sigmoidf_(bflo(gw.y)); s0[3] = sigmoidf_(bfhi(gw.y));
                    s1[0] = sigmoidf_(bflo(gw.z)); s1[1] = sigmoidf_(bfhi(gw.z)); s1[2] = sigmoidf_(bflo(gw.w)); s1[3] = sigmoidf_(bfhi(gw.w));
                    const f32x4 v0 = t0 + s0 * acc[ai][bj][m][0], v1 = t1 + s1 * acc[ai][bj][m][1];
                    u32x4 w; w.x = cvt_pk_bf16(v0[0], v0[1]); w.y = cvt_pk_bf16(v0[2], v0[3]); w.z = cvt_pk_bf16(v1[0], v1[1]); w.w = cvt_pk_bf16(v1[2], v1[3]);
                    *(PG8_GAS u32x4*)(O + r * ldc + c) = w; } }
    }
};
struct EpiRes {
    static constexpr bool PERM = true, AFTER_DRAIN = false; static constexpr int MID_T = 0;
    const PG8_GAS void* base; PG8_GAS void* out; int ldc; bool base_f32, out_f32; PG8_GAS float* ps;
    __device__ __forceinline__ static float ssq8(const u32x4 w) { return ((bflo(w.x) * bflo(w.x) + bfhi(w.x) * bfhi(w.x)) + (bflo(w.y) * bflo(w.y) + bfhi(w.y) * bfhi(w.y))) + ((bflo(w.z) * bflo(w.z) + bfhi(w.z) * bfhi(w.z)) + (bflo(w.w) * bflo(w.w) + bfhi(w.w) * bfhi(w.w))); }
    __device__ __forceinline__ void put_ps(float q, int row, int slot, int fq) const {
        ps[(size_t)row * 128 + slot * 4 + fq] = q;
    }
    __device__ __forceinline__ void operator()(const f32x4 (&acc)[2][2][4][2], const Unit& u, int wr, int wc, int fr, int fq) const {
        const int row0 = u.pm * BM + wr * 64 + fr, col0 = u.pn * BM + wc * 32 + 8 * fq, slot = u.pn * 4 + wc;
        if (base_f32) {
#pragma unroll
            for (int ai = 0; ai < 2; ++ai) {
                f32x4 v[4][2][2];
#pragma unroll
                for (int m = 0; m < 4; ++m) { const size_t off = (size_t)(row0 + ai * HALF + m * 16) * ldc + col0;
#pragma unroll
                    for (int bj = 0; bj < 2; ++bj) { v[m][bj][0] = *(const PG8_GAS f32x4*)((const PG8_GAS float*)base + off + bj * HALF); v[m][bj][1] = *(const PG8_GAS f32x4*)((const PG8_GAS float*)base + off + bj * HALF + 4); } }
#pragma unroll
                for (int m = 0; m < 4; ++m) { const size_t off = (size_t)(row0 + ai * HALF + m * 16) * ldc + col0; float q = 0.f;
#pragma unroll
                    for (int bj = 0; bj < 2; ++bj) { const f32x4 v0 = v[m][bj][0] + acc[ai][bj][m][0], v1 = v[m][bj][1] + acc[ai][bj][m][1];
                        if (out_f32) { *(PG8_GAS f32x4*)((PG8_GAS float*)out + off + bj * HALF) = v0; *(PG8_GAS f32x4*)((PG8_GAS float*)out + off + bj * HALF + 4) = v1; }
                        else { u32x4 w; w.x = cvt_pk_bf16(v0[0], v0[1]); w.y = cvt_pk_bf16(v0[2], v0[3]); w.z = cvt_pk_bf16(v1[0], v1[1]); w.w = cvt_pk_bf16(v1[2], v1[3]); q += ssq8(w);
                            *(PG8_GAS u32x4*)((PG8_GAS bf16_t*)out + off + bj * HALF) = w; } }
                    if (ps) put_ps(q, row0 + ai * HALF + m * 16, slot, fq); }
            }
        } else {
            u32x4 w[8][2];
#define ER_LOAD(s_) do { const size_t off_ = (size_t)(row0 + ((s_) >> 2) * HALF + ((s_) & 3) * 16) * ldc + col0; \
    w[s_][0] = *(const PG8_GAS u32x4*)((const PG8_GAS bf16_t*)base + off_); w[s_][1] = *(const PG8_GAS u32x4*)((const PG8_GAS bf16_t*)base + off_ + HALF); } while (0)
#pragma unroll
            for (int s_ = 0; s_ < 4; ++s_) ER_LOAD(s_);
#pragma unroll
            for (int s_ = 0; s_ < 8; ++s_) { const int ai = s_ >> 2, m = s_ & 3; const size_t off = (size_t)(row0 + ai * HALF + m * 16) * ldc + col0; float q = 0.f;
#pragma unroll
                for (int bj = 0; bj < 2; ++bj) { const u32x4 b = w[s_][bj];
                    const f32x4 v0 = (f32x4){bflo(b.x), bfhi(b.x), bflo(b.y), bfhi(b.y)} + acc[ai][bj][m][0], v1 = (f32x4){bflo(b.z), bfhi(b.z), bflo(b.w), bfhi(b.w)} + acc[ai][bj][m][1];
                    if (out_f32) { *(PG8_GAS f32x4*)((PG8_GAS float*)out + off + bj * HALF) = v0; *(PG8_GAS f32x4*)((PG8_GAS float*)out + off + bj * HALF + 4) = v1; }
                    else { u32x4 o; o.x = cvt_pk_bf16(v0[0], v0[1]); o.y = cvt_pk_bf16(v0[2], v0[3]); o.z = cvt_pk_bf16(v1[0], v1[1]); o.w = cvt_pk_bf16(v1[2], v1[3]); q += ssq8(o);
                        *(PG8_GAS u32x4*)((PG8_GAS bf16_t*)out + off + bj * HALF) = o; } }
                if (s_ + 4 < 8) ER_LOAD(s_ + 4);
                if (ps) put_ps(q, row0 + ai * HALF + m * 16, slot, fq); }
#undef ER_LOAD
        }
    }
};
struct EpiSwiGLU {
    static constexpr bool PERM = true, AFTER_DRAIN = false; static constexpr int MID_T = 0;
    PG8_GAS bf16_t* O; int ldc; const PG8_GAS float* rs;
    static constexpr bool RS_LDS = true;
    __device__ __forceinline__ const PG8_GAS float* rs_base(const Unit& u) const { return rs ? rs + (size_t)u.pm * BM : (const PG8_GAS float*)nullptr; }
    __device__ __forceinline__ void operator()(const f32x4 (&acc)[2][2][4][2], const Unit& u, int wr, int wc, int fr, int fq, const PG8_LAS float* rsl) const {
        const int row0 = u.pm * BM + wr * 64 + fr, col0 = u.pn * HALF + wc * 32 + 8 * fq;
        float rsv[2][4];
#pragma unroll
        for (int ai = 0; ai < 2; ++ai)
#pragma unroll
            for (int m = 0; m < 4; ++m) rsv[ai][m] = rsl[wr * 64 + fr + ai * HALF + m * 16];
#pragma unroll
        for (int ai = 0; ai < 2; ++ai)
#pragma unroll
            for (int m = 0; m < 4; ++m) { PG8_GAS bf16_t* rowp = O + (size_t)(row0 + ai * HALF + m * 16) * ldc + col0; const float r_ = rsv[ai][m];
                const f32x4 g0 = acc[ai][0][m][0] * r_, g1 = acc[ai][0][m][1] * r_, u0 = acc[ai][1][m][0] * r_, u1 = acc[ai][1][m][1] * r_;
                f32x4 v0, v1;
#pragma unroll
                for (int j = 0; j < 4; ++j) { v0[j] = siluf_(g0[j]) * u0[j]; v1[j] = siluf_(g1[j]) * u1[j]; }
                u32x4 w; w.x = cvt_pk_bf16(v0[0], v0[1]); w.y = cvt_pk_bf16(v0[2], v0[3]); w.z = cvt_pk_bf16(v1[0], v1[1]); w.w = cvt_pk_bf16(v1[2], v1[3]);
                *(PG8_GAS u32x4*)rowp = w; }
    }
};

struct EpiProjNat {
    static constexpr bool PERM = true, AFTER_DRAIN = false; static constexpr int MID_T = 0;
    PG8_GAS bf16_t* PROJ; int ldp; PG8_GAS bf16_t* AQ; PG8_GAS bf16_t* KB; const PG8_GAS float* rs;
    __device__ __forceinline__ void operator()(const f32x4 (&acc)[2][2][4][2], const Unit& u, int wr, int wc, int fr, int fq, const PG8_LAS float* rsl) const {
        PG8_GAS bf16_t* base; int ldc;
        float rsv[2][4];
#pragma unroll
        for (int ai = 0; ai < 2; ++ai)
#pragma unroll
            for (int m = 0; m < 4; ++m) rsv[ai][m] = rsl[wr * 64 + fr + ai * HALF + m * 16];
        if (u.pn < 36) { base = PROJ + (size_t)u.pm * BM * ldp + u.pn * BM; ldc = ldp; }
        else { const int isk = u.pn >= 40, h = (u.pn - 36) & 3, c = ((u.pm >> 5) * 4 + h) * 32 + (u.pm & 31);
            if (isk) { base = KB + (size_t)c * 65536; ldc = 256; } else { base = AQ + (size_t)c * 131072 + 256; ldc = 512; } }
        const int row0 = wr * 64 + fr, col0 = wc * 32 + 8 * fq;
#pragma unroll
        for (int ai = 0; ai < 2; ++ai)
#pragma unroll
            for (int m = 0; m < 4; ++m) { PG8_GAS bf16_t* rowp = base + (size_t)(row0 + ai * HALF + m * 16) * ldc + col0; const float r_ = rsv[ai][m];
#pragma unroll
                for (int bj = 0; bj < 2; ++bj) { const f32x4 v0 = acc[ai][bj][m][0] * r_, v1 = acc[ai][bj][m][1] * r_;
                    u32x4 w; w.x = cvt_pk_bf16(v0[0], v0[1]); w.y = cvt_pk_bf16(v0[2], v0[3]); w.z = cvt_pk_bf16(v1[0], v1[1]); w.w = cvt_pk_bf16(v1[2], v1[3]);
                    *(PG8_GAS u32x4*)(rowp + bj * HALF) = w; } }
    }
};
struct EpiSwap {
    static constexpr bool PERM = true, AFTER_DRAIN = false; static constexpr int MID_T = 0;
    PG8_GAS bf16_t* KTB; PG8_GAS bf16_t* BQ; const PG8_GAS float* rs;
    __device__ __forceinline__ void operator()(const f32x4 (&acc)[2][2][4][2], const Unit& u, int wr, int wc, int fr, int fq, const PG8_LAS float* rsl) const {
        const int b = u.pn >> 5, n = u.pn & 31; PG8_GAS bf16_t* base; int ldc; float lg = 0.f, mul = 1.f;
        { const int h = u.pm >> 1, half = u.pm & 1, c = (b * 4 + h) * 32 + n; base = BQ + (size_t)c * 262144 + (size_t)half * 131072; ldc = 512;
            lg = -__log2f(1.0f - exp2f(-5.0f - (float)h)); mul = 0.0625f; }
        asm volatile("" : "+v"(fr), "+v"(fq));
        const int row0 = wr * 64 + fr, col0 = wc * 32 + 8 * fq;
        f32x4 sc[2][2];
#pragma unroll
        for (int bj = 0; bj < 2; ++bj)
#pragma unroll
            for (int n2 = 0; n2 < 2; ++n2)
#pragma unroll
                for (int k = 0; k < 4; ++k) sc[bj][n2][k] = mul * exp2f(lg * (float)(col0 + bj * HALF + 4 * n2 + k + 1)) * rsl[col0 + bj * HALF + 4 * n2 + k];
#pragma unroll
        for (int ai = 0; ai < 2; ++ai)
#pragma unroll
            for (int m = 0; m < 4; ++m) { PG8_GAS bf16_t* rowp = base + (size_t)(row0 + ai * HALF + m * 16) * ldc + col0;
#pragma unroll
                for (int bj = 0; bj < 2; ++bj) { const f32x4 v0 = acc[ai][bj][m][0] * sc[bj][0], v1 = acc[ai][bj][m][1] * sc[bj][1];
                    u32x4 w; w.x = cvt_pk_bf16(v0[0], v0[1]); w.y = cvt_pk_bf16(v0[2], v0[3]); w.z = cvt_pk_bf16(v1[0], v1[1]); w.w = cvt_pk_bf16(v1[2], v1[3]);
                    *(PG8_GAS u32x4*)(rowp + bj * HALF) = w; } }
    }
};
struct EpiProjBoth {
    static constexpr bool PERM = true, AFTER_DRAIN = false; static constexpr int MID_T = 0;
    EpiProjNat N; EpiSwap S;
    static constexpr bool RS_LDS = true;
    __device__ __forceinline__ const PG8_GAS float* rs_base(const Unit& u) const { return N.rs ? N.rs + (size_t)(u.pn >= SWP_MARK ? u.pn - SWP_MARK : u.pm) * BM : (const PG8_GAS float*)nullptr; }
    __device__ __forceinline__ void operator()(const f32x4 (&acc)[2][2][4][2], const Unit& u, int wr, int wc, int fr, int fq, const PG8_LAS float* rsl) const {
        if (u.pn >= SWP_MARK) { Unit v = u; v.pn -= SWP_MARK; S(acc, v, wr, wc, fr, fq, rsl); } else N(acc, u, wr, wc, fr, fq, rsl);
    }
};
struct EpiS {
    static constexpr bool PERM = true, AFTER_DRAIN = false; static constexpr int MID_T = 0;
    PG8_GAS bf16_t* AQ;
    __device__ __forceinline__ void operator()(const f32x4 (&acc)[2][2][4][2], const Unit& u, int wr, int wc, int fr, int fq) const {
        PG8_GAS bf16_t* base = AQ + (size_t)u.pm * 131072;
        asm volatile("" : "+v"(fr), "+v"(fq));
        const int row0 = wr * 64 + fr, col0 = wc * 32 + 8 * fq;
#pragma unroll
        for (int ai = 0; ai < 2; ++ai)
#pragma unroll
            for (int m = 0; m < 4; ++m) { const int i = row0 + ai * HALF + m * 16; PG8_GAS bf16_t* rowp = base + (size_t)i * 512 + col0;
#pragma unroll
                for (int bj = 0; bj < 2; ++bj) { f32x4 v0 = acc[ai][bj][m][0], v1 = acc[ai][bj][m][1]; const int j0 = col0 + bj * HALF;
#pragma unroll
                    for (int k = 0; k < 4; ++k) { if (j0 + k > i) v0[k] = 0.f; if (j0 + 4 + k > i) v1[k] = 0.f; }
                    u32x4 w; w.x = cvt_pk_bf16(v0[0], v0[1]); w.y = cvt_pk_bf16(v0[2], v0[3]); w.z = cvt_pk_bf16(v1[0], v1[1]); w.w = cvt_pk_bf16(v1[2], v1[3]);
                    *(PG8_GAS u32x4*)(rowp + bj * HALF) = w; } }
    }
};
struct EpiKV {
    static constexpr bool PERM = true, AFTER_DRAIN = false; static constexpr int MID_T = 0;
    PG8_GAS bf16_t* ST;
    __device__ __forceinline__ void operator()(const f32x4 (&acc)[2][2][4][2], const Unit& u, int wr, int wc, int fr, int fq) const {
        const int h = (u.pm >> 5) & 3; const float gC = exp2f(256.0f * __log2f(1.0f - exp2f(-5.0f - (float)h)));
        PG8_GAS bf16_t* base = ST + (size_t)u.pm * 131072 + (size_t)u.pn * 65536;
        const int row0 = wr * 64 + fr, col0 = wc * 32 + 8 * fq;
#pragma unroll
        for (int ai = 0; ai < 2; ++ai)
#pragma unroll
            for (int m = 0; m < 4; ++m) { PG8_GAS bf16_t* rowp = base + (size_t)(row0 + ai * HALF + m * 16) * 256 + col0;
#pragma unroll
                for (int bj = 0; bj < 2; ++bj) { const f32x4 v0 = acc[ai][bj][m][0] * gC, v1 = acc[ai][bj][m][1] * gC;
                    u32x4 w; w.x = cvt_pk_bf16(v0[0], v0[1]); w.y = cvt_pk_bf16(v0[2], v0[3]); w.z = cvt_pk_bf16(v1[0], v1[1]); w.w = cvt_pk_bf16(v1[2], v1[3]);
                    *(PG8_GAS u32x4*)(rowp + bj * HALF) = w; } }
    }
};
struct EpiRetBoth {
    static constexpr bool PERM = true, AFTER_DRAIN = false; static constexpr int MID_T = 0;
    EpiS S; EpiKV KV;
    __device__ __forceinline__ void operator()(const f32x4 (&acc)[2][2][4][2], const Unit& u, int wr, int wc, int fr, int fq) const {
        if (u.pn >= SWP_MARK) S(acc, u, wr, wc, fr, fq); else KV(acc, u, wr, wc, fr, fq);
    }
};
struct EpiO {
    static constexpr bool PERM = true, AFTER_DRAIN = false; static constexpr int MID_T = 0;
    PG8_GAS bf16_t* RET; int seq;
    __device__ __forceinline__ void operator()(const f32x4 (&acc)[2][2][4][2], const Unit& u, int wr, int wc, int fr, int fq) const {
        const int c = u.pm, b = c >> 7, h = (c >> 5) & 3, n = c & 31; const float lg = __log2f(1.0f - exp2f(-5.0f - (float)h));
        PG8_GAS bf16_t* base = RET + ((size_t)b * seq + n * 256) * 2048 + h * 512 + u.pn * 256;
        asm volatile("" : "+v"(fr), "+v"(fq));
        const int row0 = wr * 64 + fr, col0 = wc * 32 + 8 * fq;
#pragma unroll
        for (int ai = 0; ai < 2; ++ai)
#pragma unroll
            for (int m = 0; m < 4; ++m) { const int i = row0 + ai * HALF + m * 16; const float rs = exp2f(lg * (float)(i + 1)); PG8_GAS bf16_t* rowp = base + (size_t)i * 2048 + col0;
#pragma unroll
                for (int bj = 0; bj < 2; ++bj) { const f32x4 v0 = acc[ai][bj][m][0] * rs, v1 = acc[ai][bj][m][1] * rs;
                    u32x4 w; w.x = cvt_pk_bf16(v0[0], v0[1]); w.y = cvt_pk_bf16(v0[2], v0[3]); w.z = cvt_pk_bf16(v1[0], v1[1]); w.w = cvt_pk_bf16(v1[2], v1[3]);
                    *(PG8_GAS u32x4*)(rowp + bj * HALF) = w; } }
    }
};
struct EpiMergeCat {
    static constexpr bool PERM = true, AFTER_DRAIN = false; static constexpr int MID_T = 16;
    const PG8_GAS bf16_t* ga; const PG8_GAS bf16_t* gr; int ldg; PG8_GAS bf16_t* O; int ldc;
    __device__ __forceinline__ static float en(float g) { return __expf(fminf(-g, 80.0f)); }
    __device__ __forceinline__ void mid(f32x4 (&acc)[2][2][4][2], const Unit& u, int wr, int wc, int fr, int fq) const {
        asm volatile("" : "+v"(fr), "+v"(fq));
        const int row0 = u.pm * BM + wr * 64 + fr, col0 = u.pn * BM + wc * 32 + 8 * fq;
        u32x4 wa[8][2], wg[8][2];
#define MC_LOAD(s_) do { const size_t r_ = (size_t)(row0 + ((s_) >> 2) * HALF + ((s_) & 3) * 16); \
    wa[s_][0] = *(const PG8_GAS u32x4*)(ga + r_ * ldg + col0); wa[s_][1] = *(const PG8_GAS u32x4*)(ga + r_ * ldg + col0 + HALF); \
    wg[s_][0] = *(const PG8_GAS u32x4*)(gr + r_ * ldg + col0); wg[s_][1] = *(const PG8_GAS u32x4*)(gr + r_ * ldg + col0 + HALF); } while (0)
        MC_LOAD(0); MC_LOAD(1); MC_LOAD(2);
#pragma unroll
        for (int s_ = 0; s_ < 8; ++s_) { const int ai = s_ >> 2, m = s_ & 3;
            if (s_ + 3 < 8) MC_LOAD(s_ + 3);
#pragma unroll
            for (int bj = 0; bj < 2; ++bj) { const u32x4 a = wa[s_][bj], g = wg[s_][bj];
                f32x4 q0, q1;
                q0[0] = (1.0f + en(bflo(g.x))) * __builtin_amdgcn_rcpf(1.0f + en(bflo(a.x))); q0[1] = (1.0f + en(bfhi(g.x))) * __builtin_amdgcn_rcpf(1.0f + en(bfhi(a.x)));
                q0[2] = (1.0f + en(bflo(g.y))) * __builtin_amdgcn_rcpf(1.0f + en(bflo(a.y))); q0[3] = (1.0f + en(bfhi(g.y))) * __builtin_amdgcn_rcpf(1.0f + en(bfhi(a.y)));
                q1[0] = (1.0f + en(bflo(g.z))) * __builtin_amdgcn_rcpf(1.0f + en(bflo(a.z))); q1[1] = (1.0f + en(bfhi(g.z))) * __builtin_amdgcn_rcpf(1.0f + en(bfhi(a.z)));
                q1[2] = (1.0f + en(bflo(g.w))) * __builtin_amdgcn_rcpf(1.0f + en(bflo(a.w))); q1[3] = (1.0f + en(bfhi(g.w))) * __builtin_amdgcn_rcpf(1.0f + en(bfhi(a.w)));
                acc[ai][bj][m][0] = acc[ai][bj][m][0] * q0; acc[ai][bj][m][1] = acc[ai][bj][m][1] * q1; } }
#undef MC_LOAD
    }
    __device__ __forceinline__ void operator()(const f32x4 (&acc)[2][2][4][2], const Unit& u, int wr, int wc, int fr, int fq) const {
        const int row0 = u.pm * BM + wr * 64 + fr, col0 = u.pn * BM + wc * 32 + 8 * fq;
        u32x4 wg[8][2];
#define MC_LOAD(s_) do { const size_t r_ = (size_t)(row0 + ((s_) >> 2) * HALF + ((s_) & 3) * 16); \
    wg[s_][0] = *(const PG8_GAS u32x4*)(gr + r_ * ldg + col0); wg[s_][1] = *(const PG8_GAS u32x4*)(gr + r_ * ldg + col0 + HALF); } while (0)
#pragma unroll
        for (int s_ = 0; s_ < 4; ++s_) MC_LOAD(s_);
#pragma unroll
        for (int s_ = 0; s_ < 8; ++s_) { const int ai = s_ >> 2, m = s_ & 3; const size_t r = (size_t)(row0 + ai * HALF + m * 16);
#pragma unroll
            for (int bj = 0; bj < 2; ++bj) { const int c = col0 + bj * HALF; const u32x4 g = wg[s_][bj];
                f32x4 s0, s1; s0[0] = __builtin_amdgcn_rcpf(1.0f + en(bflo(g.x))); s0[1] = __builtin_amdgcn_rcpf(1.0f + en(bfhi(g.x))); s0[2] = __builtin_amdgcn_rcpf(1.0f + en(bflo(g.y))); s0[3] = __builtin_amdgcn_rcpf(1.0f + en(bfhi(g.y)));
                s1[0] = __builtin_amdgcn_rcpf(1.0f + en(bflo(g.z))); s1[1] = __builtin_amdgcn_rcpf(1.0f + en(bfhi(g.z))); s1[2] = __builtin_amdgcn_rcpf(1.0f + en(bflo(g.w))); s1[3] = __builtin_amdgcn_rcpf(1.0f + en(bfhi(g.w)));
                const f32x4 v0 = s0 * acc[ai][bj][m][0], v1 = s1 * acc[ai][bj][m][1];
                u32x4 w; w.x = cvt_pk_bf16(v0[0], v0[1]); w.y = cvt_pk_bf16(v0[2], v0[3]); w.z = cvt_pk_bf16(v1[0], v1[1]); w.w = cvt_pk_bf16(v1[2], v1[3]);
                *(PG8_GAS u32x4*)(O + r * ldc + c) = w; }
            if (s_ + 4 < 8) MC_LOAD(s_ + 4); }
#undef MC_LOAD
    }
};
template <class T, class = void> struct has_rs_lds : std::false_type {};
template <class T> struct has_rs_lds<T, std::void_t<decltype(T::RS_LDS)>> : std::true_type {};
template <class Epi, class Desc, bool ALIGN_EPI = false, bool SP2 = false>
__device__ __forceinline__ void gemm_phase(PG8_LAS unsigned char* lds, const Desc& S, const Epi& E, const int tid) {
    const int wid = __builtin_amdgcn_readfirstlane(tid >> 6), lane = tid & 63, wr = wid >> 2, wc = wid & 3, fr = lane & 15, fq = lane >> 4;
    const int K = S.K, nt = K / BK, lda = S.lda, ldb = S.ldb;
    unsigned voffA[2], voffB[2];
#pragma unroll
    for (int i = 0; i < 2; ++i) { int R, C; stage_rc(tid * 16 + i * 8192, R, C); const int Rb = Epi::PERM ? ((R & ~31) + perm32(R & 31)) : R;
        voffA[i] = (unsigned)(R * lda + C) * 2u; voffB[i] = (unsigned)(Rb * ldb + C) * 2u; }
    const size_t kstep = (size_t)(BK * 2);
    const size_t hstepA = (size_t)HALF * lda * 2, hstepB = (size_t)HALF * ldb * 2;
    const unsigned ldsw = (unsigned)wid * 1024u;
    const int aoff = lds_byte(wr * 64 + fr, fq * 8), boff = lds_byte(wc * 32 + fr, fq * 8);
#define PG8_SA(b, h) (((b) * 2 + (h)) * HTB)
#define PG8_SB(b, h) ((4 + (b) * 2 + (h)) * HTB)
#define PG8_STAGE(bufoff, gbase, voff) do { _Pragma("unroll") for (int _i = 0; _i < 2; ++_i) \
        __builtin_amdgcn_global_load_lds((const PG8_GAS unsigned*)((const PG8_GAS char*)(gbase) + (voff)[_i]), (PG8_LAS unsigned*)(lds + (bufoff) + ldsw + _i * 8192), 16, 0, 0); } while (0)
#define PG8_LDA(dst, b, h) do { _Pragma("unroll") for (int m = 0; m < 4; ++m) _Pragma("unroll") for (int k = 0; k < 2; ++k) dst[m][k] = *(const PG8_LAS bf16x8*)(lds + PG8_SA(b, h) + aoff + m * 2048 + k * 1024); } while (0)
#define PG8_LDB(dst, b, h) do { _Pragma("unroll") for (int n = 0; n < 2; ++n) _Pragma("unroll") for (int k = 0; k < 2; ++k) dst[n][k] = *(const PG8_LAS bf16x8*)(lds + PG8_SB(b, h) + boff + n * 2048 + k * 1024); } while (0)
#define PG8_MMA(ai, bj, At, Bt) do { __builtin_amdgcn_s_setprio(1); _Pragma("unroll") for (int m = 0; m < 4; ++m) _Pragma("unroll") for (int n = 0; n < 2; ++n) _Pragma("unroll") for (int k = 0; k < 2; ++k) \
        acc[ai][bj][m][n] = __builtin_amdgcn_mfma_f32_16x16x32_bf16(Bt[n][k], At[m][k], acc[ai][bj][m][n], 0, 0, 0); __builtin_amdgcn_s_setprio(0); } while (0)
#define PG8_WAIT_V(n) asm volatile("s_waitcnt vmcnt(" #n ")" ::: "memory")
#define PG8_WAIT_L(n) asm volatile("s_waitcnt lgkmcnt(" #n ")" ::: "memory")
#define PG8_BAR __builtin_amdgcn_s_barrier()
#define PG8_SCHED __builtin_amdgcn_sched_barrier(0)
    Unit cur, nxt; int ui = 0;
    if (!S.next(0, cur)) return;
    if constexpr (has_rs_lds<Epi>::value) { const PG8_GAS float* rb_ = E.rs_base(cur); if (rb_ != nullptr && wid == 0) __builtin_amdgcn_global_load_lds((const PG8_GAS unsigned*)(rb_ + lane * 4), (PG8_LAS unsigned*)(lds + STAGE_BYTES), 16, 0, 0); }
    f32x4 acc[2][2][4][2];
#pragma unroll
    for (int a = 0; a < 2; ++a)
#pragma unroll
        for (int b = 0; b < 2; ++b)
#pragma unroll
            for (int m = 0; m < 4; ++m)
#pragma unroll
                for (int n = 0; n < 2; ++n) acc[a][b][m][n] = (f32x4){0.f, 0.f, 0.f, 0.f};
    bf16x8 At[4][2], B0[2][2], B1[2][2];
    const PG8_GAS char* cA = (const PG8_GAS char*)S.a_ptr(cur); const PG8_GAS char* cB = (const PG8_GAS char*)S.b_ptr(cur);
    S.a_ready(cur);
    if constexpr (SP2) {
        PG8_STAGE(PG8_SB(0, 0), cB, voffB); PG8_STAGE(PG8_SB(0, 1), cB + hstepB, voffB); PG8_STAGE(PG8_SA(0, 0), cA, voffA); PG8_STAGE(PG8_SA(0, 1), cA + hstepA, voffA);
        if (wr == 1) PG8_BAR;
        PG8_WAIT_V(2); PG8_BAR;
        PG8_STAGE(PG8_SB(1, 0), cB + kstep, voffB); PG8_STAGE(PG8_SA(1, 0), cA + kstep, voffA); PG8_STAGE(PG8_SB(1, 1), cB + hstepB + kstep, voffB);
        PG8_WAIT_V(6); PG8_BAR;
    } else {
        PG8_STAGE(PG8_SB(0, 0), cB, voffB); PG8_STAGE(PG8_SA(0, 0), cA, voffA); PG8_STAGE(PG8_SB(0, 1), cB + hstepB, voffB); PG8_STAGE(PG8_SA(0, 1), cA + hstepA, voffA);
        if (wr == 1) PG8_BAR;
        PG8_WAIT_V(4); PG8_BAR;
        PG8_STAGE(PG8_SB(1, 0), cB + kstep, voffB); PG8_STAGE(PG8_SA(1, 0), cA + kstep, voffA); PG8_STAGE(PG8_SB(1, 1), cB + hstepB + kstep, voffB);
        PG8_WAIT_V(6); PG8_BAR;
    }
    for (;;) {
        const bool has_next = S.next(ui + 1, nxt);
        const PG8_GAS char* nA = has_next ? (const PG8_GAS char*)S.a_ptr(nxt) : cA; const PG8_GAS char* nB = has_next ? (const PG8_GAS char*)S.b_ptr(nxt) : cB;
        for (int t = 0; t < nt; t += 2) {
            const bool last = (t == nt - 2);
            const PG8_GAS char* a1 = cA + (size_t)(t + 1) * kstep;
            const PG8_GAS char* a2 = last ? nA : cA + (size_t)(t + 2) * kstep; const PG8_GAS char* b2 = last ? nB : cB + (size_t)(t + 2) * kstep;
            const PG8_GAS char* a3 = a2 + kstep; const PG8_GAS char* b3 = b2 + kstep;
            if (last && has_next) S.a_ready(nxt);
            if constexpr (Epi::MID_T > 0) { if (t == Epi::MID_T) E.mid(acc, cur, wr, wc, fr, fq); }
            if constexpr (SP2) {
            PG8_LDB(B0, 0, 0); PG8_LDB(B1, 0, 1); PG8_SCHED; PG8_LDA(At, 0, 0); PG8_STAGE(PG8_SA(1, 1), a1 + hstepA, voffA);
            PG8_WAIT_V(8); PG8_WAIT_L(0); PG8_BAR; PG8_MMA(0, 0, At, B0); PG8_MMA(0, 1, At, B1); PG8_BAR; PG8_SCHED;
            PG8_LDA(At, 0, 1); PG8_STAGE(PG8_SB(0, 0), b2, voffB); PG8_STAGE(PG8_SB(0, 1), b2 + hstepB, voffB); PG8_STAGE(PG8_SA(0, 0), a2, voffA);
            PG8_WAIT_V(8); PG8_WAIT_L(0); PG8_BAR; PG8_MMA(1, 0, At, B0); PG8_MMA(1, 1, At, B1); PG8_BAR; PG8_SCHED;
            PG8_LDB(B0, 1, 0); PG8_LDB(B1, 1, 1); PG8_SCHED; PG8_LDA(At, 1, 0); PG8_STAGE(PG8_SA(0, 1), a2 + hstepA, voffA);
            PG8_WAIT_V(8); PG8_WAIT_L(0); PG8_BAR; PG8_MMA(0, 0, At, B0); PG8_MMA(0, 1, At, B1); PG8_BAR; PG8_SCHED;
            PG8_LDA(At, 1, 1); PG8_STAGE(PG8_SB(1, 0), b3, voffB); PG8_STAGE(PG8_SB(1, 1), b3 + hstepB, voffB); PG8_STAGE(PG8_SA(1, 0), a3, voffA);
            PG8_WAIT_V(8); PG8_WAIT_L(0); PG8_BAR; PG8_MMA(1, 0, At, B0); PG8_MMA(1, 1, At, B1); PG8_BAR; PG8_SCHED;
            } else {
            PG8_LDB(B0, 0, 0); PG8_SCHED; PG8_LDA(At, 0, 0); PG8_STAGE(PG8_SA(1, 1), a1 + hstepA, voffA);
            PG8_WAIT_L(8); PG8_BAR; PG8_WAIT_L(0); PG8_MMA(0, 0, At, B0); PG8_BAR; PG8_SCHED;
            PG8_LDB(B1, 0, 1); PG8_STAGE(PG8_SB(0, 0), b2, voffB);
            PG8_BAR; PG8_WAIT_L(0); PG8_MMA(0, 1, At, B1); PG8_BAR;
            PG8_LDA(At, 0, 1); PG8_STAGE(PG8_SA(0, 0), a2, voffA);
            PG8_BAR; PG8_WAIT_L(0); PG8_MMA(1, 0, At, B0); PG8_BAR; PG8_SCHED;
            PG8_STAGE(PG8_SB(0, 1), b2 + hstepB, voffB);
            PG8_WAIT_V(6); PG8_BAR; PG8_MMA(1, 1, At, B1); PG8_BAR;
            PG8_LDB(B0, 1, 0); PG8_SCHED; PG8_LDA(At, 1, 0); PG8_STAGE(PG8_SA(0, 1), a2 + hstepA, voffA);
            PG8_WAIT_L(8); PG8_BAR; PG8_WAIT_L(0); PG8_MMA(0, 0, At, B0); PG8_BAR; PG8_SCHED;
            PG8_LDB(B1, 1, 1); PG8_STAGE(PG8_SB(1, 0), b3, voffB);
            PG8_BAR; PG8_WAIT_L(0); PG8_MMA(0, 1, At, B1); PG8_BAR;
            PG8_LDA(At, 1, 1); PG8_STAGE(PG8_SA(1, 0), a3, voffA);
            PG8_BAR; PG8_WAIT_L(0); PG8_MMA(1, 0, At, B0); PG8_BAR; PG8_SCHED;
            PG8_STAGE(PG8_SB(1, 1), b3 + hstepB, voffB);
            PG8_WAIT_V(6); PG8_BAR; PG8_MMA(1, 1, At, B1); PG8_BAR;
            }
        }
        if constexpr (ALIGN_EPI) { if (wr == 0) PG8_BAR; }
        if constexpr (has_rs_lds<Epi>::value) { E(acc, cur, wr, wc, fr, fq, (const PG8_LAS float*)(lds + STAGE_BYTES + (ui & 1) * 1024)); S.done(cur); } else
        if constexpr (!Epi::AFTER_DRAIN) { E(acc, cur, wr, wc, fr, fq); S.done(cur); }
        if (!has_next) break;
#pragma unroll
        for (int a = 0; a < 2; ++a)
#pragma unroll
            for (int b = 0; b < 2; ++b)
#pragma unroll
                for (int m = 0; m < 4; ++m)
#pragma unroll
                    for (int n = 0; n < 2; ++n) acc[a][b][m][n] = (f32x4){0.f, 0.f, 0.f, 0.f};
        cur = nxt; cA = nA; cB = nB; ++ui;
        if constexpr (has_rs_lds<Epi>::value) { const PG8_GAS float* rb_ = E.rs_base(cur); if (rb_ != nullptr && wid == 0) __builtin_amdgcn_global_load_lds((const PG8_GAS unsigned*)(rb_ + lane * 4), (PG8_LAS unsigned*)(lds + STAGE_BYTES + (ui & 1) * 1024), 16, 0, 0); }
        if constexpr (ALIGN_EPI) { if (wr == 1) PG8_BAR; }
    }
    PG8_WAIT_V(0);
    if constexpr (!ALIGN_EPI) { if (wr == 0) PG8_BAR; }
    PG8_BAR;
    if constexpr (Epi::AFTER_DRAIN) { E.fused(acc, cur, wr, wc, fr, fq, lds, wid, lane); S.done(cur); }
#undef PG8_SA
#undef PG8_SB
#undef PG8_STAGE
#undef PG8_LDA
#undef PG8_LDB
#undef PG8_MMA
#undef PG8_WAIT_V
#undef PG8_WAIT_L
#undef PG8_BAR
#undef PG8_SCHED
}
}

namespace att {
typedef short bf16x8 __attribute__((ext_vector_type(8)));
typedef short s16x4 __attribute__((ext_vector_type(4)));
typedef float f32x16 __attribute__((ext_vector_type(16)));
typedef float f32x8v __attribute__((ext_vector_type(8)));
typedef unsigned u32x4 __attribute__((ext_vector_type(4)));
constexpr int D = 128, NW = 8, QBLK = 32, KVBLK = 64;
constexpr float SCALE = 0.088388347648318440f, LOG2E = 1.4426950408889634f, CS = SCALE * LOG2E;
constexpr int SHM_V = KVBLK * D * 2, SHM_K = KVBLK * D * 2;
constexpr int OFF_V = 0, OFF_K = 2 * SHM_V, OFF_WS = 2 * SHM_V + 2 * SHM_K, OFF_MISC = OFF_WS + NW * 256;
constexpr int OFF_Q = OFF_MISC + 256, OFF_PREF = OFF_Q + NW * 8192, ATT_LDS = OFF_PREF + 516 * 4 + 512 * 4;
constexpr int ATT_LDS_OLD = OFF_PREF;
#define KSWZ(row, colB) ((row) * 256 + ((colB) ^ (((row) & 7) << 4)))
#define SBAR() __builtin_amdgcn_sched_barrier(0)
__device__ __forceinline__ int crow(int r, int hi) { return (r & 3) + 8 * (r >> 2) + 4 * hi; }
__device__ __forceinline__ unsigned cvtpk(float lo, float hi) { unsigned r; asm volatile("v_cvt_pk_bf16_f32 %0, %1, %2" : "=v"(r) : "v"(lo), "v"(hi)); return r; }
__device__ __forceinline__ int v_st(int k, int c) { const int kk = (k & ~0xC) | ((k & 4) << 1) | ((k & 8) >> 1); return ((kk >> 3) * 4 + (c >> 5)) * 512 + ((kk & 7) * 32 + (c & 31)) * 2; }
__device__ __forceinline__ int v_rd_base(int lane) { return ((lane & 3) << 3) | (((lane >> 2) & 3) << 6) | (((lane >> 4) & 1) << 5) | (((lane >> 5) & 1) << 8); }
constexpr int v_rd_off(int d0, int ks, int half) { return d0 * 512 + ks * 4096 + half * 2048; }
template <int OFF> __device__ __forceinline__ s16x4 tr_read(int vb) { s16x4 r; asm volatile("ds_read_b64_tr_b16 %0, %1 offset:%2" : "=&v"(r) : "v"(vb), "i"(OFF) : "memory"); return r; }
template <int D0> __device__ __forceinline__ void pv_one(f32x16& od, int vb, bf16x8 pa0, bf16x8 pa1, bf16x8 pa2, bf16x8 pa3) {
  const s16x4 l0 = tr_read<v_rd_off(D0, 0, 0)>(vb), h0 = tr_read<v_rd_off(D0, 0, 1)>(vb), l1 = tr_read<v_rd_off(D0, 1, 0)>(vb), h1 = tr_read<v_rd_off(D0, 1, 1)>(vb);
  const s16x4 l2 = tr_read<v_rd_off(D0, 2, 0)>(vb), h2 = tr_read<v_rd_off(D0, 2, 1)>(vb), l3 = tr_read<v_rd_off(D0, 3, 0)>(vb), h3 = tr_read<v_rd_off(D0, 3, 1)>(vb);
  asm volatile("s_waitcnt lgkmcnt(0)" ::: "memory"); SBAR();
#define PK(L, H) (bf16x8){L[0], L[1], L[2], L[3], H[0], H[1], H[2], H[3]}
  od = __builtin_amdgcn_mfma_f32_32x32x16_bf16(pa0, PK(l0, h0), od, 0, 0, 0);
  od = __builtin_amdgcn_mfma_f32_32x32x16_bf16(pa1, PK(l1, h1), od, 0, 0, 0);
  od = __builtin_amdgcn_mfma_f32_32x32x16_bf16(pa2, PK(l2, h2), od, 0, 0, 0);
  od = __builtin_amdgcn_mfma_f32_32x32x16_bf16(pa3, PK(l3, h3), od, 0, 0, 0);
#undef PK
}
__device__ __forceinline__ void pv_d0(f32x16* o, int vb, bf16x8 pa0, bf16x8 pa1, bf16x8 pa2, bf16x8 pa3) {
  pv_one<0>(o[0], vb, pa0, pa1, pa2, pa3); pv_one<1>(o[1], vb, pa0, pa1, pa2, pa3); pv_one<2>(o[2], vb, pa0, pa1, pa2, pa3); pv_one<3>(o[3], vb, pa0, pa1, pa2, pa3);
}
__device__ __forceinline__ void qkt(f32x16& p0, f32x16& p1, const char* Ks, const char* Qs, int r32, int hi) {
  p0 = f32x16{}; p1 = f32x16{};
#pragma unroll
  for (int d0 = 0; d0 < 8; ++d0) { const int cb = (d0 * 16 + hi * 8) * 2;
    const bf16x8 b0 = *reinterpret_cast<const bf16x8*>(Ks + KSWZ(r32, cb));
    const bf16x8 b1 = *reinterpret_cast<const bf16x8*>(Ks + KSWZ(32 + r32, cb));
    const bf16x8 q = *reinterpret_cast<const bf16x8*>(Qs + KSWZ(r32, cb));
    p0 = __builtin_amdgcn_mfma_f32_32x32x16_bf16(b0, q, p0, 0, 0, 0);
    p1 = __builtin_amdgcn_mfma_f32_32x32x16_bf16(b1, q, p1, 0, 0, 0); }
}
struct TileInfo { float a0, a1; int diag; };
__device__ __forceinline__ void partialSM(f32x16& p0, f32x16& p1, const TileInfo& ti, float sl2, int rowq, int hi) {
#pragma unroll
  for (int r = 0; r < 16; ++r) { const float kc = (float)((r & 3) + 8 * (r >> 2)); p0[r] = fmaf(sl2, kc, fmaf(p0[r], CS, ti.a0)); p1[r] = fmaf(sl2, kc, fmaf(p1[r], CS, ti.a1)); }
  if (ti.diag >= 0) {
    const int k0 = ti.diag + 4 * hi;
#pragma unroll
    for (int r = 0; r < 16; ++r) { const int kq = k0 + (r & 3) + 8 * (r >> 2); if (kq > rowq) p0[r] = -INFINITY; if (kq + 32 > rowq) p1[r] = -INFINITY; }
  }
#pragma unroll
  for (int r = 0; r < 16; ++r) p0[r] = __builtin_amdgcn_exp2f(p0[r]);
}
__device__ __forceinline__ void finishSM(f32x16& p0, f32x16& p1, float& l_reg, bf16x8& pa0, bf16x8& pa1, bf16x8& pa2, bf16x8& pa3) {
#pragma unroll
  for (int r = 0; r < 16; ++r) p1[r] = __builtin_amdgcn_exp2f(p1[r]);
  float ps = 0;
#pragma unroll
  for (int r = 0; r < 16; ++r) ps += p0[r];
#pragma unroll
  for (int r = 0; r < 16; ++r) ps += p1[r];
  { auto rr = __builtin_amdgcn_permlane32_swap(__float_as_uint(ps), __float_as_uint(ps), false, false);
    ps = __uint_as_float(rr[0]) + __uint_as_float(rr[1]); }
  l_reg += ps;
#define PK4(P, BASE, OUT) do { unsigned a0 = cvtpk(P[BASE + 0], P[BASE + 1]), a1 = cvtpk(P[BASE + 2], P[BASE + 3]);   \
    unsigned b0 = cvtpk(P[BASE + 4], P[BASE + 5]), b1 = cvtpk(P[BASE + 6], P[BASE + 7]);                              \
    auto r0 = __builtin_amdgcn_permlane32_swap(a0, b0, false, false); auto r1 = __builtin_amdgcn_permlane32_swap(a1, b1, false, false); \
    u32x4 w = {r0[0], r1[0], r0[1], r1[1]}; OUT = *reinterpret_cast<bf16x8*>(&w); } while (0)
  PK4(p0, 0, pa0); PK4(p0, 8, pa1); PK4(p1, 0, pa2); PK4(p1, 8, pa3);
#undef PK4
}
#define TOP3_INS(v, i) do { const float v_ = (v); const int i_ = (i); \
    const bool b1_ = v_ > t1 || (v_ == t1 && i_ < i1), b2_ = v_ > t2 || (v_ == t2 && i_ < i2), b3_ = v_ > t3 || (v_ == t3 && i_ < i3); \
    if (b1_) { t3 = t2; i3 = i2; t2 = t1; i2 = i1; t1 = v_; i1 = i_; } else if (b2_) { t3 = t2; i3 = i2; t2 = v_; i2 = i_; } else if (b3_) { t3 = v_; i3 = i_; } } while (0)

__device__ __forceinline__ void attn_unit(int b, int h, int cur, const __attribute__((address_space(1))) unsigned short* __restrict__ QKN, int ldq, int cq, int ck, const __attribute__((address_space(1))) unsigned short* __restrict__ PROJ, int ldp, int cv, int seq, const __attribute__((address_space(1))) float* __restrict__ kmean,
                                          __attribute__((address_space(1))) unsigned short* __restrict__ OA, int ldo, char* lds, int tid, int wpast, float smax2) {
  const int wid = __builtin_amdgcn_readfirstlane(tid >> 6), lane = tid & 63, r32 = lane & 31, hi = lane >> 5;
  char* V_lds = lds + OFF_V; char* K_lds = lds + OFF_K;
  float* wsf = (float*)(lds + OFF_WS) + wid * 64; float* li_l = wsf; float* al_l = wsf + 32;
  volatile int* misc = (volatile int*)(lds + OFF_MISC);
  const float slope = exp2f(-(float)(h + 1)), sl2 = slope * LOG2E;
  const int rowq = wid * QBLK + r32;
  float l_reg = 0; f32x16 o[4] = {};
  const float negm = -(smax2 + sl2 * (float)rowq);
  char* Q_lds = lds + OFF_Q + wid * 8192;
  __syncthreads();
  { const __attribute__((address_space(1))) unsigned short* Qw = QKN + ((size_t)b * seq + cur * 256 + rowq) * ldq + cq + h * D + hi * 8;
#pragma unroll
    for (int d0 = 0; d0 < 8; ++d0) { const bf16x8 qv = *(const __attribute__((address_space(1))) bf16x8*)(Qw + d0 * 16); *reinterpret_cast<bf16x8*>(Q_lds + KSWZ(r32, (d0 * 16 + hi * 8) * 2)) = qv; } }
  asm volatile("s_waitcnt lgkmcnt(0)" ::: "memory");
  unsigned selmask = 0u;
  if (cur > 0) {
    f32x16 g = {};
    const __attribute__((address_space(1))) float* km = kmean + ((size_t)(b * 8 + h) * 32 + r32) * D + hi * 8;
#pragma unroll
    for (int d0 = 0; d0 < 8; ++d0) { const f32x8v x = *(const __attribute__((address_space(1))) f32x8v*)(km + d0 * 16);
      u32x4 wh = {cvtpk(x[0], x[1]), cvtpk(x[2], x[3]), cvtpk(x[4], x[5]), cvtpk(x[6], x[7])};
      float rl[8];
#pragma unroll
      for (int k = 0; k < 4; ++k) { rl[2 * k] = x[2 * k] - __uint_as_float(wh[k] << 16); rl[2 * k + 1] = x[2 * k + 1] - __uint_as_float(wh[k] & 0xffff0000u); }
      u32x4 wl = {cvtpk(rl[0], rl[1]), cvtpk(rl[2], rl[3]), cvtpk(rl[4], rl[5]), cvtpk(rl[6], rl[7])};
      const bf16x8 q = *reinterpret_cast<const bf16x8*>(Q_lds + KSWZ(r32, (d0 * 16 + hi * 8) * 2));
      g = __builtin_amdgcn_mfma_f32_32x32x16_bf16(*reinterpret_cast<bf16x8*>(&wh), q, g, 0, 0, 0);
      g = __builtin_amdgcn_mfma_f32_32x32x16_bf16(*reinterpret_cast<bf16x8*>(&wl), q, g, 0, 0, 0); }
    float t1 = -INFINITY, t2 = -INFINITY, t3 = -INFINITY; int i1 = 64, i2 = 65, i3 = 66;
#pragma unroll
    for (int r = 0; r < 16; ++r) { const int n = crow(r, hi); const float v = n < cur ? g[r] : -INFINITY; TOP3_INS(v, n); }
#define PARTNER_F(x) ({ const auto rr_ = __builtin_amdgcn_permlane32_swap(__float_as_uint(x), __float_as_uint(x), false, false); __uint_as_float(hi ? rr_[0] : rr_[1]); })
#define PARTNER_I(x) ({ const auto rr_ = __builtin_amdgcn_permlane32_swap((unsigned)(x), (unsigned)(x), false, false); (int)(hi ? rr_[0] : rr_[1]); })
    const float u1 = PARTNER_F(t1), u2 = PARTNER_F(t2), u3 = PARTNER_F(t3); const int j1 = PARTNER_I(i1), j2 = PARTNER_I(i2), j3 = PARTNER_I(i3);
#undef PARTNER_F
#undef PARTNER_I
    TOP3_INS(u1, j1); TOP3_INS(u2, j2); TOP3_INS(u3, j3);
    if (t1 > -INFINITY) selmask |= 1u << i1; if (t2 > -INFINITY) selmask |= 1u << i2; if (t3 > -INFINITY) selmask |= 1u << i3;
  }
  if (tid == 0) misc[0] = 0;
  __syncthreads();
  { unsigned wm = selmask;
    wm |= (unsigned)__builtin_amdgcn_ds_swizzle((int)wm, (1 << 10) | 0x1f); wm |= (unsigned)__builtin_amdgcn_ds_swizzle((int)wm, (2 << 10) | 0x1f); wm |= (unsigned)__builtin_amdgcn_ds_swizzle((int)wm, (4 << 10) | 0x1f);
    wm |= (unsigned)__builtin_amdgcn_ds_swizzle((int)wm, (8 << 10) | 0x1f); wm |= (unsigned)__builtin_amdgcn_ds_swizzle((int)wm, (16 << 10) | 0x1f);
    { const auto rr_ = __builtin_amdgcn_permlane32_swap(wm, wm, false, false); wm = rr_[0] | rr_[1]; }
    if (lane == 0 && wm) atomicOr((unsigned*)&misc[0], wm); }
  __syncthreads();
  if (tid == 0) { const unsigned any = (unsigned)misc[0]; int cnt = 0; const int nmin = cur - wpast > 0 ? cur - wpast : 0;
    for (int n = cur - 1; n >= nmin; --n) if ((any >> n) & 1u) { misc[4 + cnt] = n; ++cnt; }
    misc[1] = cnt; }
  __syncthreads();
  const int NT = 4 * (1 + __builtin_amdgcn_readfirstlane(misc[1]));
  const __attribute__((address_space(1))) unsigned short* Kh = QKN + (size_t)b * seq * ldq + ck + h * D; const __attribute__((address_space(1))) unsigned short* Vh = PROJ + (size_t)b * seq * ldp + cv + h * D;
  const int sr = tid >> 4, sc = (tid & 15) * 8, vst0 = v_st(sr, sc), vst1 = v_st(32 + sr, sc);
  const int vb0 = (int)(uintptr_t)V_lds + v_rd_base(lane);
  struct { bf16x8 vs0, vs1, ks0, ks1; } sr_[2];
#define TKEY(j) ((j) < 4 ? cur * 256 + (j) * 64 : __builtin_amdgcn_readfirstlane(misc[4 + (((j) - 4) >> 2)]) * 256 + ((j) & 3) * 64)
#define TINFO(ti, j) do { const int j_ = (j); int kp_; if (j_ < 4) { kp_ = j_ * 64; ti.a0 = sl2 * (float)(kp_ + 4 * hi) + negm; \
        ti.diag = (j_ * 64 + 63 > wid * QBLK) ? j_ * 64 : -1; }     \
      else { const int n_ = __builtin_amdgcn_readfirstlane(misc[4 + ((j_ - 4) >> 2)]); kp_ = (n_ - cur) * 256 + (j_ & 3) * 64; ti.a0 = ((selmask >> n_) & 1u) ? sl2 * (float)(kp_ + 4 * hi) + negm : -INFINITY; ti.diag = -1; } \
      ti.a1 = ti.a0 + 32.f * sl2; } while (0)
#define SLOAD(i, k0) do { const size_t k0_ = (size_t)(k0); sr_[i].vs0 = *(const __attribute__((address_space(1))) bf16x8*)(&Vh[(k0_ + sr) * ldp + sc]); sr_[i].vs1 = *(const __attribute__((address_space(1))) bf16x8*)(&Vh[(k0_ + 32 + sr) * ldp + sc]); \
    sr_[i].ks0 = *(const __attribute__((address_space(1))) bf16x8*)(&Kh[(k0_ + sr) * ldq + sc]); sr_[i].ks1 = *(const __attribute__((address_space(1))) bf16x8*)(&Kh[(k0_ + 32 + sr) * ldq + sc]); } while (0)
#define SWRITE(bb, i) do { *(bf16x8*)(V_lds + (bb) * SHM_V + vst0) = sr_[i].vs0; *(bf16x8*)(V_lds + (bb) * SHM_V + vst1) = sr_[i].vs1; const int kc = sc * 2; \
    *(bf16x8*)(K_lds + (bb) * SHM_K + KSWZ(sr, kc)) = sr_[i].ks0; *(bf16x8*)(K_lds + (bb) * SHM_K + KSWZ(32 + sr, kc)) = sr_[i].ks1; } while (0)
#define SWAIT() asm volatile("s_waitcnt vmcnt(4)" ::: "memory")
  f32x16 pA0, pA1, pB0, pB1; bf16x8 pa0, pa1, pa2, pa3; TileInfo tiA, tiB;
  constexpr int SE = 0, SO = 1;
  SLOAD(SE, TKEY(0)); asm volatile("s_waitcnt vmcnt(0)" ::: "memory"); SWRITE(0, SE); __syncthreads();
  qkt(pA0, pA1, K_lds, Q_lds, r32, hi); TINFO(tiA, 0); partialSM(pA0, pA1, tiA, sl2, rowq, hi);
  SLOAD(SO, TKEY(1)); SLOAD(SE, TKEY(2));
  SWAIT(); SWRITE(1, SO); __syncthreads();
  for (int j = 1; j + 1 < NT; j += 2) {
    SBAR(); qkt(pB0, pB1, K_lds + SHM_K, Q_lds, r32, hi);
    finishSM(pA0, pA1, l_reg, pa0, pa1, pa2, pa3); SBAR();
    SLOAD(SO, TKEY(j + 2 < NT ? j + 2 : j)); SBAR();
    pv_d0(o, vb0, pa0, pa1, pa2, pa3); TINFO(tiB, j); partialSM(pB0, pB1, tiB, sl2, rowq, hi);
    __syncthreads(); SWAIT(); SWRITE(0, SE);
    __syncthreads();
    SBAR(); qkt(pA0, pA1, K_lds, Q_lds, r32, hi);
    finishSM(pB0, pB1, l_reg, pa0, pa1, pa2, pa3); SBAR();
    SLOAD(SE, TKEY(j + 3 < NT ? j + 3 : j)); SBAR();
    pv_d0(o, vb0 + SHM_V, pa0, pa1, pa2, pa3); TINFO(tiA, j + 1); partialSM(pA0, pA1, tiA, sl2, rowq, hi);
    __syncthreads(); SWAIT(); SWRITE(1, SO);
    __syncthreads();
  }
  SBAR(); qkt(pB0, pB1, K_lds + SHM_K, Q_lds, r32, hi);
  finishSM(pA0, pA1, l_reg, pa0, pa1, pa2, pa3); SBAR();
  pv_d0(o, vb0, pa0, pa1, pa2, pa3); TINFO(tiB, NT - 1); partialSM(pB0, pB1, tiB, sl2, rowq, hi);
  __syncthreads();
  finishSM(pB0, pB1, l_reg, pa0, pa1, pa2, pa3); SBAR();
  pv_d0(o, vb0 + SHM_V, pa0, pa1, pa2, pa3);
  asm volatile("s_waitcnt vmcnt(0)" ::: "memory");
  if (hi == 0) li_l[r32] = l_reg; asm volatile("s_waitcnt lgkmcnt(0)" ::: "memory");
  __attribute__((address_space(1))) unsigned short* Ow = OA + ((size_t)b * seq + cur * 256 + wid * QBLK) * ldo + h * D;
#pragma unroll
  for (int r = 0; r < 16; ++r) { const int orow = crow(r, hi); const float rli = __builtin_amdgcn_rcpf(li_l[orow]);
#pragma unroll
    for (int d0 = 0; d0 < 4; ++d0) { const float v = o[d0][r] * rli; unsigned u = __float_as_uint(v); u = (u + 0x7fffu + ((u >> 16) & 1u)) >> 16; Ow[(size_t)orow * ldo + d0 * 32 + r32] = (unsigned short)u; } }
#undef TKEY
#undef TINFO
#undef SLOAD
#undef SWRITE
#undef SWAIT
}
constexpr int LIST_CAP = 8192;
__device__ __forceinline__ void attn_select(int b, int h, int cur, int wv, const __attribute__((address_space(1))) unsigned short* __restrict__ QKN, int ldq, int seq,
                                            const __attribute__((address_space(1))) float* __restrict__ kmean, __attribute__((address_space(1))) unsigned short* __restrict__ LIST,
                                            __attribute__((address_space(1))) unsigned* __restrict__ LCNT, __attribute__((address_space(1))) float* __restrict__ PL, int mtot, int lane, int wpast) {
  const int r32 = lane & 31, hi = lane >> 5, t = cur * 256 + wv * 32 + r32;
  bf16x8 qr[8];
  { const __attribute__((address_space(1))) unsigned short* Qw = QKN + ((size_t)b * seq + t) * ldq + h * D + hi * 8;
#pragma unroll
    for (int d0 = 0; d0 < 8; ++d0) qr[d0] = *(const __attribute__((address_space(1))) bf16x8*)(Qw + d0 * 16); }
  f32x16 g = {};
  const __attribute__((address_space(1))) float* km = kmean + ((size_t)(b * 8 + h) * 32 + r32) * D + hi * 8;
#pragma unroll
  for (int d0 = 0; d0 < 8; ++d0) { const f32x8v x = *(const __attribute__((address_space(1))) f32x8v*)(km + d0 * 16);
    u32x4 wh = {cvtpk(x[0], x[1]), cvtpk(x[2], x[3]), cvtpk(x[4], x[5]), cvtpk(x[6], x[7])};
    float rl[8];
#pragma unroll
    for (int k = 0; k < 4; ++k) { rl[2 * k] = x[2 * k] - __uint_as_float(wh[k] << 16); rl[2 * k + 1] = x[2 * k + 1] - __uint_as_float(wh[k] & 0xffff0000u); }
    u32x4 wl = {cvtpk(rl[0], rl[1]), cvtpk(rl[2], rl[3]), cvtpk(rl[4], rl[5]), cvtpk(rl[6], rl[7])};
    g = __builtin_amdgcn_mfma_f32_32x32x16_bf16(*reinterpret_cast<bf16x8*>(&wh), qr[d0], g, 0, 0, 0);
    g = __builtin_amdgcn_mfma_f32_32x32x16_bf16(*reinterpret_cast<bf16x8*>(&wl), qr[d0], g, 0, 0, 0); }
  float t1 = -INFINITY, t2 = -INFINITY, t3 = -INFINITY; int i1 = 64, i2 = 65, i3 = 66;
#pragma unroll
  for (int r = 0; r < 16; ++r) { const int n = crow(r, hi); const float v = n < cur ? g[r] : -INFINITY; TOP3_INS(v, n); }
#define PARTNER_F(x) ({ const auto rr_ = __builtin_amdgcn_permlane32_swap(__float_as_uint(x), __float_as_uint(x), false, false); __uint_as_float(hi ? rr_[0] : rr_[1]); })
#define PARTNER_I(x) ({ const auto rr_ = __builtin_amdgcn_permlane32_swap((unsigned)(x), (unsigned)(x), false, false); (int)(hi ? rr_[0] : rr_[1]); })
  const float u1 = PARTNER_F(t1), u2 = PARTNER_F(t2), u3 = PARTNER_F(t3); const int j1 = PARTNER_I(i1), j2 = PARTNER_I(i2), j3 = PARTNER_I(i3);
#undef PARTNER_F
#undef PARTNER_I
  TOP3_INS(u1, j1); TOP3_INS(u2, j2); TOP3_INS(u3, j3);
  const int nmin = cur - wpast > 0 ? cur - wpast : 0;
  const bool v1 = t1 > -INFINITY && i1 >= nmin, v2 = t2 > -INFINITY && i2 >= nmin, v3 = t3 > -INFINITY && i3 >= nmin;
  const size_t m = (size_t)b * seq + t;
  if (hi == 0) { if (!v1) PL[((size_t)0 * mtot + m) * 8 + h] = 0.f; if (!v2) PL[((size_t)1 * mtot + m) * 8 + h] = 0.f; if (!v3) PL[((size_t)2 * mtot + m) * 8 + h] = 0.f; }
  unsigned mycnt = 0u;
  for (int n = nmin; n < cur; ++n) { const bool sel = hi == 0 && ((v1 && i1 == n) || (v2 && i2 == n) || (v3 && i3 == n)); const unsigned long long mask = __ballot(sel); if (lane == n) mycnt = (unsigned)__popcll(mask); }
  unsigned mybase = 0u;
  if (mycnt) mybase = __hip_atomic_fetch_add(LCNT + (b * 8 + h) * 32 + lane, mycnt, __ATOMIC_RELAXED, __HIP_MEMORY_SCOPE_AGENT);
  for (int n = nmin; n < cur; ++n) {
    const bool s1 = v1 && i1 == n, s2 = v2 && i2 == n, s3 = v3 && i3 == n, sel = hi == 0 && (s1 || s2 || s3);
    const unsigned long long mask = __ballot(sel);
    const unsigned base = (unsigned)__builtin_amdgcn_readlane((int)mybase, n);
    if (sel) { const unsigned rank = __builtin_amdgcn_mbcnt_hi((unsigned)(mask >> 32), __builtin_amdgcn_mbcnt_lo((unsigned)mask, 0u));
      LIST[(size_t)((b * 8 + h) * 32 + n) * LIST_CAP + base + rank] = (unsigned short)(t | ((s1 ? 0 : s2 ? 1 : 2) << 13)); }
  }
}
__device__ __forceinline__ void attn_block_unit(bool own, int b, int h, int kb, int c0, int cnt, const __attribute__((address_space(1))) unsigned short* __restrict__ LIST,
                                                const __attribute__((address_space(1))) unsigned short* __restrict__ QKN, int ldq, int ck, const __attribute__((address_space(1))) unsigned short* __restrict__ PROJ, int ldp, int cv, int seq,
                                                __attribute__((address_space(1))) unsigned short* __restrict__ P01, __attribute__((address_space(1))) unsigned short* __restrict__ P23,
                                                __attribute__((address_space(1))) float* __restrict__ PL, int mtot, char* lds, int tid, float smax2) {
  const int wid = __builtin_amdgcn_readfirstlane(tid >> 6), lane = tid & 63, r32 = lane & 31, hi = lane >> 5;
  char* V_lds = lds + OFF_V; char* K_lds = lds + OFF_K;
  float* wsf = (float*)(lds + OFF_WS) + wid * 64; float* li_l = wsf; int* tj_l = (int*)(wsf + 32);
  const float slope = exp2f(-(float)(h + 1)), sl2 = slope * LOG2E;
  const int rowq = wid * QBLK + r32;
  const int kpos0 = kb * 256;
  const __attribute__((address_space(1))) unsigned short* Kh = QKN + ((size_t)b * seq + kpos0) * ldq + ck + h * D; const __attribute__((address_space(1))) unsigned short* Vh = PROJ + ((size_t)b * seq + kpos0) * ldp + cv + h * D;
  const int sr = tid >> 4, sc = (tid & 15) * 8, vst0 = v_st(sr, sc), vst1 = v_st(32 + sr, sc);
  const int vb0 = (int)(uintptr_t)V_lds + v_rd_base(lane);
  struct { bf16x8 vs0, vs1, ks0, ks1; } sr_[2];
#define SLOAD(i, k0) do { const size_t k0_ = (size_t)(k0); sr_[i].vs0 = *(const __attribute__((address_space(1))) bf16x8*)(&Vh[(k0_ + sr) * ldp + sc]); sr_[i].vs1 = *(const __attribute__((address_space(1))) bf16x8*)(&Vh[(k0_ + 32 + sr) * ldp + sc]); \
    sr_[i].ks0 = *(const __attribute__((address_space(1))) bf16x8*)(&Kh[(k0_ + sr) * ldq + sc]); sr_[i].ks1 = *(const __attribute__((address_space(1))) bf16x8*)(&Kh[(k0_ + 32 + sr) * ldq + sc]); } while (0)
  int trow, slot; bool valid = true;
  if (own) { trow = kb * 256 + rowq; slot = 3; }
  else { const int idx = c0 + rowq; valid = idx < cnt; const int e = valid ? (int)LIST[(size_t)((b * 8 + h) * 32 + kb) * LIST_CAP + idx] : ((kb + 1) * 256); trow = e & 8191; slot = valid ? (e >> 13) : 0; }
  SLOAD(0, 0);
  bf16x8 qv[8];
  { const __attribute__((address_space(1))) unsigned short* Qw = QKN + ((size_t)b * seq + trow) * ldq + h * D + hi * 8;
#pragma unroll
    for (int d0 = 0; d0 < 8; ++d0) qv[d0] = *(const __attribute__((address_space(1))) bf16x8*)(Qw + d0 * 16); }
  float l_reg = 0; f32x16 o[4] = {};
  char* Q_lds = lds + OFF_Q + wid * 8192;
  __syncthreads();
#pragma unroll
  for (int d0 = 0; d0 < 8; ++d0) *reinterpret_cast<bf16x8*>(Q_lds + KSWZ(r32, (d0 * 16 + hi * 8) * 2)) = qv[d0];
  if (hi == 0) tj_l[r32] = valid ? ((slot << 16) | trow) : -1;
  asm volatile("s_waitcnt lgkmcnt(0)" ::: "memory");
  const float abase = -smax2 - sl2 * (float)(trow - kpos0 - 4 * hi);
#define BTINFO(ti, j) do { ti.a0 = abase + sl2 * (float)(64 * (j)); ti.a1 = ti.a0 + 32.f * sl2; ti.diag = (own && ((j) * 64 + 63 > wid * QBLK)) ? (j) * 64 : -1; } while (0)
#define SWRITE(bb, i) do { *(bf16x8*)(V_lds + (bb) * SHM_V + vst0) = sr_[i].vs0; *(bf16x8*)(V_lds + (bb) * SHM_V + vst1) = sr_[i].vs1; const int kc = sc * 2; \
    *(bf16x8*)(K_lds + (bb) * SHM_K + KSWZ(sr, kc)) = sr_[i].ks0; *(bf16x8*)(K_lds + (bb) * SHM_K + KSWZ(32 + sr, kc)) = sr_[i].ks1; } while (0)
  f32x16 pA0, pA1, pB0, pB1; bf16x8 pa0, pa1, pa2, pa3; TileInfo tiA, tiB;
  asm volatile("s_waitcnt vmcnt(0)" ::: "memory"); SWRITE(0, 0); __syncthreads();
  qkt(pA0, pA1, K_lds, Q_lds, r32, hi); BTINFO(tiA, 0); partialSM(pA0, pA1, tiA, sl2, rowq, hi);
  SLOAD(1, 64); SLOAD(0, 128);
  asm volatile("s_waitcnt vmcnt(4)" ::: "memory"); SWRITE(1, 1); __syncthreads();
  SBAR(); qkt(pB0, pB1, K_lds + SHM_K, Q_lds, r32, hi);
  finishSM(pA0, pA1, l_reg, pa0, pa1, pa2, pa3); SBAR();
  SLOAD(1, 192); SBAR();
  pv_d0(o, vb0, pa0, pa1, pa2, pa3); BTINFO(tiB, 1); partialSM(pB0, pB1, tiB, sl2, rowq, hi);
  __syncthreads(); asm volatile("s_waitcnt vmcnt(4)" ::: "memory"); SWRITE(0, 0);
  __syncthreads();
  SBAR(); qkt(pA0, pA1, K_lds, Q_lds, r32, hi);
  finishSM(pB0, pB1, l_reg, pa0, pa1, pa2, pa3); SBAR();
  pv_d0(o, vb0 + SHM_V, pa0, pa1, pa2, pa3); BTINFO(tiA, 2); partialSM(pA0, pA1, tiA, sl2, rowq, hi);
  __syncthreads(); asm volatile("s_waitcnt vmcnt(0)" ::: "memory"); SWRITE(1, 1);
  __syncthreads();
  SBAR(); qkt(pB0, pB1, K_lds + SHM_K, Q_lds, r32, hi);
  finishSM(pA0, pA1, l_reg, pa0, pa1, pa2, pa3); SBAR();
  pv_d0(o, vb0, pa0, pa1, pa2, pa3); BTINFO(tiB, 3); partialSM(pB0, pB1, tiB, sl2, rowq, hi);
  finishSM(pB0, pB1, l_reg, pa0, pa1, pa2, pa3); SBAR();
  pv_d0(o, vb0 + SHM_V, pa0, pa1, pa2, pa3);
  if (hi == 0) li_l[r32] = l_reg; asm volatile("s_waitcnt lgkmcnt(0)" ::: "memory");
  if (hi == 0 && valid) { PL[((size_t)slot * mtot + (size_t)b * seq + trow) * 8 + h] = l_reg;
    if (own && kb == 0) { const size_t m_ = (size_t)b * seq + trow; PL[((size_t)0 * mtot + m_) * 8 + h] = 0.f; PL[((size_t)1 * mtot + m_) * 8 + h] = 0.f; PL[((size_t)2 * mtot + m_) * 8 + h] = 0.f; } }
#pragma unroll
  for (int r = 0; r < 16; ++r) { const int orow = crow(r, hi); const int e = tj_l[orow]; const float lv = li_l[orow]; const float rli = lv > 0.f ? __builtin_amdgcn_rcpf(lv) : 0.f;
    if (e >= 0) { const int sl = e >> 16; __attribute__((address_space(1))) unsigned short* Ow = (sl < 2 ? P01 : P23) + ((size_t)(sl & 1) * mtot + (size_t)b * seq + (e & 0xffff)) * 1024 + h * D;
#pragma unroll
      for (int d0 = 0; d0 < 4; ++d0) { const float v = o[d0][r] * rli; unsigned u = __float_as_uint(v); u = (u + 0x7fffu + ((u >> 16) & 1u)) >> 16; Ow[d0 * 32 + r32] = (unsigned short)u; } } }
#undef BTINFO
#undef SLOAD
#undef SWRITE
}
__device__ __forceinline__ void qkt_r(f32x16& p0, f32x16& p1, const char* Ks, const bf16x8* qr, int r32, int hi) {
  p0 = f32x16{}; p1 = f32x16{};
#pragma unroll
  for (int d0 = 0; d0 < 8; ++d0) { const int cb = (d0 * 16 + hi * 8) * 2;
    const bf16x8 b0 = *reinterpret_cast<const bf16x8*>(Ks + KSWZ(r32, cb));
    const bf16x8 b1 = *reinterpret_cast<const bf16x8*>(Ks + KSWZ(32 + r32, cb));
    p0 = __builtin_amdgcn_mfma_f32_32x32x16_bf16(b0, qr[d0], p0, 0, 0, 0);
    p1 = __builtin_amdgcn_mfma_f32_32x32x16_bf16(b1, qr[d0], p1, 0, 0, 0); }
}
constexpr int KV4_V = 0, KV4_K = 4 * SHM_V, KV4_WS = 4 * SHM_V + 4 * SHM_K, KV4_END = KV4_WS + NW * 256;
__device__ __forceinline__ void attn_kv_unit(int b, int h, int kb, int seg0, int segn, bool with_own, const __attribute__((address_space(1))) unsigned short* __restrict__ LIST,
                                             const __attribute__((address_space(1))) unsigned short* __restrict__ QKN, int ldq, int ck, const __attribute__((address_space(1))) unsigned short* __restrict__ PROJ, int ldp, int cv, int seq,
                                             __attribute__((address_space(1))) unsigned short* __restrict__ P01, __attribute__((address_space(1))) unsigned short* __restrict__ P23,
                                             __attribute__((address_space(1))) float* __restrict__ PL, int mtot, char* lds, int tid, float smax2) {
  const int wid = __builtin_amdgcn_readfirstlane(tid >> 6), lane = tid & 63, r32 = lane & 31, hi = lane >> 5;
  char* V_lds = lds + KV4_V; char* K_lds = lds + KV4_K;
  float* wsf = (float*)(lds + KV4_WS) + wid * 64; float* li_l = wsf; int* tj_l = (int*)(wsf + 32);
  const float slope = exp2f(-(float)(h + 1)), sl2 = slope * LOG2E;
  const int kpos0 = kb * 256;
  {
    const __attribute__((address_space(1))) unsigned short* Kh = QKN + ((size_t)b * seq + kpos0) * ldq + ck + h * D; const __attribute__((address_space(1))) unsigned short* Vh = PROJ + ((size_t)b * seq + kpos0) * ldp + cv + h * D;
    const int sr = tid >> 4, sc = (tid & 15) * 8, vst0 = v_st(sr, sc), vst1 = v_st(32 + sr, sc), kc = sc * 2;
    bf16x8 kv[4][4];
#pragma unroll
    for (int t = 0; t < 4; ++t) { const size_t k0 = (size_t)(t * 64);
      kv[t][0] = *(const __attribute__((address_space(1))) bf16x8*)(&Vh[(k0 + sr) * ldp + sc]); kv[t][1] = *(const __attribute__((address_space(1))) bf16x8*)(&Vh[(k0 + 32 + sr) * ldp + sc]);
      kv[t][2] = *(const __attribute__((address_space(1))) bf16x8*)(&Kh[(k0 + sr) * ldq + sc]); kv[t][3] = *(const __attribute__((address_space(1))) bf16x8*)(&Kh[(k0 + 32 + sr) * ldq + sc]); }
    __syncthreads();
#pragma unroll
    for (int t = 0; t < 4; ++t) {
      *(bf16x8*)(V_lds + t * SHM_V + vst0) = kv[t][0]; *(bf16x8*)(V_lds + t * SHM_V + vst1) = kv[t][1];
      *(bf16x8*)(K_lds + t * SHM_K + KSWZ(sr, kc)) = kv[t][2]; *(bf16x8*)(K_lds + t * SHM_K + KSWZ(32 + sr, kc)) = kv[t][3]; }
    __syncthreads();
  }
  const int vb0 = (int)(uintptr_t)V_lds + v_rd_base(lane);
  const int nown = with_own ? 8 : 0, ngr = nown + ((segn + 31) >> 5);
#define GRAW(gg, raw, isv) do { raw = 0; isv = true; if ((gg) >= nown) { const int idx_ = seg0 + ((gg) - nown) * 32 + r32; isv = idx_ < seg0 + segn; \
    if (isv) raw = (int)LIST[(size_t)((b * 8 + h) * 32 + kb) * LIST_CAP + idx_]; } } while (0)
#define GDEC(gg, raw, isv, e) do { asm volatile("" : "+v"(raw)); e = (gg) < nown ? ((kpos0 + (gg) * 32 + r32) | (3 << 13) | (1 << 16)) : (isv ? (raw | (1 << 16)) : (kpos0 + 256)); } while (0)
#define LOADQ(e) do { const __attribute__((address_space(1))) unsigned short* Qw_ = QKN + ((size_t)b * seq + ((e) & 8191)) * ldq + h * D + hi * 8; \
    _Pragma("unroll") for (int d0 = 0; d0 < 8; ++d0) qr[d0] = *(const __attribute__((address_space(1))) bf16x8*)(Qw_ + d0 * 16); } while (0)
  int e_cur = 0; bf16x8 qr[8];
  if (wid < ngr) { int raw0_; bool isv0_; GRAW(wid, raw0_, isv0_); GDEC(wid, raw0_, isv0_, e_cur); LOADQ(e_cur); }
  __builtin_amdgcn_s_waitcnt(0x0F70);
  for (int g = wid; g < ngr; g += NW) {
    const bool own = g < nown, has_n = g + NW < ngr;
    int raw_n = 0, e_nxt = 0; bool isv_n = true; if (has_n) GRAW(g + NW, raw_n, isv_n);
    const int trow = e_cur & 8191, slot = (e_cur >> 13) & 3; const bool valid = ((e_cur >> 16) & 1) != 0;
    const int rowq = own ? g * 32 + r32 : 1 << 20;
    const float abase = -smax2 - sl2 * (float)(trow - kpos0 - 4 * hi);
    float l_reg = 0; f32x16 o[4] = {};
    const int nt = own ? (g * 32 + 31) / 64 + 1 : 4;
    f32x16 pA0, pA1, pB0, pB1; bf16x8 pa0, pa1, pa2, pa3; TileInfo ti;
#define KTI(j) do { ti.a0 = abase + sl2 * (float)(64 * (j)); ti.a1 = ti.a0 + 32.f * sl2; ti.diag = (own && ((j) * 64 + 63 > g * 32)) ? (j) * 64 : -1; } while (0)
    qkt_r(pA0, pA1, K_lds, qr, r32, hi); KTI(0); partialSM(pA0, pA1, ti, sl2, rowq, hi);
    if (nt > 1) { SBAR(); qkt_r(pB0, pB1, K_lds + SHM_K, qr, r32, hi); }
    finishSM(pA0, pA1, l_reg, pa0, pa1, pa2, pa3); SBAR();
    pv_d0(o, vb0, pa0, pa1, pa2, pa3);
    if (nt > 1) {
      KTI(1); partialSM(pB0, pB1, ti, sl2, rowq, hi);
      if (nt > 2) { SBAR(); qkt_r(pA0, pA1, K_lds + 2 * SHM_K, qr, r32, hi); }
      finishSM(pB0, pB1, l_reg, pa0, pa1, pa2, pa3); SBAR();
      pv_d0(o, vb0 + SHM_V, pa0, pa1, pa2, pa3);
      if (nt > 2) {
        KTI(2); partialSM(pA0, pA1, ti, sl2, rowq, hi);
        if (nt > 3) { SBAR(); qkt_r(pB0, pB1, K_lds + 3 * SHM_K, qr, r32, hi); if (has_n) { GDEC(g + NW, raw_n, isv_n, e_nxt); LOADQ(e_nxt); } }
        finishSM(pA0, pA1, l_reg, pa0, pa1, pa2, pa3); SBAR();
        pv_d0(o, vb0 + 2 * SHM_V, pa0, pa1, pa2, pa3);
        if (nt > 3) {
          KTI(3); partialSM(pB0, pB1, ti, sl2, rowq, hi);
          finishSM(pB0, pB1, l_reg, pa0, pa1, pa2, pa3); SBAR();
          pv_d0(o, vb0 + 3 * SHM_V, pa0, pa1, pa2, pa3);
        }
      }
    }
#undef KTI
    if (nt < 4 && has_n) { GDEC(g + NW, raw_n, isv_n, e_nxt); LOADQ(e_nxt); }
    __builtin_amdgcn_s_waitcnt(0x0F70);
    if (hi == 0) { li_l[r32] = l_reg; tj_l[r32] = valid ? ((slot << 16) | trow) : -1; }
    asm volatile("s_waitcnt lgkmcnt(0)" ::: "memory");
    if (hi == 0 && valid) { const size_t m_ = (size_t)b * seq + trow; PL[((size_t)slot * mtot + m_) * 8 + h] = l_reg;
      if (own && kb == 0) { PL[((size_t)0 * mtot + m_) * 8 + h] = 0.f; PL[((size_t)1 * mtot + m_) * 8 + h] = 0.f; PL[((size_t)2 * mtot + m_) * 8 + h] = 0.f; } }
#pragma unroll
    for (int r = 0; r < 16; ++r) { const int orow = crow(r, hi); const int e = tj_l[orow]; const float lv = li_l[orow]; const float rli = lv > 0.f ? __builtin_amdgcn_rcpf(lv) : 0.f;
      if (e >= 0) { const int sl = e >> 16; __attribute__((address_space(1))) unsigned short* Ow = (sl < 2 ? P01 : P23) + ((size_t)(sl & 1) * mtot + (size_t)b * seq + (e & 0xffff)) * 1024 + h * D;
#pragma unroll
        for (int d0 = 0; d0 < 4; ++d0) { const float v = o[d0][r] * rli; unsigned u = __float_as_uint(v); u = (u + 0x7fffu + ((u >> 16) & 1u)) >> 16; Ow[d0 * 32 + r32] = (unsigned short)u; } } }
    asm volatile("s_waitcnt lgkmcnt(0)" ::: "memory");
    e_cur = e_nxt;
  }
#undef GRAW
#undef GDEC
#undef LOADQ
}
#undef KSWZ
#undef SBAR
#undef TOP3_INS
}

#ifndef DBG_ATT
#define DBG_ATT 0
#endif
#ifndef MK_ONE_LAUNCH
#define MK_ONE_LAUNCH 1
#endif
#ifndef PG8_SP2
#define PG8_SP2 true
#endif
#ifndef PG8_ALIGN
#define PG8_ALIGN true
#endif
constexpr int NWAVES = 8;
constexpr int BATCH = 2, SEQ = 8192, DM = 2048, DEPTH = 4;
constexpr int M = BATCH * SEQ;
constexpr int AH = 8, AD = 128, AW = 1024, MB = 256, NBLK = SEQ / MB;
constexpr int RH = 4, RDK = 256, RDV = 512;
constexpr int DFF = 5632, NIN = 13312;
constexpr int LDP = 9216, NNAT = 11264, NSWP = 2048;
constexpr int C_QA = 0, C_KA = 1024, C_VA = 2048, C_GR = 3072, C_GA = 5120, C_GT = 7168;
constexpr float EPS = 1e-6f;
constexpr int NPH = 12;
constexpr int NPHASES = DEPTH * NPH;

constexpr size_t MiB = 1u << 20;
constexpr size_t WS_CTL = 0, CTL_ZERO_BYTES = 128 * 1024;
constexpr size_t WS_KMEAN = 1 * MiB;
constexpr size_t WS_W0 = 2 * MiB, WS_W1 = 1232 * MiB;
constexpr size_t WS_WNAT = 0 * MiB, WS_WSWP = 44 * MiB, WS_WOA = 56 * MiB, WS_WOUT = 68 * MiB, WS_WFI = 76 * MiB, WS_WFO = 120 * MiB;
constexpr size_t WS_H = 144 * MiB;
constexpr size_t WS_PROJ = 208 * MiB;
constexpr size_t WS_OA = 496 * MiB, WS_ORR = 528 * MiB, WS_MRG = 592 * MiB, WS_T = 656 * MiB, WS_RET = 784 * MiB;
constexpr size_t WS_ST = WS_T;
constexpr size_t WS_AQ = 912 * MiB;
constexpr size_t WS_BQ = 976 * MiB;
constexpr size_t WS_KB = 1104 * MiB, WS_KTB = 1136 * MiB, WS_QKN = 1168 * MiB, WS_LIST = 1376 * MiB, WS_PL = 1384 * MiB, WS_PS = 1386 * MiB, WS_RS = 1394 * MiB, WS_END = 1395 * MiB;
constexpr size_t WS_P01 = 720 * MiB, WS_P23 = 592 * MiB;
constexpr int CW_BAR = 4096, CW_ATTQ = 8192, CW_DBG = 12288, CW_CVQ = 16384, CW_SCQ = 16384 + 256, CW_LCNT = 20480;

constexpr int RING_OFF = 0, RING_BYTES = 131072;
constexpr int LDS_BYTES = 147456;
constexpr int LDSCTL_OFF = LDS_BYTES - 1024, MISC_OFF = LDSCTL_OFF + 320;

#define GAS __attribute__((address_space(1)))
#define LAS __attribute__((address_space(3)))
typedef unsigned short bf16;
typedef unsigned v4u __attribute__((ext_vector_type(4)));
typedef float f32x4 __attribute__((ext_vector_type(4)));
typedef short bf16x8 __attribute__((ext_vector_type(8)));
typedef GAS unsigned gu32;
typedef GAS unsigned long long gu64;
#define RLX_AGENT __ATOMIC_RELAXED, __HIP_MEMORY_SCOPE_AGENT
#define LDS_WAIT() asm volatile("s_waitcnt lgkmcnt(0)" ::: "memory")
#define VM_WAIT() asm volatile("s_waitcnt vmcnt(0)" ::: "memory")
__device__ __forceinline__ unsigned long long rt() { return __builtin_amdgcn_s_memrealtime(); }
__device__ __forceinline__ unsigned f2bf(float f) { unsigned u = __builtin_bit_cast(unsigned, f); return (u + 0x7fffu + ((u >> 16) & 1u)) >> 16; }
__device__ __forceinline__ unsigned pk2(float lo, float hi) { return f2bf(lo) | (f2bf(hi) << 16); }

#define XB_TMO      128
#define XB_XCNT(j)  (256  + 64 * (j))
#define XB_XSUB(j)  (1280 + 64 * (j))
#define XB_XGEN(j)  (2304 + 64 * (j))
#define XB_TOP      3328
#define XB_TOPGEN   3392
#define XCD_BAR_WORDS 3456
#define XB_SPIN_CAP (1u << 22)

__device__ __forceinline__ unsigned xb_ld(unsigned* p)              { return __hip_atomic_load(p, __ATOMIC_RELAXED, __HIP_MEMORY_SCOPE_AGENT); }
__device__ __forceinline__ unsigned xb_add(unsigned* p, unsigned v) { return __hip_atomic_fetch_add(p, v, __ATOMIC_RELAXED, __HIP_MEMORY_SCOPE_AGENT); }
__device__ __forceinline__ unsigned xb_xcc_id() { return (unsigned)__builtin_amdgcn_s_getreg((3 << 11) | 20) & 0xFu; }
#define XB_SPIN(cond, bar) do { unsigned _sp = 0; while (cond) { __builtin_amdgcn_s_sleep(1); \
    if ((++_sp & 255u) == 0u) { if (xb_ld(&(bar)[XB_TMO])) break; if (_sp > XB_SPIN_CAP) { atomicAdd(&(bar)[XB_TMO], 1u); break; } } } } while (0)

struct XcdBarrier {
    unsigned* bar; unsigned x;
    volatile LAS unsigned* st;
};

__device__ __forceinline__ XcdBarrier xcd_barrier_post(unsigned* bar, volatile LAS unsigned* st) {
    XcdBarrier b; b.bar = bar; b.x = xb_xcc_id(); b.st = st;
    if (threadIdx.x == 0) (void)xb_add(&bar[XB_XCNT(b.x)], 1u);
    return b;
}
__device__ __forceinline__ void xcd_barrier_complete(unsigned* bar, unsigned x, unsigned& nloc, unsigned& nx) {
    const unsigned G = gridDim.x * gridDim.y * gridDim.z;
    unsigned sum, cnt, mine, sp = 0u;
    for (;;) {
        sum = 0u; cnt = 0u; mine = 0u;
#pragma unroll
        for (unsigned j = 0; j < 16; ++j) { const unsigned c = xb_ld(&bar[XB_XCNT(j)]); sum += c; cnt += (c > 0u) ? 1u : 0u; mine = (j == x) ? c : mine; }
        if (sum == G) break;
        __builtin_amdgcn_s_sleep(1);
        if ((++sp & 255u) == 0u) { if (xb_ld(&bar[XB_TMO])) break; if (sp > XB_SPIN_CAP) { atomicAdd(&bar[XB_TMO], 1u); break; } }
    }
    nloc = mine > 0u ? mine : 1u; nx = cnt > 0u ? cnt : 1u;
}

__device__ __forceinline__ void xcd_barrier(const XcdBarrier& b) {
    asm volatile("s_waitcnt vmcnt(0)" ::: "memory");
    __syncthreads();
    if (threadIdx.x == 0) {
        unsigned* bar = b.bar;
        __builtin_amdgcn_s_waitcnt(0);
        unsigned nloc = b.st[0], nx = b.st[1];
        if (nloc == 0u) { xcd_barrier_complete(bar, b.x, nloc, nx); b.st[0] = nloc; b.st[1] = nx; }
        const unsigned old = xb_add(&bar[XB_XSUB(b.x)], 1u);
        const unsigned gen = old / nloc;
        if (old + 1u == (gen + 1u) * nloc) {
            __builtin_amdgcn_fence(__ATOMIC_RELEASE, "agent");
            asm volatile("s_waitcnt vmcnt(0)" ::: "memory");
            const unsigned og = xb_add(&bar[XB_TOP], 1u);
            const unsigned tg = og / nx;
            if (og + 1u == (tg + 1u) * nx) xb_add(&bar[XB_TOPGEN], 1u);
            else XB_SPIN(xb_ld(&bar[XB_TOPGEN]) == tg, bar);
            __builtin_amdgcn_fence(__ATOMIC_ACQUIRE, "agent");
            xb_add(&bar[XB_XGEN(b.x)], 1u);
            asm volatile("s_waitcnt vmcnt(0)" ::: "memory");
        } else {
            XB_SPIN(xb_ld(&bar[XB_XGEN(b.x)]) == gen, bar);
            __builtin_amdgcn_fence(__ATOMIC_ACQUIRE, "agent");
            asm volatile("s_waitcnt vmcnt(0)" ::: "memory");
        }
    }
    __syncthreads();
}

struct Frame {
    LAS unsigned char* lds;
    volatile LAS unsigned* MISC;
    gu32* ctl;
    int tid, lane, wave;
    int vcu, G;
};
#define SWZ_XOR(v, m) __builtin_amdgcn_ds_swizzle((v), ((m) << 10) | 0x1f)
__device__ __forceinline__ float wave_sum(float v) {
    v += __int_as_float(SWZ_XOR(__float_as_int(v), 1)); v += __int_as_float(SWZ_XOR(__float_as_int(v), 2)); v += __int_as_float(SWZ_XOR(__float_as_int(v), 4));
    v += __int_as_float(SWZ_XOR(__float_as_int(v), 8)); v += __int_as_float(SWZ_XOR(__float_as_int(v), 16));
    const auto rr = __builtin_amdgcn_permlane32_swap(__float_as_uint(v), __float_as_uint(v), false, false);
    return __uint_as_float(rr[0]) + __uint_as_float(rr[1]);
}
__device__ __forceinline__ float wave_max(float v) {
    v = fmaxf(v, __int_as_float(SWZ_XOR(__float_as_int(v), 1))); v = fmaxf(v, __int_as_float(SWZ_XOR(__float_as_int(v), 2))); v = fmaxf(v, __int_as_float(SWZ_XOR(__float_as_int(v), 4)));
    v = fmaxf(v, __int_as_float(SWZ_XOR(__float_as_int(v), 8))); v = fmaxf(v, __int_as_float(SWZ_XOR(__float_as_int(v), 16)));
    const auto rr = __builtin_amdgcn_permlane32_swap(__float_as_uint(v), __float_as_uint(v), false, false);
    return fmaxf(__uint_as_float(rr[0]), __uint_as_float(rr[1]));
}
__device__ __forceinline__ unsigned wave_or(unsigned v) {
    v |= (unsigned)SWZ_XOR((int)v, 1); v |= (unsigned)SWZ_XOR((int)v, 2); v |= (unsigned)SWZ_XOR((int)v, 4); v |= (unsigned)SWZ_XOR((int)v, 8); v |= (unsigned)SWZ_XOR((int)v, 16);
    const auto rr = __builtin_amdgcn_permlane32_swap(v, v, false, false);
    return rr[0] | rr[1];
}
__device__ __forceinline__ float bf2f(bf16 b) { return __uint_as_float(((unsigned)b) << 16); }
__device__ __forceinline__ float blo(unsigned w) { return __uint_as_float(w << 16); }
__device__ __forceinline__ float bhi(unsigned w) { return __uint_as_float(w & 0xffff0000u); }

__device__ __forceinline__ void transpose_item(const GAS float* W, int K, int N, int k0, int n0, GAS bf16* WT, int dst_row0, GAS bf16* WT2, int dst2_row0, int ldw, int kofs, LAS float* scr, int lane, const GAS float* gain) {
    const int lr = lane >> 4, lc = (lane & 15) * 4;
    f32x4 v[16];
    const GAS float* src = W + (size_t)(k0 + lr) * N + n0 + lc;
#pragma unroll
    for (int i = 0; i < 16; ++i) v[i] = *(const GAS f32x4*)(src + (size_t)(4 * i) * N);
    if (gain) {
#pragma unroll
        for (int i = 0; i < 16; ++i) { const float gk = gain[k0 + lr + 4 * i]; v[i] = v[i] * gk; } }
#pragma unroll
    for (int i = 0; i < 16; ++i) { LAS float* d = scr + (4 * i + lr) * 65 + lc; d[0] = v[i].x; d[1] = v[i].y; d[2] = v[i].z; d[3] = v[i].w; }
    LDS_WAIT(); asm volatile("" ::: "memory");
    const int kc = lane & 7;
#pragma unroll
    for (int j = 0; j < 8; ++j) { const int n = (lane >> 3) + 8 * j; const LAS float* s = scr + (8 * kc) * 65 + n;
        v4u o; o.x = pk2(s[0 * 65], s[1 * 65]); o.y = pk2(s[2 * 65], s[3 * 65]); o.z = pk2(s[4 * 65], s[5 * 65]); o.w = pk2(s[6 * 65], s[7 * 65]);
        if (WT) *(GAS v4u*)(WT + (size_t)(dst_row0 + n) * ldw + kofs + k0 + 8 * kc) = o;
        if (WT2) *(GAS v4u*)(WT2 + (size_t)(dst2_row0 + n) * ldw + kofs + k0 + 8 * kc) = o; }
    LDS_WAIT(); asm volatile("" ::: "memory");
}
constexpr int I_IN = (DM / 64) * (NIN / 64), I_OA = (AW / 64) * (DM / 64), I_OR = (2048 / 64) * (DM / 64), I_OUT = (DM / 64) * (DM / 64), I_FI = (DM / 64) * (2 * DFF / 64), I_FO = (DFF / 64) * (DM / 64);
constexpr int NCONV = I_IN + I_OA + I_OR + I_OUT + I_FI + I_FO;
static_assert(NCONV % 8 == 0, "conversion items are dealt eight at a time");
__device__ __forceinline__ void convert_item(Frame& F, const float* const* in, int lw, unsigned char* wset, int it) {
    LAS float* scr = (LAS float*)(F.lds + RING_OFF + F.wave * 16896);
    const GAS float* W; int K, N, mode = 0, ldw, kofs = 0; GAS bf16* WT; GAS bf16* WT2 = nullptr; const GAS float* gain = nullptr;
    if (it < I_IN) { W = (const GAS float*)in[1] + (size_t)lw * DM * NIN; K = DM; N = NIN; mode = 2; gain = (const GAS float*)in[7] + (size_t)lw * DM; WT = (GAS bf16*)(wset + WS_WNAT); WT2 = (GAS bf16*)(wset + WS_WSWP); ldw = DM; }
    else if ((it -= I_IN) < I_OA) { W = (const GAS float*)in[2] + (size_t)lw * AW * DM; K = AW; N = DM; WT = (GAS bf16*)(wset + WS_WOA); ldw = 3072; }
    else if ((it -= I_OA) < I_OR) { W = (const GAS float*)in[3] + (size_t)lw * 2048 * DM; K = 2048; N = DM; WT = (GAS bf16*)(wset + WS_WOA); ldw = 3072; kofs = 1024; }
    else if ((it -= I_OR) < I_OUT) { W = (const GAS float*)in[4] + (size_t)lw * DM * DM; K = DM; N = DM; WT = (GAS bf16*)(wset + WS_WOUT); ldw = DM; }
    else if ((it -= I_OUT) < I_FI) { W = (const GAS float*)in[9] + (size_t)lw * DM * 2 * DFF; K = DM; N = 2 * DFF; mode = 1; gain = (const GAS float*)in[8] + (size_t)lw * DM; WT = (GAS bf16*)(wset + WS_WFI); ldw = DM; }
    else { it -= I_FI; W = (const GAS float*)in[10] + (size_t)lw * DFF * DM; K = DFF; N = DM; WT = (GAS bf16*)(wset + WS_WFO); ldw = DFF; }
    const int nblk = N / 64, kb = it / nblk, nb = it % nblk, k0 = 64 * kb, n0 = 64 * nb;
    int dst = n0, dst2 = 0; GAS bf16* w1 = WT; GAS bf16* w2 = nullptr;
    if (mode == 1) { const int isu = n0 >= DFF ? 1 : 0; const int j = n0 - isu * DFF; dst = (j / 128) * 256 + isu * 128 + (j % 128); }
    if (mode == 2) {
        if (n0 < 3072) dst = n0; else if (n0 < 4096) dst = n0 - 3072 + 9216; else if (n0 < 5120) dst = n0 - 4096 + 10240;
        else if (n0 < 7168) { w1 = nullptr; w2 = WT2; dst2 = n0 - 5120; } else dst = n0 - 7168 + 3072; }
    transpose_item(W, K, N, k0, n0, w1, dst, w2, dst2, ldw, kofs, scr, F.lane, gain);
}
__device__ __forceinline__ void rmsnorm_phase(Frame& F, const GAS float* x, const GAS float* g, GAS bf16* out) {
    const int gw = F.vcu * NWAVES + F.wave, NGW = F.G * NWAVES;
    for (int m = gw; m < M; m += 2 * NGW) {
        const bool two = m + NGW < M; const int m1 = two ? m + NGW : m;
        const GAS f32x4* xr0 = (const GAS f32x4*)(x + (size_t)m * DM) + F.lane; const GAS f32x4* xr1 = (const GAS f32x4*)(x + (size_t)m1 * DM) + F.lane;
        f32x4 v0[8], v1[8]; float s0 = 0.f, s1 = 0.f;
#pragma unroll
        for (int j = 0; j < 8; ++j) v0[j] = xr0[64 * j];
#pragma unroll
        for (int j = 0; j < 8; ++j) v1[j] = xr1[64 * j];
#pragma unroll
        for (int j = 0; j < 8; ++j) { s0 += (v0[j].x * v0[j].x + v0[j].y * v0[j].y) + (v0[j].z * v0[j].z + v0[j].w * v0[j].w); s1 += (v1[j].x * v1[j].x + v1[j].y * v1[j].y) + (v1[j].z * v1[j].z + v1[j].w * v1[j].w); }
        const float rstd0 = 1.0f / sqrtf(wave_sum(s0) * (1.f / DM) + EPS), rstd1 = 1.0f / sqrtf(wave_sum(s1) * (1.f / DM) + EPS);
        GAS unsigned long long* o0 = (GAS unsigned long long*)(out + (size_t)m * DM) + F.lane; GAS unsigned long long* o1 = (GAS unsigned long long*)(out + (size_t)m1 * DM) + F.lane;
#pragma unroll
        for (int j = 0; j < 8; ++j) { const f32x4 gg = ((const GAS f32x4*)g)[F.lane + 64 * j];
            o0[64 * j] = (unsigned long long)pk2(v0[j].x * rstd0 * gg.x, v0[j].y * rstd0 * gg.y) | ((unsigned long long)pk2(v0[j].z * rstd0 * gg.z, v0[j].w * rstd0 * gg.w) << 32);
            if (two) o1[64 * j] = (unsigned long long)pk2(v1[j].x * rstd1 * gg.x, v1[j].y * rstd1 * gg.y) | ((unsigned long long)pk2(v1[j].z * rstd1 * gg.z, v1[j].w * rstd1 * gg.w) << 32); }
    }
}
__device__ __forceinline__ float rms_ssq4(const v4u (&w)[4]) { float s = 0.f;
#pragma unroll
    for (int j = 0; j < 4; ++j) s += (blo(w[j].x) * blo(w[j].x) + bhi(w[j].x) * bhi(w[j].x)) + (blo(w[j].y) * blo(w[j].y) + bhi(w[j].y) * bhi(w[j].y)) + (blo(w[j].z) * blo(w[j].z) + bhi(w[j].z) * bhi(w[j].z)) + (blo(w[j].w) * blo(w[j].w) + bhi(w[j].w) * bhi(w[j].w));
    return s; }
__device__ __forceinline__ void rms_store4(const v4u (&w)[4], float rstd, const GAS float* g, GAS bf16* orow, int lane) {
    GAS v4u* o = (GAS v4u*)orow + lane;
#pragma unroll
    for (int j = 0; j < 4; ++j) { const f32x4 g0 = ((const GAS f32x4*)g)[2 * (lane + 64 * j)], g1 = ((const GAS f32x4*)g)[2 * (lane + 64 * j) + 1];
        v4u r; r.x = pk2(blo(w[j].x) * rstd * g0.x, bhi(w[j].x) * rstd * g0.y); r.y = pk2(blo(w[j].y) * rstd * g0.z, bhi(w[j].y) * rstd * g0.w);
        r.z = pk2(blo(w[j].z) * rstd * g1.x, bhi(w[j].z) * rstd * g1.y); r.w = pk2(blo(w[j].w) * rstd * g1.z, bhi(w[j].w) * rstd * g1.w);
        o[64 * j] = r; }
}
__device__ __forceinline__ void rmsnorm_bf16_phase(Frame& F, const GAS bf16* x, const GAS float* g, GAS bf16* out) {
    const int gw = F.vcu * NWAVES + F.wave, NGW = F.G * NWAVES;
    for (int m = gw; m < M; m += 2 * NGW) {
        const bool two = m + NGW < M; const int m1 = two ? m + NGW : m;
        const GAS v4u* xr0 = (const GAS v4u*)(x + (size_t)m * DM) + F.lane; const GAS v4u* xr1 = (const GAS v4u*)(x + (size_t)m1 * DM) + F.lane;
        v4u w0[4], w1[4];
#pragma unroll
        for (int j = 0; j < 4; ++j) w0[j] = xr0[64 * j];
#pragma unroll
        for (int j = 0; j < 4; ++j) w1[j] = xr1[64 * j];
        const float r0 = 1.0f / sqrtf(wave_sum(rms_ssq4(w0)) * (1.f / DM) + EPS), r1 = 1.0f / sqrtf(wave_sum(rms_ssq4(w1)) * (1.f / DM) + EPS);
        rms_store4(w0, r0, g, out + (size_t)m * DM, F.lane);
        if (two) rms_store4(w1, r1, g, out + (size_t)m1 * DM, F.lane);
    }
}
__device__ __forceinline__ void rstd_phase(Frame& F, const GAS float* PS, GAS float* RS) {
    const int sub = F.lane & 7;
    for (int row = (F.vcu * NWAVES * 64 + F.tid) >> 3; row < M; row += F.G * NWAVES * 8) {
        float q = 0.f;
#pragma unroll
        for (int t_ = 0; t_ < 4; ++t_) { const f32x4 p = ((const GAS f32x4*)(PS + (size_t)row * 128))[sub * 4 + t_]; q += (p.x + p.y) + (p.z + p.w); }
        q += __int_as_float(SWZ_XOR(__float_as_int(q), 1)); q += __int_as_float(SWZ_XOR(__float_as_int(q), 2)); q += __int_as_float(SWZ_XOR(__float_as_int(q), 4));
        if (sub == 0) RS[row] = 1.0f / sqrtf(q * (1.f / DM) + EPS);
    }
}
__device__ __forceinline__ void rs_prefill_lds(Frame& F, const GAS float* PS, int panel) {
    LAS float* dst = (LAS float*)(F.lds + RING_OFF + pg8::STAGE_BYTES);
    const int row = F.tid >> 1, half = F.tid & 1;
    const GAS f32x4* p = (const GAS f32x4*)(PS + ((size_t)panel * 256 + row) * 128 + half * 64);
    f32x4 v[16];
#pragma unroll
    for (int j = 0; j < 16; ++j) v[j] = p[j];
    float q = 0.f;
#pragma unroll
    for (int j = 0; j < 16; ++j) q += (v[j].x + v[j].y) + (v[j].z + v[j].w);
    q += __int_as_float(SWZ_XOR(__float_as_int(q), 1));
    const float r = 1.0f / sqrtf(q * (1.f / DM) + EPS);
    if (half == 0) { dst[row] = r; dst[256 + row] = r; }
    __syncthreads();
}
__device__ __forceinline__ void cast_rstd_phase(Frame& F, const GAS float* x, GAS bf16* out, GAS float* RS) {
    const int gw = F.vcu * NWAVES + F.wave, NGW = F.G * NWAVES;
    for (int m = gw; m < M; m += 2 * NGW) {
        const bool two = m + NGW < M; const int m1 = two ? m + NGW : m;
        const GAS f32x4* xr0 = (const GAS f32x4*)(x + (size_t)m * DM) + F.lane; const GAS f32x4* xr1 = (const GAS f32x4*)(x + (size_t)m1 * DM) + F.lane;
        f32x4 v0[8], v1[8]; float s0 = 0.f, s1 = 0.f;
#pragma unroll
        for (int j = 0; j < 8; ++j) v0[j] = xr0[64 * j];
#pragma unroll
        for (int j = 0; j < 8; ++j) v1[j] = xr1[64 * j];
#pragma unroll
        for (int j = 0; j < 8; ++j) { s0 += (v0[j].x * v0[j].x + v0[j].y * v0[j].y) + (v0[j].z * v0[j].z + v0[j].w * v0[j].w); s1 += (v1[j].x * v1[j].x + v1[j].y * v1[j].y) + (v1[j].z * v1[j].z + v1[j].w * v1[j].w); }
        const float rstd0 = 1.0f / sqrtf(wave_sum(s0) * (1.f / DM) + EPS), rstd1 = 1.0f / sqrtf(wave_sum(s1) * (1.f / DM) + EPS);
        GAS unsigned long long* o0 = (GAS unsigned long long*)(out + (size_t)m * DM) + F.lane; GAS unsigned long long* o1 = (GAS unsigned long long*)(out + (size_t)m1 * DM) + F.lane;
#pragma unroll
        for (int j = 0; j < 8; ++j) {
            o0[64 * j] = (unsigned long long)pk2(v0[j].x, v0[j].y) | ((unsigned long long)pk2(v0[j].z, v0[j].w) << 32);
            if (two) o1[64 * j] = (unsigned long long)pk2(v1[j].x, v1[j].y) | ((unsigned long long)pk2(v1[j].z, v1[j].w) << 32); }
        if (F.lane == 0) { RS[m] = rstd0; if (two) RS[m1] = rstd1; }
    }
}
__device__ __forceinline__ void qknorm_phase(Frame& F, const GAS bf16* PROJ, GAS bf16* QKN, const GAS float* qg, const GAS float* kg, GAS float* kmean) {
    LAS float* red = (LAS float*)(F.lds + RING_OFF);
    const int nunits = 2 * BATCH * AH * NBLK;
    const int l16 = F.lane & 15, rs = F.lane >> 4;
    v4u wn[8];
#define QK_SRC(u_) (PROJ + ((size_t)((((u_) >> 1) / NBLK) / AH) * SEQ + (((u_) >> 1) % NBLK) * MB + F.wave * 32 + rs) * LDP + (((u_) & 1) ? C_KA : C_QA) + ((((u_) >> 1) / NBLK) % AH) * AD + l16 * 8)
    if (F.vcu < nunits) { const GAS bf16* src0 = QK_SRC(F.vcu);
#pragma unroll
        for (int st = 0; st < 8; ++st) wn[st] = *(const GAS v4u*)(src0 + (size_t)(4 * st) * LDP); }
    for (int u = F.vcu; u < nunits; u += F.G) {
        const int isk = u & 1, r = u >> 1, n = r % NBLK, bh = r / NBLK, h = bh % AH, b = bh / AH;
        const GAS float* gain = (isk ? kg : qg) + l16 * 8;
        const f32x4 ga = *(const GAS f32x4*)gain, gb = *(const GAS f32x4*)(gain + 4);
        const size_t row0 = (size_t)b * SEQ + n * MB + F.wave * 32 + rs;
        GAS bf16* dst = QKN + row0 * 2048 + (isk ? 1024 : 0) + h * AD + l16 * 8;
        v4u w[8];
#pragma unroll
        for (int st = 0; st < 8; ++st) w[st] = wn[st];
        if (u + F.G < nunits) { const GAS bf16* src1 = QK_SRC(u + F.G);
#pragma unroll
            for (int st = 0; st < 8; ++st) wn[st] = *(const GAS v4u*)(src1 + (size_t)(4 * st) * LDP); }
        float a[8] = {0.f, 0.f, 0.f, 0.f, 0.f, 0.f, 0.f, 0.f};
#pragma unroll
        for (int st = 0; st < 8; ++st) {
            const float x0 = blo(w[st].x), x1 = bhi(w[st].x), x2 = blo(w[st].y), x3 = bhi(w[st].y), x4 = blo(w[st].z), x5 = bhi(w[st].z), x6 = blo(w[st].w), x7 = bhi(w[st].w);
            float q = ((x0 * x0 + x1 * x1) + (x2 * x2 + x3 * x3)) + ((x4 * x4 + x5 * x5) + (x6 * x6 + x7 * x7));
            q += __int_as_float(SWZ_XOR(__float_as_int(q), 1)); q += __int_as_float(SWZ_XOR(__float_as_int(q), 2)); q += __int_as_float(SWZ_XOR(__float_as_int(q), 4)); q += __int_as_float(SWZ_XOR(__float_as_int(q), 8));
            const float rstd = 1.0f / sqrtf(q * (1.f / AD) + EPS);
            v4u o; o.x = pk2(x0 * rstd * ga.x, x1 * rstd * ga.y); o.y = pk2(x2 * rstd * ga.z, x3 * rstd * ga.w); o.z = pk2(x4 * rstd * gb.x, x5 * rstd * gb.y); o.w = pk2(x6 * rstd * gb.z, x7 * rstd * gb.w);
            *(GAS v4u*)(dst + (size_t)(4 * st) * 2048) = o;
            a[0] += blo(o.x); a[1] += bhi(o.x); a[2] += blo(o.y); a[3] += bhi(o.y); a[4] += blo(o.z); a[5] += bhi(o.z); a[6] += blo(o.w); a[7] += bhi(o.w);
        }
        if (isk) {
#pragma unroll
            for (int k = 0; k < 8; ++k) { float v = a[k]; v += __int_as_float(SWZ_XOR(__float_as_int(v), 16));
                const auto rr = __builtin_amdgcn_permlane32_swap(__float_as_uint(v), __float_as_uint(v), false, false); a[k] = __uint_as_float(rr[0]) + __uint_as_float(rr[1]); }
            __syncthreads();
            if (F.lane < 16) {
#pragma unroll
                for (int k = 0; k < 8; ++k) red[F.wave * 128 + l16 * 8 + k] = a[k]; }
            __syncthreads();
            if (F.tid < 128) { float sm = 0.f;
#pragma unroll
                for (int w8 = 0; w8 < 8; ++w8) sm += red[w8 * 128 + F.tid];
                kmean[(size_t)(bh * NBLK + n) * AD + F.tid] = sm * (1.f / MB); }
        }
    }
#undef QK_SRC
}
__device__ __forceinline__ void attn_naive_phase(Frame& F, const GAS bf16* QKN, const GAS bf16* PROJ, const GAS float* kmean, GAS bf16* OA, int wg_lo) {
    LAS float* qf = (LAS float*)(F.lds + RING_OFF + F.wave * 8192);
    LAS float* pb = qf + 128;
    const int lane = F.lane;
    const int nw = (F.G - wg_lo) * NWAVES, w0 = (F.vcu - wg_lo) * NWAVES + F.wave;
    const float scale = 0.08838834764831845f;
    for (int u = w0; u < BATCH * AH * SEQ; u += nw) {
        const int t = u % SEQ, bh = u / SEQ, h = bh % AH, b = bh / AH, cur = t >> 8;
        const size_t m = (size_t)b * SEQ + t;
        const float slope = exp2f(-(float)(h + 1));
        { const unsigned qw = *((const GAS unsigned*)(QKN + m * 2048 + h * AD) + lane); qf[2 * lane] = blo(qw); qf[2 * lane + 1] = bhi(qw); }
        LDS_WAIT(); asm volatile("" ::: "memory");
        float g = -INFINITY;
        if (lane < cur) { const GAS float* km = kmean + (size_t)(bh * NBLK + lane) * AD; float a = 0.f;
            for (int d = 0; d < AD; d += 4) { const f32x4 kv = *(const GAS f32x4*)(km + d); a += qf[d] * kv.x + qf[d + 1] * kv.y + qf[d + 2] * kv.z + qf[d + 3] * kv.w; }
            g = a; }
        int sel0 = 0, sel1 = 0, sel2 = 0; bool val0 = false, val1 = false, val2 = false;
#pragma unroll
        for (int j = 0; j < 3; ++j) {
            const float mx = wave_max(g); const bool v = mx > -INFINITY;
            const unsigned long long bal = __ballot(g == mx);
            const int ln = v ? (__ffsll((long long)bal) - 1) : 0;
            if (v && lane == ln) g = -INFINITY;
            if (j == 0) { sel0 = ln; val0 = v; } else if (j == 1) { sel1 = ln; val1 = v; } else { sel2 = ln; val2 = v; }
        }
        float sc[4][4]; float mx = -INFINITY;
#pragma unroll
        for (int jb = 0; jb < 4; ++jb) {
            const bool v = jb == 0 ? val0 : jb == 1 ? val1 : jb == 2 ? val2 : true;
            const int blk = jb == 0 ? sel0 : jb == 1 ? sel1 : jb == 2 ? sel2 : cur;
#pragma unroll
            for (int i = 0; i < 4; ++i) {
                float s = -INFINITY;
                if (v) {
                    const int kpos = blk * MB + i * 64 + lane;
                    const GAS bf16* krow = QKN + ((size_t)b * SEQ + kpos) * 2048 + 1024 + h * AD;
                    float a = 0.f;
                    for (int d8 = 0; d8 < 16; ++d8) { const v4u kk = *(const GAS v4u*)(krow + d8 * 8); const LAS float* q8 = qf + d8 * 8;
                        a += q8[0] * blo(kk.x) + q8[1] * bhi(kk.x) + q8[2] * blo(kk.y) + q8[3] * bhi(kk.y) + q8[4] * blo(kk.z) + q8[5] * bhi(kk.z) + q8[6] * blo(kk.w) + q8[7] * bhi(kk.w); }
                    s = a * scale - slope * (float)(t - kpos);
                    if (jb == 3 && kpos > t) s = -INFINITY;
                }
                sc[jb][i] = s; mx = fmaxf(mx, s);
            }
        }
        mx = wave_max(mx);
        float sum = 0.f;
#pragma unroll
        for (int jb = 0; jb < 4; ++jb)
#pragma unroll
            for (int i = 0; i < 4; ++i) { const float p = __expf(sc[jb][i] - mx); sum += p; pb[jb * 256 + i * 64 + lane] = p; }
        sum = wave_sum(sum);
        LDS_WAIT(); asm volatile("" ::: "memory");
        float o0 = 0.f, o1 = 0.f;
#pragma unroll
        for (int jb = 0; jb < 4; ++jb) {
            const bool v = jb == 0 ? val0 : jb == 1 ? val1 : jb == 2 ? val2 : true;
            const int blk = jb == 0 ? sel0 : jb == 1 ? sel1 : jb == 2 ? sel2 : cur;
            if (v) {
                const int nk = jb == 3 ? (t - cur * MB + 1) : MB;
                const GAS bf16* vb = PROJ + ((size_t)b * SEQ + blk * MB) * LDP + C_VA + h * AD;
                for (int kk = 0; kk < nk; ++kk) { const float p = pb[jb * 256 + kk]; const unsigned vw = *((const GAS unsigned*)(vb + (size_t)kk * LDP) + lane); o0 += p * blo(vw); o1 += p * bhi(vw); }
            }
        }
        const float inv = 1.0f / sum;
        *((GAS unsigned*)(OA + m * AW + h * AD) + lane) = pk2(o0 * inv, o1 * inv);
        LDS_WAIT(); asm volatile("" ::: "memory");
    }
}
__device__ __forceinline__ void ktrans_phase(Frame& F, const GAS bf16* KB, GAS bf16* KTB) {
    LAS bf16* scr = (LAS bf16*)(F.lds + RING_OFF + F.wave * 9216);
    const int gw = F.vcu * NWAVES + F.wave, NGW = F.G * NWAVES, lr = F.lane >> 3, lc = F.lane & 7;
    for (int it = gw; it < 256 * 16; it += NGW) {
        const int c = it >> 4, jt = (it >> 2) & 3, dt = it & 3;
        const GAS bf16* src = KB + (size_t)c * 65536 + (size_t)(jt * 64) * 256 + dt * 64;
        GAS bf16* dst = KTB + (size_t)c * 65536 + (size_t)(dt * 64) * 256 + jt * 64;
        v4u v[8];
#pragma unroll
        for (int i = 0; i < 8; ++i) v[i] = *(const GAS v4u*)(src + (size_t)(lr + 8 * i) * 256 + lc * 8);
#pragma unroll
        for (int i = 0; i < 8; ++i) *(LAS v4u*)(scr + (lr + 8 * i) * 72 + lc * 8) = v[i];
        LDS_WAIT(); asm volatile("" ::: "memory");
#pragma unroll
        for (int i = 0; i < 8; ++i) { const int d = lr + 8 * i; const LAS bf16* p = scr + (lc * 8) * 72 + d;
            v4u o; o.x = (unsigned)p[0] | ((unsigned)p[72] << 16); o.y = (unsigned)p[2 * 72] | ((unsigned)p[3 * 72] << 16); o.z = (unsigned)p[4 * 72] | ((unsigned)p[5 * 72] << 16); o.w = (unsigned)p[6 * 72] | ((unsigned)p[7 * 72] << 16);
            *(GAS v4u*)(dst + (size_t)d * 256 + lc * 8) = o; }
        LDS_WAIT(); asm volatile("" ::: "memory");
    }
}
__device__ __forceinline__ void scan_item(Frame& F, const GAS bf16* ST, GAS bf16* BQ, int item) {
    { const int idx = item * 512 + F.tid;
        const int bh = idx >> 14, rem = idx & 16383, e = rem >> 5, d8 = rem & 31, h = bh & 3;
        const float gC = exp2f(256.0f * __log2f(1.0f - exp2f(-5.0f - (float)h)));
        float s[8];
#pragma unroll
        for (int k = 0; k < 8; ++k) s[k] = 0.f;
        const GAS bf16* sp = ST + (size_t)bh * 32 * 131072 + (size_t)e * 256 + 8 * d8;
        GAS bf16* bp = BQ + (size_t)bh * 32 * 262144 + (size_t)e * 512 + 256 + 8 * d8;
        for (int n0 = 0; n0 < 32; n0 += 16) {
            v4u kv[16];
#pragma unroll
            for (int k = 0; k < 16; ++k) kv[k] = *(const GAS v4u*)(sp + (size_t)(n0 + k) * 131072);
#pragma unroll
            for (int k = 0; k < 16; ++k) {
                v4u o; o.x = pk2(s[0], s[1]); o.y = pk2(s[2], s[3]); o.z = pk2(s[4], s[5]); o.w = pk2(s[6], s[7]);
                *(GAS v4u*)(bp + (size_t)(n0 + k) * 262144) = o;
                s[0] = s[0] * gC + blo(kv[k].x); s[1] = s[1] * gC + bhi(kv[k].x); s[2] = s[2] * gC + blo(kv[k].y); s[3] = s[3] * gC + bhi(kv[k].y);
                s[4] = s[4] * gC + blo(kv[k].z); s[5] = s[5] * gC + bhi(kv[k].z); s[6] = s[6] * gC + blo(kv[k].w); s[7] = s[7] * gC + bhi(kv[k].w); }
        }
    }
}
__device__ __forceinline__ void attn_phase(Frame& F, char* ldsg, const GAS bf16* QKN, const GAS bf16* PROJ, const GAS float* kmean, GAS bf16* OA, gu32* qctr, const GAS float* qg, const GAS float* kg) {
    const float gq = wave_max(fmaxf(fabsf(qg[2 * F.lane]), fabsf(qg[2 * F.lane + 1]))), gk = wave_max(fmaxf(fabsf(kg[2 * F.lane]), fabsf(kg[2 * F.lane + 1])));
    const float tv = 2.0f * 11.3138f * gq * gk + 25.0f;
    volatile int* misc = (volatile int*)(ldsg + att::OFF_MISC);
    __syncthreads();
    if (F.tid == 0) misc[3] = __float_as_int(tv);
    for (;;) {
        __syncthreads();
        if (F.tid == 0) misc[2] = (int)__hip_atomic_fetch_add(qctr, 1u, RLX_AGENT);
        __syncthreads();
        const int u = __builtin_amdgcn_readfirstlane(misc[2]);
        if (u >= BATCH * AH * NBLK) break;
        const int cur = 31 - (u >> 4), rem = u & 15, h = 7 - (rem >> 1), b = rem & 1;
        const float tnat = __int_as_float(__builtin_amdgcn_readfirstlane(misc[3]));
        const float wf = tnat * exp2f((float)(h + 1)) * (1.0f / 256.0f);
        const int wpast = wf >= 31.0f ? 31 : (int)wf + 1;
        int tl; asm volatile("v_mbcnt_lo_u32_b32 %0, -1, 0\n\tv_mbcnt_hi_u32_b32 %0, -1, %0" : "=v"(tl)); tl += F.wave * 64;
        const float smax2 = (tnat - 25.0f) * 0.5f * 1.02f * att::LOG2E;
        att::attn_unit(b, h, cur, QKN, 2048, 0, 1024, PROJ, LDP, C_VA, SEQ, kmean, OA, 3072, ldsg, tl, wpast, smax2);
    }
}
__device__ __forceinline__ int attn_wpast(float tnat, int h) { const float wf = tnat * exp2f((float)(h + 1)) * (1.0f / 256.0f); return wf >= 31.0f ? 31 : (int)wf + 1; }
__device__ __forceinline__ float attn_tnat(Frame& F, const GAS float* qg, const GAS float* kg) {
    const float gq = wave_max(fmaxf(fabsf(qg[2 * F.lane]), fabsf(qg[2 * F.lane + 1]))), gk = wave_max(fmaxf(fabsf(kg[2 * F.lane]), fabsf(kg[2 * F.lane + 1])));
    return 2.0f * 11.3138f * gq * gk + 25.0f;
}
__device__ __forceinline__ void attn_select_phase(Frame& F, const GAS bf16* QKN, const GAS float* kmean, GAS bf16* LIST, gu32* LCNT, GAS float* PL, const GAS float* qg, const GAS float* kg) {
    const float tnat = attn_tnat(F, qg, kg);
    const int gw = F.vcu * NWAVES + F.wave, NGW = F.G * NWAVES;
    for (int wu = gw; wu < BATCH * AH * (NBLK - 1) * 8; wu += NGW) {
        const int wv = wu & 7, r = wu >> 3, cur = 1 + r % (NBLK - 1), bh = r / (NBLK - 1), h = bh % AH, b = bh / AH;
        att::attn_select(b, h, cur, wv, QKN, 2048, SEQ, kmean, LIST, LCNT, PL, M, F.lane, attn_wpast(tnat, h));
    }
}
__device__ __forceinline__ void attn_gather_phase(Frame& F, char* ldsg, const GAS bf16* QKN, const GAS bf16* PROJ, const GAS bf16* LIST, gu32* LCNT, GAS bf16* P01, GAS bf16* P23, GAS float* PL, gu32* qctr, const GAS float* qg, const GAS float* kg) {
    const float tv = attn_tnat(F, qg, kg);
    volatile int* misc = (volatile int*)(ldsg + att::OFF_MISC);
    volatile int* pref = (volatile int*)(ldsg + att::OFF_PREF);
    volatile int* pcnt = (volatile int*)(ldsg + att::OFF_PREF + 516 * 4);
    __syncthreads();
    { const int c_ = (int)__hip_atomic_load(LCNT + F.tid, RLX_AGENT); pcnt[F.tid] = c_; pref[1 + F.tid] = (c_ + 255) >> 8; }
    if (F.tid == 0) misc[3] = __float_as_int(tv);
    __syncthreads();
    unsigned qn = 0u;
    if (F.tid == 0) { int s_ = 0; pref[0] = 0; for (int i = 1; i <= 512; ++i) { s_ += pref[i]; pref[i] = s_; }
        qn = __hip_atomic_fetch_add(qctr, 1u, RLX_AGENT); }
    for (;;) {
        if (F.tid == 0) { const int q = (int)qn; const int ug = pref[512];
            int li = -1, ch = 0;
            if (q < ug) { int lo_ = 0, hi_ = 512; while (hi_ - lo_ > 1) { const int mid = (lo_ + hi_) >> 1; if (pref[mid] <= q) lo_ = mid; else hi_ = mid; } li = lo_; ch = q - pref[lo_]; }
            else if (q < ug + BATCH * AH * NBLK) { li = 512 + (q - ug); }
            misc[2] = li; misc[5] = ch;
            if (li >= 0) qn = __hip_atomic_fetch_add(qctr, 1u, RLX_AGENT); }
        __syncthreads();
        const int li = __builtin_amdgcn_readfirstlane(misc[2]), ch = __builtin_amdgcn_readfirstlane(misc[5]);
        if (li < 0) break;
        const float tnat = __int_as_float(__builtin_amdgcn_readfirstlane(misc[3]));
        const float smax2 = (tnat - 25.0f) * 0.5f * 1.02f * att::LOG2E;
        int tl; asm volatile("v_mbcnt_lo_u32_b32 %0, -1, 0\n\tv_mbcnt_hi_u32_b32 %0, -1, %0" : "=v"(tl)); tl += F.wave * 64;
        if (li < 512) { const int n = li & 31, bh = li >> 5, h = bh & 7, b = bh >> 3; const int cnt = __builtin_amdgcn_readfirstlane(pcnt[li]);
            att::attn_block_unit(false, b, h, n, ch * 256, cnt, LIST, QKN, 2048, 1024, PROJ, LDP, C_VA, SEQ, P01, P23, PL, M, ldsg, tl, smax2); }
        else { const int u = li - 512, cur = u >> 4, rem = u & 15, h = rem >> 1, b = rem & 1;
            att::attn_block_unit(true, b, h, cur, 0, 256, LIST, QKN, 2048, 1024, PROJ, LDP, C_VA, SEQ, P01, P23, PL, M, ldsg, tl, smax2); }
    }
}
constexpr int SEGR = 512;
__device__ __forceinline__ void attn_kv_phase(Frame& F, char* ldsg, const GAS bf16* QKN, const GAS bf16* PROJ, const GAS bf16* LIST, gu32* LCNT, GAS bf16* P01, GAS bf16* P23, GAS float* PL, gu32* qctr, const GAS float* qg, const GAS float* kg) {
    const float tv = attn_tnat(F, qg, kg);
    volatile int* pref = (volatile int*)(ldsg + att::KV4_END);
    volatile int* pcnt = (volatile int*)(ldsg + att::KV4_END + 516 * 4);
    volatile unsigned short* utab = (volatile unsigned short*)(ldsg + att::KV4_END + 516 * 4 + 512 * 4);
    volatile int* misc = (volatile int*)(ldsg + att::KV4_END + 516 * 4 + 512 * 4 + 4096);
    __syncthreads();
    unsigned qn = 0u;
    if (F.tid == 0) qn = __hip_atomic_fetch_add(qctr, 1u, RLX_AGENT);
    int pv_;
    { const int i = F.tid, n = i >> 4, r = i & 15, h = 7 - (r >> 1), b = r & 1, lid = (b * 8 + h) * 32 + n;
      const int c_ = n < 31 ? (int)__hip_atomic_load(LCNT + lid, RLX_AGENT) : 0; pcnt[i] = c_; const int ns = (c_ + SEGR - 1) / SEGR; pv_ = ns > 0 ? ns : 1; pref[1 + i] = pv_; }
    if (F.tid == 0) { misc[1] = __float_as_int(tv); pref[0] = 0; }
    for (int off = 1; off < 512; off <<= 1) {
        __syncthreads();
        const int add_ = F.tid >= off ? pref[1 + F.tid - off] : 0;
        __syncthreads();
        pv_ += add_; pref[1 + F.tid] = pv_;
    }
    __syncthreads();
    if (F.tid == 0) { const int s_ = pref[512]; misc[2] = s_ < 2048 ? s_ : 2048; }
    __syncthreads();
    { const int i = F.tid, u0 = pref[i], u1 = pref[i + 1]; for (int u = u0; u < u1 && u < 2048; ++u) utab[u] = (unsigned short)((i << 4) | (u - u0)); }
    __syncthreads();
    for (;;) {
        if (F.tid == 0) { const int q = (int)qn; int code = -1; if (q < misc[2]) { code = utab[q]; qn = __hip_atomic_fetch_add(qctr, 1u, RLX_AGENT); } misc[0] = code; }
        __syncthreads();
        const int code = __builtin_amdgcn_readfirstlane(misc[0]);
        if (code < 0) break;
        const int i = code >> 4, seg = code & 15, n = i >> 4, r = i & 15, h = 7 - (r >> 1), b = r & 1;
        const int cnt = __builtin_amdgcn_readfirstlane(pcnt[i]);
        const int seg0 = seg * SEGR; int segn = cnt - seg0; segn = segn > SEGR ? SEGR : (segn < 0 ? 0 : segn);
        const float tnat = __int_as_float(__builtin_amdgcn_readfirstlane(misc[1]));
        const float smax2 = (tnat - 25.0f) * 0.5f * 1.02f * att::LOG2E;
        int tl; asm volatile("v_mbcnt_lo_u32_b32 %0, -1, 0\n\tv_mbcnt_hi_u32_b32 %0, -1, %0" : "=v"(tl)); tl += F.wave * 64;
        att::attn_kv_unit(b, h, n, seg0, segn, seg == 0, LIST, QKN, 2048, 1024, PROJ, LDP, C_VA, SEQ, P01, P23, PL, M, ldsg, tl, smax2);
    }
}
__device__ __forceinline__ v4u combine_unit(float l0, float l1, float l2, float l3, const v4u w0, const v4u w1, const v4u w2, const v4u w3) {
    const float inv = 1.0f / (((l0 + l1) + l2) + l3);
    const float c0 = l0 * inv, c1 = l1 * inv, c2 = l2 * inv, c3 = l3 * inv;
#define CMB(f, c) ((l0 > 0.f ? c0 * f(w0.c) : 0.f) + (l1 > 0.f ? c1 * f(w1.c) : 0.f) + (l2 > 0.f ? c2 * f(w2.c) : 0.f) + c3 * f(w3.c))
    v4u o;
    o.x = pk2(CMB(blo, x), CMB(bhi, x)); o.y = pk2(CMB(blo, y), CMB(bhi, y)); o.z = pk2(CMB(blo, z), CMB(bhi, z)); o.w = pk2(CMB(blo, w), CMB(bhi, w));
#undef CMB
    return o;
}
__device__ __forceinline__ void attn_combine_phase(Frame& F, const GAS bf16* P01, const GAS bf16* P23, const GAS float* PL, GAS bf16* AC) {
    const int gw = F.vcu * NWAVES + F.wave, NGW = F.G * NWAVES, g4 = F.lane >> 4, l16 = F.lane & 15;
    for (int u4 = gw; u4 < M * AH / 4; u4 += 2 * NGW) {
        const bool two = u4 + NGW < M * AH / 4; const int u4b = two ? u4 + NGW : u4;
        const int ua = u4 * 4 + g4, ub = u4b * 4 + g4; const size_t ma = ua >> 3, mb = ub >> 3; const int ha = ua & 7, hb = ub & 7;
        const float la0 = PL[((size_t)0 * M + ma) * 8 + ha], la1 = PL[((size_t)1 * M + ma) * 8 + ha], la2 = PL[((size_t)2 * M + ma) * 8 + ha], la3 = PL[((size_t)3 * M + ma) * 8 + ha];
        const float lb0 = PL[((size_t)0 * M + mb) * 8 + hb], lb1 = PL[((size_t)1 * M + mb) * 8 + hb], lb2 = PL[((size_t)2 * M + mb) * 8 + hb], lb3 = PL[((size_t)3 * M + mb) * 8 + hb];
        const v4u wa0 = ((const GAS v4u*)(P01 + ((size_t)0 * M + ma) * 1024 + ha * 128))[l16], wa1 = ((const GAS v4u*)(P01 + ((size_t)1 * M + ma) * 1024 + ha * 128))[l16];
        const v4u wa2 = ((const GAS v4u*)(P23 + ((size_t)0 * M + ma) * 1024 + ha * 128))[l16], wa3 = ((const GAS v4u*)(P23 + ((size_t)1 * M + ma) * 1024 + ha * 128))[l16];
        const v4u wb0 = ((const GAS v4u*)(P01 + ((size_t)0 * M + mb) * 1024 + hb * 128))[l16], wb1 = ((const GAS v4u*)(P01 + ((size_t)1 * M + mb) * 1024 + hb * 128))[l16];
        const v4u wb2 = ((const GAS v4u*)(P23 + ((size_t)0 * M + mb) * 1024 + hb * 128))[l16], wb3 = ((const GAS v4u*)(P23 + ((size_t)1 * M + mb) * 1024 + hb * 128))[l16];
        ((GAS v4u*)(AC + ma * 3072 + ha * 128))[l16] = combine_unit(la0, la1, la2, la3, wa0, wa1, wa2, wa3);
        if (two) ((GAS v4u*)(AC + mb * 3072 + hb * 128))[l16] = combine_unit(lb0, lb1, lb2, lb3, wb0, wb1, wb2, wb3);
    }
}
__device__ __forceinline__ void groupnorm_unit(const v4u rw, const v4u gw4, GAS bf16* orow, int lane) {
    float y[8] = {blo(rw.x), bhi(rw.x), blo(rw.y), bhi(rw.y), blo(rw.z), bhi(rw.z), blo(rw.w), bhi(rw.w)};
    const float g[8] = {blo(gw4.x), bhi(gw4.x), blo(gw4.y), bhi(gw4.y), blo(gw4.z), bhi(gw4.z), blo(gw4.w), bhi(gw4.w)};
    const float mean = wave_sum(((y[0] + y[1]) + (y[2] + y[3])) + ((y[4] + y[5]) + (y[6] + y[7]))) * (1.f / RDV);
    float q = 0.f;
#pragma unroll
    for (int k = 0; k < 8; ++k) { y[k] -= mean; q += y[k] * y[k]; }
    const float rstd = 1.0f / sqrtf(wave_sum(q) * (1.f / RDV) + EPS);
    v4u o; o.x = pk2(y[0] * rstd * pg8::siluf_(g[0]), y[1] * rstd * pg8::siluf_(g[1])); o.y = pk2(y[2] * rstd * pg8::siluf_(g[2]), y[3] * rstd * pg8::siluf_(g[3]));
    o.z = pk2(y[4] * rstd * pg8::siluf_(g[4]), y[5] * rstd * pg8::siluf_(g[5])); o.w = pk2(y[6] * rstd * pg8::siluf_(g[6]), y[7] * rstd * pg8::siluf_(g[7]));
    ((GAS v4u*)orow)[lane] = o;
}
__device__ __forceinline__ void groupnorm_phase(Frame& F, const GAS bf16* RET, const GAS bf16* PROJ, GAS bf16* ORR) {
    const int gw = F.vcu * NWAVES + F.wave, NGW = F.G * NWAVES;
    for (int u0 = gw; u0 < M * RH; u0 += 4 * NGW) {
        v4u rw[4], gg[4]; int uu[4];
#pragma unroll
        for (int j = 0; j < 4; ++j) { const int u = u0 + j * NGW; uu[j] = u < M * RH ? u : u0; const size_t m = uu[j] >> 2; const int h = uu[j] & 3;
            rw[j] = ((const GAS v4u*)(RET + m * 2048 + h * RDV))[F.lane]; gg[j] = ((const GAS v4u*)(PROJ + m * LDP + C_GR + h * RDV))[F.lane]; }
#pragma unroll
        for (int j = 0; j < 4; ++j) { const size_t m = uu[j] >> 2; const int h = uu[j] & 3;
            if (j == 0 || u0 + j * NGW < M * RH) groupnorm_unit(rw[j], gg[j], ORR + m * 3072 + 1024 + h * RDV, F.lane); }
    }
}

__device__ __forceinline__ void groupnorm_own_chunks(Frame& F, const GAS bf16* RET, const GAS bf16* PROJ, GAS bf16* ORR) {
    for (int c = (int)blockIdx.x; c < BATCH * RH * (SEQ / 256); c += F.G) {
        const int b = c >> 7, h = (c >> 5) & 3, n = c & 31;
        for (int k0 = 0; k0 < 256 / NWAVES; k0 += 4) {
            v4u rw[4], gg[4];
#pragma unroll
            for (int j = 0; j < 4; ++j) { const size_t m = (size_t)b * SEQ + n * 256 + F.wave + NWAVES * (k0 + j);
                rw[j] = ((const GAS v4u*)(RET + m * 2048 + h * RDV))[F.lane]; gg[j] = ((const GAS v4u*)(PROJ + m * LDP + C_GR + h * RDV))[F.lane]; }
#pragma unroll
            for (int j = 0; j < 4; ++j) { const size_t m = (size_t)b * SEQ + n * 256 + F.wave + NWAVES * (k0 + j); groupnorm_unit(rw[j], gg[j], ORR + m * 3072 + 1024 + h * RDV, F.lane); }
        }
    }
}

struct Args { const float* in[11]; float* out; unsigned char* ws; int ph_lo, ph_hi; };
__global__ void __launch_bounds__(NWAVES * 64, 2) hybrid_fwd(Args args) {
    extern __shared__ __attribute__((aligned(16))) unsigned char lds[];
    Frame F;
    F.lds = (LAS unsigned char*)lds;
    F.MISC = (volatile LAS unsigned*)(F.lds + MISC_OFF);
    F.tid = threadIdx.x; F.lane = F.tid & 63; F.wave = __builtin_amdgcn_readfirstlane(F.tid >> 6);
    F.G = gridDim.x; { const int bx = blockIdx.x; F.vcu = (F.G % 8 == 0) ? (bx % 8) * (F.G / 8) + bx / 8 : bx; }
    unsigned char* ws = args.ws;
    F.ctl = (gu32*)(ws + WS_CTL);
    for (int u = F.tid; u < (LDS_BYTES - LDSCTL_OFF) / 4; u += NWAVES * 64) ((LAS unsigned*)(F.lds + LDSCTL_OFF))[u] = 0u;
    __syncthreads();
    XcdBarrier bar; bar.bar = (unsigned*)(F.ctl + CW_BAR); bar.x = 0; bar.st = nullptr;
    if (MK_ONE_LAUNCH) bar = xcd_barrier_post((unsigned*)(F.ctl + CW_BAR), F.MISC + 8);
    const int lo = args.ph_lo, hi = args.ph_hi;
#define IN(k) (lo <= (k) && (k) < hi)
#define SEAM(k) do { if (MK_ONE_LAUNCH && IN((k) + 1)) { XcdBarrier b2_ = bar; b2_.bar = (unsigned*)(WSP() + WS_CTL) + CW_BAR; { unsigned x_ = bar.x; asm volatile("" : "+s"(x_)); b2_.x = x_; } xcd_barrier(b2_); } } while (0)
#define WSP() ({ unsigned char* p_ = args.ws; asm volatile("" : "+s"(p_)); (unsigned char*)(GAS unsigned char*)p_; })
#define PTRS() { int ln_; asm volatile("v_mbcnt_lo_u32_b32 %0, -1, 0\n\tv_mbcnt_hi_u32_b32 %0, -1, %0" : "=v"(ln_)); F.lane = ln_; F.tid = F.wave * 64 + ln_; }     \
    unsigned char* const w_ = WSP(); \
    GAS float* const kmean = (GAS float*)(w_ + WS_KMEAN); \
    unsigned char* const wset_ = w_ + ((l & 1) ? WS_W1 : WS_W0); \
    GAS bf16*const Wnat_t = (GAS bf16*)(wset_ + WS_WNAT), *const Wswp_t = (GAS bf16*)(wset_ + WS_WSWP), *const Wcat_t = (GAS bf16*)(wset_ + WS_WOA), *const Wout_t = (GAS bf16*)(wset_ + WS_WOUT), *const Wfi_t = (GAS bf16*)(wset_ + WS_WFI), *const Wfo_t = (GAS bf16*)(wset_ + WS_WFO); \
    GAS bf16*const H = (GAS bf16*)(w_ + WS_H), *const PROJ = (GAS bf16*)(w_ + WS_PROJ), *const ACT = (GAS bf16*)(w_ + WS_PROJ), *const AC = (GAS bf16*)(w_ + WS_OA), *const MRG = (GAS bf16*)(w_ + WS_MRG); \
    GAS bf16*const RET = (GAS bf16*)(w_ + WS_RET), *const ST = (GAS bf16*)(w_ + WS_ST); \
    GAS bf16*const LIST = (GAS bf16*)(w_ + WS_LIST), *const P01 = (GAS bf16*)(w_ + WS_P01), *const P23 = (GAS bf16*)(w_ + WS_P23); GAS float*const PL = (GAS float*)(w_ + WS_PL); (void)LIST; (void)P01; (void)P23; (void)PL; \
    GAS float*const PS = (GAS float*)(w_ + WS_PS); GAS float*const RS = (GAS float*)(w_ + WS_RS); (void)PS; (void)RS; \
    GAS bf16*const QKN = (GAS bf16*)(w_ + WS_QKN); (void)QKN; GAS bf16*const XR = (GAS bf16*)(w_ + WS_RET + 64 * MiB); (void)XR;     \
    GAS bf16*const AQ = (GAS bf16*)(w_ + WS_AQ), *const BQ = (GAS bf16*)(w_ + WS_BQ), *const KB = (GAS bf16*)(w_ + WS_KB), *const KTB = (GAS bf16*)(w_ + WS_KTB); \
    (void)kmean; (void)Wnat_t; (void)Wswp_t; (void)Wcat_t; (void)Wout_t; (void)Wfi_t; (void)Wfo_t; (void)H; (void)PROJ; (void)ACT; (void)AC; (void)MRG; (void)RET; (void)ST; (void)AQ; (void)BQ; (void)KB; (void)KTB
    const bool own_panel = MK_ONE_LAUNCH && F.G == 256;
    const int team_panel = 8 * ((int)blockIdx.x & 7) + (((int)blockIdx.x >> 3) & 7);
    for (int l = 0; l < DEPTH; ++l) {
        const int pb = l * NPH;
        const GAS float* x_in = (const GAS float*)args.in[0]; GAS float* xres = (GAS float*)args.out;
        const GAS float* xcur = (l == 0) ? x_in : (const GAS float*)xres;
        if (IN(pb + 0) && l == 0) { PTRS();
            const int gw = F.vcu * NWAVES + F.wave, NGW = F.G * NWAVES;
            for (int it = gw; it < NCONV; it += NGW) convert_item(F, args.in, 0, wset_, it);
            __syncthreads();
        }
        if (IN(pb + 1)) { PTRS(); if (l == 0) { cast_rstd_phase(F, x_in, H, RS); SEAM(pb + 1); } else if (!own_panel) { rstd_phase(F, PS, RS); SEAM(pb + 1); } }
        if (IN(pb + 2)) { PTRS();
            const bool pre_ = own_panel && l > 0; if (pre_) rs_prefill_lds(F, PS, team_panel);
            { pg8::ProjDesc D{l == 0 ? (const GAS bf16*)H : (const GAS bf16*)XR, Wnat_t, Wswp_t, DM, DM, DM, {}, {}, 0}; D.On.init(M, NNAT, F.G, (int)blockIdx.x); D.Os.init(NSWP, M, F.G, (int)blockIdx.x, true); D.nnat = (D.On.nwg - (int)blockIdx.x + F.G - 1) / F.G;
              pg8::EpiProjBoth E{{PROJ, LDP, AQ, KB, pre_ ? (const GAS float*)nullptr : (const GAS float*)RS}, {KTB, BQ, RS}};
              pg8::gemm_phase<pg8::EpiProjBoth, pg8::ProjDesc, PG8_ALIGN, PG8_SP2>(F.lds + RING_OFF, D, E, F.tid); }
            SEAM(pb + 2);
        }
        if (IN(pb + 3)) { PTRS();
            ktrans_phase(F, KB, KTB);
            __syncthreads();
            qknorm_phase(F, PROJ, QKN, (const GAS float*)args.in[5] + (size_t)l * AD, (const GAS float*)args.in[6] + (size_t)l * AD, kmean);
            if (MK_ONE_LAUNCH) { XcdBarrier b2_ = bar; b2_.bar = (unsigned*)(WSP() + WS_CTL) + CW_BAR; { unsigned x_ = bar.x; asm volatile("" : "+s"(x_)); b2_.x = x_; } xcd_barrier(b2_); }
            attn_select_phase(F, QKN, kmean, LIST, F.ctl + CW_LCNT + 512 * l, PL, (const GAS float*)args.in[5] + (size_t)l * AD, (const GAS float*)args.in[6] + (size_t)l * AD);
            __syncthreads();
            { const int c_ = (int)blockIdx.x; pg8::RetDesc D{AQ + 256, KB, BQ, KTB, 256, 512, 256, F.G, c_, c_ < 256 ? (256 - c_ + F.G - 1) / F.G : 0};
              pg8::EpiRetBoth E{{AQ}, {ST}};
              pg8::gemm_phase<pg8::EpiRetBoth, pg8::RetDesc, PG8_ALIGN, PG8_SP2>(F.lds + RING_OFF, D, E, F.tid); }
            SEAM(pb + 3);
        }
        if (IN(pb + 4)) { PTRS();
            attn_kv_phase(F, (char*)lds, QKN, PROJ, LIST, F.ctl + CW_LCNT + 512 * l, P01, P23, PL, F.ctl + CW_ATTQ + 64 * l, (const GAS float*)args.in[5] + (size_t)l * AD, (const GAS float*)args.in[6] + (size_t)l * AD);
            { int ln_; asm volatile("v_mbcnt_lo_u32_b32 %0, -1, 0\n\tv_mbcnt_hi_u32_b32 %0, -1, %0" : "=v"(ln_)); F.lane = ln_; F.tid = F.wave * 64 + ln_; }
            for (;;) {
                __syncthreads();
                if (F.tid == 0) F.MISC[16] = __hip_atomic_fetch_add(F.ctl + CW_SCQ + 64 * l, 1u, RLX_AGENT);
                __syncthreads();
                const int it = (int)__builtin_amdgcn_readfirstlane(F.MISC[16]);
                if (it >= BATCH * RH * RDV * 32 / 512) break;
                scan_item(F, ST, BQ, it);
            }
            if (l + 1 < DEPTH) {
                unsigned char* const wnext = w_ + (((l + 1) & 1) ? WS_W1 : WS_W0);
                unsigned qn_ = 0u;
                __syncthreads();
                if (F.tid == 0) qn_ = __hip_atomic_fetch_add(F.ctl + CW_CVQ + 64 * l, 1u, RLX_AGENT);
                for (int rnd = 0;; ++rnd) {
                    if (F.tid == 0) F.MISC[16 + (rnd & 1)] = qn_;
                    __syncthreads();
                    const int tk = (int)__builtin_amdgcn_readfirstlane(F.MISC[16 + (rnd & 1)]);
                    if (tk * 8 >= NCONV) break;
                    if (F.tid == 0) qn_ = __hip_atomic_fetch_add(F.ctl + CW_CVQ + 64 * l, 1u, RLX_AGENT);
                    convert_item(F, args.in, l + 1, wnext, tk * 8 + F.wave);
                }
            }
            SEAM(pb + 4);
        }
        if (IN(pb + 5)) { PTRS();
            pg8::BatchDesc D{AQ, BQ, 512, 512, 512, 131072, 262144, 0, 131072, 512, 2, F.G, (int)blockIdx.x, 1};
            pg8::EpiO E{RET, SEQ};
            pg8::gemm_phase<pg8::EpiO, pg8::BatchDesc, PG8_ALIGN, PG8_SP2>(F.lds + RING_OFF, D, E, F.tid);
            VM_WAIT(); __syncthreads();
            groupnorm_own_chunks(F, RET, PROJ, AC);
            attn_combine_phase(F, P01, P23, PL, AC);
            SEAM(pb + 5);
        }
        if (IN(pb + 7)) { PTRS();
            pg8::PlainDesc D{AC, Wcat_t, 3072, 3072, 3072, {}}; D.O.init(M, DM, F.G, (int)blockIdx.x);
            pg8::EpiMergeCat E{PROJ + C_GA, PROJ + C_GT, LDP, MRG, DM};
            pg8::gemm_phase<pg8::EpiMergeCat, pg8::PlainDesc, PG8_ALIGN, PG8_SP2>(F.lds + RING_OFF, D, E, F.tid);
            SEAM(pb + 7);
        }
        if (IN(pb + 8)) { PTRS();
            pg8::PlainDesc D{MRG, Wout_t, DM, DM, DM, {}}; D.O.init(M, DM, F.G, (int)blockIdx.x);
            pg8::EpiRes E{l == 0 ? (const GAS void*)x_in : (const GAS void*)XR, (GAS void*)XR, DM, l == 0, false, PS};
            pg8::gemm_phase<pg8::EpiRes, pg8::PlainDesc, PG8_ALIGN, PG8_SP2>(F.lds + RING_OFF, D, E, F.tid);
            SEAM(pb + 8);
        }
        if (IN(pb + 9) && !own_panel) { PTRS(); rstd_phase(F, PS, RS); SEAM(pb + 9); }
        if (IN(pb + 10)) { PTRS(); if (own_panel) rs_prefill_lds(F, PS, team_panel);
            pg8::PlainDesc D{XR, Wfi_t, DM, DM, DM, {}}; D.O.init(M, 2 * DFF, F.G, (int)blockIdx.x);
            pg8::EpiSwiGLU E{ACT, DFF, own_panel ? (const GAS float*)nullptr : (const GAS float*)RS};
            pg8::gemm_phase<pg8::EpiSwiGLU, pg8::PlainDesc, PG8_ALIGN, PG8_SP2>(F.lds + RING_OFF, D, E, F.tid);
            SEAM(pb + 10);
        }
        if (IN(pb + 11)) { PTRS();
            pg8::PlainDesc D{ACT, Wfo_t, DFF, DFF, DFF, {}}; D.O.init(M, DM, F.G, (int)blockIdx.x);
            pg8::EpiRes E{(const GAS void*)XR, l == DEPTH - 1 ? (GAS void*)xres : (GAS void*)XR, DM, false, l == DEPTH - 1, l == DEPTH - 1 ? (GAS float*)nullptr : PS};
            pg8::gemm_phase<pg8::EpiRes, pg8::PlainDesc, PG8_ALIGN, PG8_SP2>(F.lds + RING_OFF, D, E, F.tid);
            SEAM(pb + 11);
        }
    }
#undef IN
#undef PTRS
#undef WSP
#undef SEAM
}

extern "C" void kernel_launch(void* const* d_in, const int* in_sizes, int n_in, void* d_out, int out_size, void* d_ws, size_t ws_size, hipStream_t stream) {
    static int grid = 0;
    if (grid == 0) {
        if (n_in != 11 || in_sizes[0] != M * DM || out_size != M * DM || ws_size < WS_END) { fprintf(stderr, "kernel_launch: shape/workspace mismatch: n_in %d in0 %d out %d ws %zu (need %zu)\n", n_in, n_in > 0 ? in_sizes[0] : -1, out_size, ws_size, (size_t)WS_END); grid = -1; return; }
        int dev = 0, cus = 0, per_cu = 0;
        if (hipGetDevice(&dev) != hipSuccess || hipDeviceGetAttribute(&cus, hipDeviceAttributeMultiprocessorCount, dev) != hipSuccess) { grid = -1; return; }
        if (hipFuncSetAttribute((const void*)hybrid_fwd, hipFuncAttributeMaxDynamicSharedMemorySize, LDS_BYTES) != hipSuccess) { fprintf(stderr, "kernel_launch: hipFuncSetAttribute failed\n"); grid = -1; return; }
        if (hipOccupancyMaxActiveBlocksPerMultiprocessor(&per_cu, (const void*)hybrid_fwd, NWAVES * 64, LDS_BYTES) != hipSuccess || per_cu < 1)
            fprintf(stderr, "kernel_launch: note: occupancy query reports %d workgroups per CU\n", per_cu);
        (void)hipGetLastError();
        grid = cus;
    }
    if (grid < 0) return;
    if (hipMemsetAsync((char*)d_ws + WS_CTL, 0, CTL_ZERO_BYTES, stream) != hipSuccess) return;
    Args a{};
    for (int i = 0; i < 11; ++i) a.in[i] = (const float*)d_in[i];
    a.out = (float*)d_out; a.ws = (unsigned char*)d_ws;
#if MK_ONE_LAUNCH
    a.ph_lo = 0; a.ph_hi = NPHASES;
    hipLaunchKernelGGL(hybrid_fwd, dim3(grid), dim3(NWAVES * 64), LDS_BYTES, stream, a);
#else
    for (int p = 0; p < NPHASES; ++p) { a.ph_lo = p; a.ph_hi = p + 1; hipLaunchKernelGGL(hybrid_fwd, dim3(grid), dim3(NWAVES * 64), LDS_BYTES, stream, a); }
#endif
    const hipError_t le = hipPeekAtLastError();
    if (le != hipSuccess) fprintf(stderr, "kernel_launch: launch failed: %s\n", hipGetErrorName(le));
}
```

```cpp
#include <hip/hip_runtime.h>
#include <cstdio>
#include <cstdint>
#include <type_traits>
namespace pg8 {
#define PG8_LAS __attribute__((address_space(3)))
#define PG8_GAS __attribute__((address_space(1)))
typedef unsigned short bf16_t;
typedef short bf16x8 __attribute__((ext_vector_type(8)));
typedef float f32x4 __attribute__((ext_vector_type(4)));
typedef unsigned u32x4 __attribute__((ext_vector_type(4)));
constexpr int BM = 256, BK = 64, HALF = 128, HTB = HALF * BK * 2  , STAGE_BYTES = 8 * HTB, NXCD = 8, WGM = 8;

__host__ __device__ __forceinline__ int lds_byte(int r, int c) { const int st = (r >> 4) * 2 + (c >> 5), rr = r & 15, cc = c & 31, ob = rr * 64 + cc * 2; return st * 1024 + (ob ^ (((ob >> 9) & 1) << 5)); }
__host__ __device__ __forceinline__ void stage_rc(int b, int& R, int& C) { const int st = b / 1024, sb = b % 1024, swz = sb ^ (((sb >> 9) & 1) << 5); R = (st >> 1) * 16 + swz / 64; C = (st & 1) * 32 + (swz % 64) / 2; }
__host__ __device__ __forceinline__ int perm32(int rho) { const int n = rho >> 4, i = rho & 15; return 8 * (i >> 2) + 4 * n + (i & 3); }

struct Unit { int pm, pn; };
struct StaticOrder {
    int nM, nN, nwg, G, c; bool sw;
    __host__ __device__ void init(int M, int N, int G_, int c_, bool sw_ = false) { nM = M / BM; nN = N / BM; nwg = nM * nN; G = G_; c = c_; sw = sw_ && (nwg % NXCD == 0) && (nN % NXCD == 0); }
    __host__ __device__ bool next(int i, Unit& u) const {
        const long L = (long)i * G + c; if (L >= nwg) return false;
        int wgid = (int)L; { const int q = nwg / NXCD, r = nwg % NXCD, xcd = wgid % NXCD, off = wgid / NXCD; wgid = (xcd < r ? xcd * (q + 1) : r * (q + 1) + (xcd - r) * q) + off; }
        if (sw) { const int q = nwg / NXCD, per = nN / NXCD, xcd = wgid / q, off = wgid % q; u.pm = off / per; u.pn = xcd * per + off % per; return true; }
        const int nig = WGM * nN, gid = wgid / nig, fm = gid * WGM, gsz = (nM - fm) < WGM ? (nM - fm) : WGM;
        u.pm = fm + ((wgid % nig) % gsz); u.pn = (wgid % nig) / gsz; return true;
    }
};
struct PlainDesc {
    const PG8_GAS bf16_t* A; const PG8_GAS bf16_t* Bt; int K, lda, ldb; StaticOrder O;
    __device__ __forceinline__ bool next(int i, Unit& u) const { return O.next(i, u); }
    __device__ __forceinline__ const PG8_GAS bf16_t* a_ptr(const Unit& u) const { return A + (size_t)u.pm * BM * lda; }
    __device__ __forceinline__ const PG8_GAS bf16_t* b_ptr(const Unit& u) const { return Bt + (size_t)u.pn * BM * ldb; }
    __device__ __forceinline__ void a_ready(const Unit&) const {}
    __device__ __forceinline__ void done(const Unit&) const {}
};
struct BatchDesc {
    const PG8_GAS bf16_t* A; const PG8_GAS bf16_t* Bt; int K, lda, ldb; size_t sA, sB, tA, tB; int nunits, ntile, G, c, own_batches;
    __device__ __forceinline__ bool next(int i, Unit& u) const {
        if (own_batches) { u.pm = c + (i / ntile) * G; u.pn = i % ntile; return u.pm * ntile < nunits; }
        const int L = i * G + c; if (L >= nunits) return false; u.pm = L / ntile; u.pn = L % ntile; return true; }
    __device__ __forceinline__ const PG8_GAS bf16_t* a_ptr(const Unit& u) const { return A + (size_t)u.pm * sA + (size_t)u.pn * tA; }
    __device__ __forceinline__ const PG8_GAS bf16_t* b_ptr(const Unit& u) const { return Bt + (size_t)u.pm * sB + (size_t)u.pn * tB; }
    __device__ __forceinline__ void a_ready(const Unit&) const {}
    __device__ __forceinline__ void done(const Unit&) const {}
};

constexpr int SWP_MARK = 4096;
struct ProjDesc {
    const PG8_GAS bf16_t* H; const PG8_GAS bf16_t* Wnat; const PG8_GAS bf16_t* Wswp; int K, lda, ldb; StaticOrder On, Os; int nnat;
    __device__ __forceinline__ bool next(int i, Unit& u) const {
        if (i < nnat) return On.next(i, u);
        if (!Os.next(i - nnat, u)) return false;
        u.pn += SWP_MARK; return true; }
    __device__ __forceinline__ const PG8_GAS bf16_t* a_ptr(const Unit& u) const { return u.pn >= SWP_MARK ? Wswp + (size_t)u.pm * BM * lda : H + (size_t)u.pm * BM * lda; }
    __device__ __forceinline__ const PG8_GAS bf16_t* b_ptr(const Unit& u) const { return u.pn >= SWP_MARK ? H + (size_t)(u.pn - SWP_MARK) * BM * ldb : Wnat + (size_t)u.pn * BM * ldb; }
    __device__ __forceinline__ void a_ready(const Unit&) const {}
    __device__ __forceinline__ void done(const Unit&) const {}
};

struct RetDesc {
    const PG8_GAS bf16_t* AQq; const PG8_GAS bf16_t* KB; const PG8_GAS bf16_t* BQ; const PG8_GAS bf16_t* KTB; int K, lda, ldb, G, c, ns;
    __device__ __forceinline__ bool next(int i, Unit& u) const {
        if (i < ns) { u.pm = i * G + c; u.pn = SWP_MARK; return true; }
        const int L = (i - ns) * G + c; if (L >= 512) return false; u.pm = L >> 1; u.pn = L & 1; return true; }
    __device__ __forceinline__ const PG8_GAS bf16_t* a_ptr(const Unit& u) const { return u.pn >= SWP_MARK ? AQq + (size_t)u.pm * 131072 : BQ + (size_t)u.pm * 262144 + (size_t)u.pn * 131072; }
    __device__ __forceinline__ const PG8_GAS bf16_t* b_ptr(const Unit& u) const { return u.pn >= SWP_MARK ? KB + (size_t)u.pm * 65536 : KTB + (size_t)u.pm * 65536; }
    __device__ __forceinline__ void a_ready(const Unit&) const {}
    __device__ __forceinline__ void done(const Unit&) const {}
};

__device__ __forceinline__ unsigned cvt_pk_bf16(float lo, float hi) { unsigned r; asm volatile("v_cvt_pk_bf16_f32 %0, %1, %2" : "=v"(r) : "v"(lo), "v"(hi)); return r; }
__device__ __forceinline__ float bflo(unsigned w) { return __uint_as_float(w << 16); }
__device__ __forceinline__ float bfhi(unsigned w) { return __uint_as_float(w & 0xffff0000u); }
__device__ __forceinline__ float sigmoidf_(float x) { return __builtin_amdgcn_rcpf(1.0f + __expf(-x)); }
__device__ __forceinline__ float siluf_(float x) { return x * sigmoidf_(x); }
typedef unsigned u32x2 __attribute__((ext_vector_type(2)));

struct EpiProj {
    static constexpr bool PERM = true, AFTER_DRAIN = false; static constexpr int MID_T = 0;
    PG8_GAS bf16_t* O; int ldc;
    __device__ __forceinline__ void operator()(const f32x4 (&acc)[2][2][4][2], const Unit& u, int wr, int wc, int fr, int fq) const {
        const int row0 = u.pm * BM + wr * 64 + fr, col0 = u.pn * BM + wc * 32 + 8 * fq;
#pragma unroll
        for (int ai = 0; ai < 2; ++ai)
#pragma unroll
            for (int m = 0; m < 4; ++m) { PG8_GAS bf16_t* rowp = O + (size_t)(row0 + ai * HALF + m * 16) * ldc + col0;
#pragma unroll
                for (int bj = 0; bj < 2; ++bj) { const f32x4 v0 = acc[ai][bj][m][0], v1 = acc[ai][bj][m][1];
                    u32x4 w; w.x = cvt_pk_bf16(v0[0], v0[1]); w.y = cvt_pk_bf16(v0[2], v0[3]); w.z = cvt_pk_bf16(v1[0], v1[1]); w.w = cvt_pk_bf16(v1[2], v1[3]);
                    *(PG8_GAS u32x4*)(rowp + bj * HALF) = w; } }
    }
};
struct EpiSigMulF32 {
    static constexpr bool PERM = false, AFTER_DRAIN = false; static constexpr int MID_T = 0;
    const PG8_GAS bf16_t* gate; int ldg; PG8_GAS float* T; int ldc;
    __device__ __forceinline__ void operator()(const f32x4 (&acc)[2][2][4][2], const Unit& u, int wr, int wc, int fr, int fq) const {
        const int row0 = u.pm * BM + wr * 64 + fr, col0 = u.pn * BM + wc * 32 + 4 * fq;
#pragma unroll
        for (int ai = 0; ai < 2; ++ai)
#pragma unroll
            for (int m = 0; m < 4; ++m) { const size_t r = (size_t)(row0 + ai * HALF + m * 16);
#pragma unroll
                for (int bj = 0; bj < 2; ++bj)
#pragma unroll
                    for (int n = 0; n < 2; ++n) { const int c = col0 + bj * HALF + n * 16;
                        const u32x2 gw = *(const PG8_GAS u32x2*)(gate + r * ldg + c);
                        f32x4 s; s[0] = sigmoidf_(bflo(gw.x)); s[1] = sigmoidf_(bfhi(gw.x)); s[2] = sigmoidf_(bflo(gw.y)); s[3] = sigmoidf_(bfhi(gw.y));
                        *(PG8_GAS f32x4*)(T + r * ldc + c) = acc[ai][bj][m][n] * s; } }
    }
};
struct EpiMerge {
    static constexpr bool PERM = true, AFTER_DRAIN = false; static constexpr int MID_T = 0;
    const PG8_GAS float* T; int ldt; const PG8_GAS bf16_t* gate; int ldg; PG8_GAS bf16_t* O; int ldc;
    __device__ __forceinline__ void operator()(const f32x4 (&acc)[2][2][4][2], const Unit& u, int wr, int wc, int fr, int fq) const {
        const int row0 = u.pm * BM + wr * 64 + fr, col0 = u.pn * BM + wc * 32 + 8 * fq;
#pragma unroll
        for (int ai = 0; ai < 2; ++ai)
#pragma unroll
            for (int m = 0; m < 4; ++m) { const size_t r = (size_t)(row0 + ai * HALF + m * 16);
#pragma unroll
                for (int bj = 0; bj < 2; ++bj) { const int c = col0 + bj * HALF;
                    const u32x4 gw = *(const PG8_GAS u32x4*)(gate + r * ldg + c);
                    const f32x4 t0 = *(const PG8_GAS f32x4*)(T + r * ldt + c), t1 = *(const PG8_GAS f32x4*)(T + r * ldt + c + 4);
                    f32x4 s0, s1; s0[0] = sigmoidf_(bflo(gw.x)); s0[1] = sigmoidf_(bfhi(gw.x)); s0[2] = sigmoidf_(bflo(gw.y)); s0[3] = sigmoidf_(bfhi(gw.y));
                    s1[0] = sigmoidf_(bflo(gw.z)); s1[1] = sigmoidf_(bfhi(gw.z)); s1[2] = sigmoidf_(bflo(gw.w)); s1[3] = sigmoidf_(bfhi(gw.w));
                    const f32x4 v0 = t0 + s0 * acc[ai][bj][m][0], v1 = t1 + s1 * acc[ai][bj][m][1];
                    u32x4 w; w.x = cvt_pk_bf16(v0[0], v0[1]); w.y = cvt_pk_bf16(v0[2], v0[3]); w.z = cvt_pk_bf16(v1[0], v1[1]); w.w = cvt_pk_bf16(v1[2], v1[3]);
                    *(PG8_GAS u32x4*)(O + r * ldc + c) = w; } }
    }
};
struct EpiRes {
    static constexpr bool PERM = true, AFTER_DRAIN = false; static constexpr int MID_T = 0;
    const PG8_GAS void* base; PG8_GAS void* out; int ldc; bool base_f32, out_f32; PG8_GAS float* ps;
    __device__ __forceinline__ static float ssq8(const u32x4 w) { return ((bflo(w.x) * bflo(w.x) + bfhi(w.x) * bfhi(w.x)) + (bflo(w.y) * bflo(w.y) + bfhi(w.y) * bfhi(w.y))) + ((bflo(w.z) * bflo(w.z) + bfhi(w.z) * bfhi(w.z)) + (bflo(w.w) * bflo(w.w) + bfhi(w.w) * bfhi(w.w))); }
    __device__ __forceinline__ void put_ps(float q, int row, int slot, int fq) const {
        ps[(size_t)row * 128 + slot * 4 + fq] = q;
    }
    __device__ __forceinline__ void operator()(const f32x4 (&acc)[2][2][4][2], const Unit& u, int wr, int wc, int fr, int fq) const {
        const int row0 = u.pm * BM + wr * 64 + fr, col0 = u.pn * BM + wc * 32 + 8 * fq, slot = u.pn * 4 + wc;
        if (base_f32) {
#pragma unroll
            for (int ai = 0; ai < 2; ++ai) {
                f32x4 v[4][2][2];
#pragma unroll
                for (int m = 0; m < 4; ++m) { const size_t off = (size_t)(row0 + ai * HALF + m * 16) * ldc + col0;
#pragma unroll
                    for (int bj = 0; bj < 2; ++bj) { v[m][bj][0] = *(const PG8_GAS f32x4*)((const PG8_GAS float*)base + off + bj * HALF); v[m][bj][1] = *(const PG8_GAS f32x4*)((const PG8_GAS float*)base + off + bj * HALF + 4); } }
#pragma unroll
                for (int m = 0; m < 4; ++m) { const size_t off = (size_t)(row0 + ai * HALF + m * 16) * ldc + col0; float q = 0.f;
#pragma unroll
                    for (int bj = 0; bj < 2; ++bj) { const f32x4 v0 = v[m][bj][0] + acc[ai][bj][m][0], v1 = v[m][bj][1] + acc[ai][bj][m][1];
                        if (out_f32) { *(PG8_GAS f32x4*)((PG8_GAS float*)out + off + bj * HALF) = v0; *(PG8_GAS f32x4*)((PG8_GAS float*)out + off + bj * HALF + 4) = v1; }
                        else { u32x4 w; w.x = cvt_pk_bf16(v0[0], v0[1]); w.y = cvt_pk_bf16(v0[2], v0[3]); w.z = cvt_pk_bf16(v1[0], v1[1]); w.w = cvt_pk_bf16(v1[2], v1[3]); q += ssq8(w);
                            *(PG8_GAS u32x4*)((PG8_GAS bf16_t*)out + off + bj * HALF) = w; } }
                    if (ps) put_ps(q, row0 + ai * HALF + m * 16, slot, fq); }
            }
        } else {
            u32x4 w[8][2];
#define ER_LOAD(s_) do { const size_t off_ = (size_t)(row0 + ((s_) >> 2) * HALF + ((s_) & 3) * 16) * ldc + col0; \
    w[s_][0] = *(const PG8_GAS u32x4*)((const PG8_GAS bf16_t*)base + off_); w[s_][1] = *(const PG8_GAS u32x4*)((const PG8_GAS bf16_t*)base + off_ + HALF); } while (0)
#pragma unroll
            for (int s_ = 0; s_ < 4; ++s_) ER_LOAD(s_);
#pragma unroll
            for (int s_ = 0; s_ < 8; ++s_) { const int ai = s_ >> 2, m = s_ & 3; const size_t off = (size_t)(row0 + ai * HALF + m * 16) * ldc + col0; float q = 0.f;
#pragma unroll
                for (int bj = 0; bj < 2; ++bj) { const u32x4 b = w[s_][bj];
                    const f32x4 v0 = (f32x4){bflo(b.x), bfhi(b.x), bflo(b.y), bfhi(b.y)} + acc[ai][bj][m][0], v1 = (f32x4){bflo(b.z), bfhi(b.z), bflo(b.w), bfhi(b.w)} + acc[ai][bj][m][1];
                    if (out_f32) { *(PG8_GAS f32x4*)((PG8_GAS float*)out + off + bj * HALF) = v0; *(PG8_GAS f32x4*)((PG8_GAS float*)out + off + bj * HALF + 4) = v1; }
                    else { u32x4 o; o.x = cvt_pk_bf16(v0[0], v0[1]); o.y = cvt_pk_bf16(v0[2], v0[3]); o.z = cvt_pk_bf16(v1[0], v1[1]); o.w = cvt_pk_bf16(v1[2], v1[3]); q += ssq8(o);
                        *(PG8_GAS u32x4*)((PG8_GAS bf16_t*)out + off + bj * HALF) = o; } }
                if (s_ + 4 < 8) ER_LOAD(s_ + 4);
                if (ps) put_ps(q, row0 + ai * HALF + m * 16, slot, fq); }
#undef ER_LOAD
        }
    }
};
struct EpiSwiGLU {
    static constexpr bool PERM = true, AFTER_DRAIN = false; static constexpr int MID_T = 0;
    PG8_GAS bf16_t* O; int ldc; const PG8_GAS float* rs;
    static constexpr bool RS_LDS = true;
    __device__ __forceinline__ const PG8_GAS float* rs_base(const Unit& u) const { return rs ? rs + (size_t)u.pm * BM : (const PG8_GAS float*)nullptr; }
    __device__ __forceinline__ void operator()(const f32x4 (&acc)[2][2][4][2], const Unit& u, int wr, int wc, int fr, int fq, const PG8_LAS float* rsl) const {
        const int row0 = u.pm * BM + wr * 64 + fr, col0 = u.pn * HALF + wc * 32 + 8 * fq;
        float rsv[2][4];
#pragma unroll
        for (int ai = 0; ai < 2; ++ai)
#pragma unroll
            for (int m = 0; m < 4; ++m) rsv[ai][m] = rsl[wr * 64 + fr + ai * HALF + m * 16];
#pragma unroll
        for (int ai = 0; ai < 2; ++ai)
#pragma unroll
            for (int m = 0; m < 4; ++m) { PG8_GAS bf16_t* rowp = O + (size_t)(row0 + ai * HALF + m * 16) * ldc + col0; const float r_ = rsv[ai][m];
                const f32x4 g0 = acc[ai][0][m][0] * r_, g1 = acc[ai][0][m][1] * r_, u0 = acc[ai][1][m][0] * r_, u1 = acc[ai][1][m][1] * r_;
                f32x4 v0, v1;
#pragma unroll
                for (int j = 0; j < 4; ++j) { v0[j] = siluf_(g0[j]) * u0[j]; v1[j] = siluf_(g1[j]) * u1[j]; }
                u32x4 w; w.x = cvt_pk_bf16(v0[0], v0[1]); w.y = cvt_pk_bf16(v0[2], v0[3]); w.z = cvt_pk_bf16(v1[0], v1[1]); w.w = cvt_pk_bf16(v1[2], v1[3]);
                *(PG8_GAS u32x4*)rowp = w; }
    }
};

struct EpiProjNat {
    static constexpr bool PERM = true, AFTER_DRAIN = false; static constexpr int MID_T = 0;
    PG8_GAS bf16_t* PROJ; int ldp; PG8_GAS bf16_t* AQ; PG8_GAS bf16_t* KB; const PG8_GAS float* rs;
    PG8_GAS bf16_t* QKN; const PG8_GAS float* qg; const PG8_GAS float* kg; PG8_GAS float* kmean; PG8_LAS float* xl; float eps;
    __device__ __forceinline__ static float dpp_row_sum(float x) {
        x += __builtin_bit_cast(float, __builtin_amdgcn_update_dpp(0, __builtin_bit_cast(int, x), 0xB1, 0xf, 0xf, true));
        x += __builtin_bit_cast(float, __builtin_amdgcn_update_dpp(0, __builtin_bit_cast(int, x), 0x4E, 0xf, 0xf, true));
        x += __builtin_bit_cast(float, __builtin_amdgcn_update_dpp(0, __builtin_bit_cast(int, x), 0x141, 0xf, 0xf, true));
        x += __builtin_bit_cast(float, __builtin_amdgcn_update_dpp(0, __builtin_bit_cast(int, x), 0x140, 0xf, 0xf, true));
        return x; }
    __device__ __forceinline__ void qk(const f32x4 (&acc)[2][2][4][2], const Unit& u, int wr, int wc, int fr, int fq, const PG8_LAS float* rsl) const {
        const int isk = u.pn >= 4 ? 1 : 0, h0 = 2 * (u.pn & 3);
        PG8_LAS float* SS = xl;
        PG8_LAS float* KM = xl + 4096;
        const PG8_GAS float* gp = (isk ? kg : qg) + wc * 32 + fq * 8;
        const f32x4 ga = *(const PG8_GAS f32x4*)gp, gb = *(const PG8_GAS f32x4*)(gp + 4);
        float rsv[2][4];
#pragma unroll
        for (int ai = 0; ai < 2; ++ai)
#pragma unroll
            for (int m = 0; m < 4; ++m) rsv[ai][m] = rsl[wr * 64 + fr + ai * HALF + m * 16];
#pragma unroll
        for (int ai = 0; ai < 2; ++ai)
#pragma unroll
            for (int m = 0; m < 4; ++m) { const int rowl = wr * 64 + fr + ai * HALF + m * 16; const float r_ = rsv[ai][m];
#pragma unroll
                for (int bj = 0; bj < 2; ++bj) { const f32x4 a = acc[ai][bj][m][0] * r_, b = acc[ai][bj][m][1] * r_;
                    float q = ((a[0] * a[0] + a[1] * a[1]) + (a[2] * a[2] + a[3] * a[3])) + ((b[0] * b[0] + b[1] * b[1]) + (b[2] * b[2] + b[3] * b[3]));
                    unsigned qa_ = __builtin_bit_cast(unsigned, q), qb_ = qa_; asm volatile("" : "+v"(qb_));
                    const auto rr = __builtin_amdgcn_permlane32_swap(qa_, qb_, false, false);
                    { const unsigned r0_ = rr[0], r1_ = rr[1]; q = __builtin_bit_cast(float, r0_) + __builtin_bit_cast(float, r1_); }
                    asm volatile("" : "+v"(q));
                    SS[((rowl * 2 + bj) * 4 + wc) * 2 + (fq & 1)] = q; } }
        __syncthreads();
#pragma unroll
        for (int bj = 0; bj < 2; ++bj) {
            float rn[2][4], cs[8];
#pragma unroll
            for (int k = 0; k < 8; ++k) cs[k] = 0.f;
#pragma unroll
            for (int ai = 0; ai < 2; ++ai)
#pragma unroll
                for (int m = 0; m < 4; ++m) { const int rowl = wr * 64 + fr + ai * HALF + m * 16;
                    const f32x4 s0 = *(const PG8_LAS f32x4*)(SS + (rowl * 2 + bj) * 8), s1 = *(const PG8_LAS f32x4*)(SS + (rowl * 2 + bj) * 8 + 4);
                    const float tot = ((s0[0] + s0[1]) + (s0[2] + s0[3])) + ((s1[0] + s1[1]) + (s1[2] + s1[3]));
                    rn[ai][m] = rsv[ai][m] * (1.0f / __builtin_sqrtf(tot * (1.f / 128.f) + eps)); }
#pragma unroll
            for (int ai = 0; ai < 2; ++ai)
#pragma unroll
                for (int m = 0; m < 4; ++m) { const size_t row = (size_t)u.pm * BM + wr * 64 + fr + ai * HALF + m * 16;
                    const float s_ = rn[ai][m]; const f32x4 v0 = acc[ai][bj][m][0] * s_ * ga, v1 = acc[ai][bj][m][1] * s_ * gb;
                    u32x4 w; w.x = cvt_pk_bf16(v0[0], v0[1]); w.y = cvt_pk_bf16(v0[2], v0[3]); w.z = cvt_pk_bf16(v1[0], v1[1]); w.w = cvt_pk_bf16(v1[2], v1[3]);
                    *(PG8_GAS u32x4*)(QKN + row * 2048 + (isk ? 1024 : 0) + (h0 + bj) * 128 + wc * 32 + fq * 8) = w;
                    cs[0] += bflo(w.x); cs[1] += bfhi(w.x); cs[2] += bflo(w.y); cs[3] += bfhi(w.y); cs[4] += bflo(w.z); cs[5] += bfhi(w.z); cs[6] += bflo(w.w); cs[7] += bfhi(w.w); }
            if (isk) {
#pragma unroll
                for (int k = 0; k < 8; ++k) { float t_ = dpp_row_sum(cs[k]); asm volatile("" : "+v"(t_)); if (fr == 0) KM[wr * 256 + bj * 128 + wc * 32 + fq * 8 + k] = t_; } }
        }
        if (isk) {
            __syncthreads();
            const int tid_ = ((wr * 4 + wc) * 4 + fq) * 16 + fr;
            if (tid_ < 256) { const int b_ = u.pm >> 5, n_ = u.pm & 31;
                kmean[(size_t)((b_ * 8 + h0 + (tid_ >> 7)) * 32 + n_) * 128 + (tid_ & 127)] = (KM[tid_] + KM[256 + tid_]) * (1.f / 256.f); }
        }
    }
    __device__ __forceinline__ void operator()(const f32x4 (&acc)[2][2][4][2], const Unit& u, int wr, int wc, int fr, int fq, const PG8_LAS float* rsl) const {
        if (u.pn < 8) { qk(acc, u, wr, wc, fr, fq, rsl); return; }
        PG8_GAS bf16_t* base; int ldc;
        float rsv[2][4];
#pragma unroll
        for (int ai = 0; ai < 2; ++ai)
#pragma unroll
            for (int m = 0; m < 4; ++m) rsv[ai][m] = rsl[wr * 64 + fr + ai * HALF + m * 16];
        if (u.pn < 36) { base = PROJ + (size_t)u.pm * BM * ldp + u.pn * BM; ldc = ldp; }
        else { const int isk = u.pn >= 40, h = (u.pn - 36) & 3, c = ((u.pm >> 5) * 4 + h) * 32 + (u.pm & 31);
            if (isk) { base = KB + (size_t)c * 65536; ldc = 256; } else { base = AQ + (size_t)c * 131072 + 256; ldc = 512; } }
        const int row0 = wr * 64 + fr, col0 = wc * 32 + 8 * fq;
#pragma unroll
        for (int ai = 0; ai < 2; ++ai)
#pragma unroll
            for (int m = 0; m < 4; ++m) { PG8_GAS bf16_t* rowp = base + (size_t)(row0 + ai * HALF + m * 16) * ldc + col0; const float r_ = rsv[ai][m];
#pragma unroll
                for (int bj = 0; bj < 2; ++bj) { const f32x4 v0 = acc[ai][bj][m][0] * r_, v1 = acc[ai][bj][m][1] * r_;
                    u32x4 w; w.x = cvt_pk_bf16(v0[0], v0[1]); w.y = cvt_pk_bf16(v0[2], v0[3]); w.z = cvt_pk_bf16(v1[0], v1[1]); w.w = cvt_pk_bf16(v1[2], v1[3]);
                    *(PG8_GAS u32x4*)(rowp + bj * HALF) = w; } }
    }
};
struct EpiSwap {
    static constexpr bool PERM = true, AFTER_DRAIN = false; static constexpr int MID_T = 0;
    PG8_GAS bf16_t* KTB; PG8_GAS bf16_t* BQ; const PG8_GAS float* rs;
    __device__ __forceinline__ void operator()(const f32x4 (&acc)[2][2][4][2], const Unit& u, int wr, int wc, int fr, int fq, const PG8_LAS float* rsl) const {
        const int b = u.pn >> 5, n = u.pn & 31; PG8_GAS bf16_t* base; int ldc; float lg = 0.f, mul = 1.f;
        { const int h = u.pm >> 1, half = u.pm & 1, c = (b * 4 + h) * 32 + n; base = BQ + (size_t)c * 262144 + (size_t)half * 131072; ldc = 512;
            lg = -__log2f(1.0f - exp2f(-5.0f - (float)h)); mul = 0.0625f; }
        asm volatile("" : "+v"(fr), "+v"(fq));
        const int row0 = wr * 64 + fr, col0 = wc * 32 + 8 * fq;
        f32x4 sc[2][2];
#pragma unroll
        for (int bj = 0; bj < 2; ++bj)
#pragma unroll
            for (int n2 = 0; n2 < 2; ++n2)
#pragma unroll
                for (int k = 0; k < 4; ++k) sc[bj][n2][k] = mul * exp2f(lg * (float)(col0 + bj * HALF + 4 * n2 + k + 1)) * rsl[col0 + bj * HALF + 4 * n2 + k];
#pragma unroll
        for (int ai = 0; ai < 2; ++ai)
#pragma unroll
            for (int m = 0; m < 4; ++m) { PG8_GAS bf16_t* rowp = base + (size_t)(row0 + ai * HALF + m * 16) * ldc + col0;
#pragma unroll
                for (int bj = 0; bj < 2; ++bj) { const f32x4 v0 = acc[ai][bj][m][0] * sc[bj][0], v1 = acc[ai][bj][m][1] * sc[bj][1];
                    u32x4 w; w.x = cvt_pk_bf16(v0[0], v0[1]); w.y = cvt_pk_bf16(v0[2], v0[3]); w.z = cvt_pk_bf16(v1[0], v1[1]); w.w = cvt_pk_bf16(v1[2], v1[3]);
                    *(PG8_GAS u32x4*)(rowp + bj * HALF) = w; } }
    }
};
struct EpiProjBoth {
    static constexpr bool PERM = true, AFTER_DRAIN = false; static constexpr int MID_T = 0;
    EpiProjNat N; EpiSwap S;
    static constexpr bool RS_LDS = true;
    __device__ __forceinline__ const PG8_GAS float* rs_base(const Unit& u) const { return N.rs ? N.rs + (size_t)(u.pn >= SWP_MARK ? u.pn - SWP_MARK : u.pm) * BM : (const PG8_GAS float*)nullptr; }
    __device__ __forceinline__ void operator()(const f32x4 (&acc)[2][2][4][2], const Unit& u, int wr, int wc, int fr, int fq, const PG8_LAS float* rsl) const {
        if (u.pn >= SWP_MARK) { Unit v = u; v.pn -= SWP_MARK; S(acc, v, wr, wc, fr, fq, rsl); } else N(acc, u, wr, wc, fr, fq, rsl);
    }
};
struct EpiS {
    static constexpr bool PERM = true, AFTER_DRAIN = false; static constexpr int MID_T = 0;
    PG8_GAS bf16_t* AQ;
    __device__ __forceinline__ void operator()(const f32x4 (&acc)[2][2][4][2], const Unit& u, int wr, int wc, int fr, int fq) const {
        PG8_GAS bf16_t* base = AQ + (size_t)u.pm * 131072;
        asm volatile("" : "+v"(fr), "+v"(fq));
        const int row0 = wr * 64 + fr, col0 = wc * 32 + 8 * fq;
#pragma unroll
        for (int ai = 0; ai < 2; ++ai)
#pragma unroll
            for (int m = 0; m < 4; ++m) { const int i = row0 + ai * HALF + m * 16; PG8_GAS bf16_t* rowp = base + (size_t)i * 512 + col0;
#pragma unroll
                for (int bj = 0; bj < 2; ++bj) { f32x4 v0 = acc[ai][bj][m][0], v1 = acc[ai][bj][m][1]; const int j0 = col0 + bj * HALF;
#pragma unroll
                    for (int k = 0; k < 4; ++k) { if (j0 + k > i) v0[k] = 0.f; if (j0 + 4 + k > i) v1[k] = 0.f; }
                    u32x4 w; w.x = cvt_pk_bf16(v0[0], v0[1]); w.y = cvt_pk_bf16(v0[2], v0[3]); w.z = cvt_pk_bf16(v1[0], v1[1]); w.w = cvt_pk_bf16(v1[2], v1[3]);
                    *(PG8_GAS u32x4*)(rowp + bj * HALF) = w; } }
    }
};
struct EpiKV {
    static constexpr bool PERM = true, AFTER_DRAIN = false; static constexpr int MID_T = 0;
    PG8_GAS bf16_t* ST;
    __device__ __forceinline__ void operator()(const f32x4 (&acc)[2][2][4][2], const Unit& u, int wr, int wc, int fr, int fq) const {
        const int h = (u.pm >> 5) & 3; const float gC = exp2f(256.0f * __log2f(1.0f - exp2f(-5.0f - (float)h)));
        PG8_GAS bf16_t* base = ST + (size_t)u.pm * 131072 + (size_t)u.pn * 65536;
        const int row0 = wr * 64 + fr, col0 = wc * 32 + 8 * fq;
#pragma unroll
        for (int ai = 0; ai < 2; ++ai)
#pragma unroll
            for (int m = 0; m < 4; ++m) { PG8_GAS bf16_t* rowp = base + (size_t)(row0 + ai * HALF + m * 16) * 256 + col0;
#pragma unroll
                for (int bj = 0; bj < 2; ++bj) { const f32x4 v0 = acc[ai][bj][m][0] * gC, v1 = acc[ai][bj][m][1] * gC;
                    u32x4 w; w.x = cvt_pk_bf16(v0[0], v0[1]); w.y = cvt_pk_bf16(v0[2], v0[3]); w.z = cvt_pk_bf16(v1[0], v1[1]); w.w = cvt_pk_bf16(v1[2], v1[3]);
                    *(PG8_GAS u32x4*)(rowp + bj * HALF) = w; } }
    }
};
struct EpiRetBoth {
    static constexpr bool PERM = true, AFTER_DRAIN = false; static constexpr int MID_T = 0;
    EpiS S; EpiKV KV;
    __device__ __forceinline__ void operator()(const f32x4 (&acc)[2][2][4][2], const Unit& u, int wr, int wc, int fr, int fq) const {
        if (u.pn >= SWP_MARK) S(acc, u, wr, wc, fr, fq); else KV(acc, u, wr, wc, fr, fq);
    }
};
struct EpiO {
    static constexpr bool PERM = true, AFTER_DRAIN = false; static constexpr int MID_T = 0;
    PG8_GAS bf16_t* RET; int seq;
    __device__ __forceinline__ void operator()(const f32x4 (&acc)[2][2][4][2], const Unit& u, int wr, int wc, int fr, int fq) const {
        const int c = u.pm, b = c >> 7, h = (c >> 5) & 3, n = c & 31; const float lg = __log2f(1.0f - exp2f(-5.0f - (float)h));
        PG8_GAS bf16_t* base = RET + ((size_t)b * seq + n * 256) * 2048 + h * 512 + u.pn * 256;
        asm volatile("" : "+v"(fr), "+v"(fq));
        const int row0 = wr * 64 + fr, col0 = wc * 32 + 8 * fq;
#pragma unroll
        for (int ai = 0; ai < 2; ++ai)
#pragma unroll
            for (int m = 0; m < 4; ++m) { const int i = row0 + ai * HALF + m * 16; const float rs = exp2f(lg * (float)(i + 1)); PG8_GAS bf16_t* rowp = base + (size_t)i * 2048 + col0;
#pragma unroll
                for (int bj = 0; bj < 2; ++bj) { const f32x4 v0 = acc[ai][bj][m][0] * rs, v1 = acc[ai][bj][m][1] * rs;
                    u32x4 w; w.x = cvt_pk_bf16(v0[0], v0[1]); w.y = cvt_pk_bf16(v0[2], v0[3]); w.z = cvt_pk_bf16(v1[0], v1[1]); w.w = cvt_pk_bf16(v1[2], v1[3]);
                    *(PG8_GAS u32x4*)(rowp + bj * HALF) = w; } }
    }
};
struct EpiMergeCat {
    static constexpr bool PERM = true, AFTER_DRAIN = false; static constexpr int MID_T = 16;
    const PG8_GAS bf16_t* ga; const PG8_GAS bf16_t* gr; int ldg; PG8_GAS bf16_t* O; int ldc;
    __device__ __forceinline__ static float en(float g) { return __expf(fminf(-g, 80.0f)); }
    __device__ __forceinline__ void mid(f32x4 (&acc)[2][2][4][2], const Unit& u, int wr, int wc, int fr, int fq) const {
        asm volatile("" : "+v"(fr), "+v"(fq));
        const int row0 = u.pm * BM + wr * 64 + fr, col0 = u.pn * BM + wc * 32 + 8 * fq;
        u32x4 wa[8][2], wg[8][2];
#define MC_LOAD(s_) do { const size_t r_ = (size_t)(row0 + ((s_) >> 2) * HALF + ((s_) & 3) * 16); \
    wa[s_][0] = *(const PG8_GAS u32x4*)(ga + r_ * ldg + col0); wa[s_][1] = *(const PG8_GAS u32x4*)(ga + r_ * ldg + col0 + HALF); \
    wg[s_][0] = *(const PG8_GAS u32x4*)(gr + r_ * ldg + col0); wg[s_][1] = *(const PG8_GAS u32x4*)(gr + r_ * ldg + col0 + HALF); } while (0)
        MC_LOAD(0); MC_LOAD(1); MC_LOAD(2);
#pragma unroll
        for (int s_ = 0; s_ < 8; ++s_) { const int ai = s_ >> 2, m = s_ & 3;
            if (s_ + 3 < 8) MC_LOAD(s_ + 3);
#pragma unroll
            for (int bj = 0; bj < 2; ++bj) { const u32x4 a = wa[s_][bj], g = wg[s_][bj];
                f32x4 q0, q1;
                q0[0] = (1.0f + en(bflo(g.x))) * __builtin_amdgcn_rcpf(1.0f + en(bflo(a.x))); q0[1] = (1.0f + en(bfhi(g.x))) * __builtin_amdgcn_rcpf(1.0f + en(bfhi(a.x)));
                q0[2] = (1.0f + en(bflo(g.y))) * __builtin_amdgcn_rcpf(1.0f + en(bflo(a.y))); q0[3] = (1.0f + en(bfhi(g.y))) * __builtin_amdgcn_rcpf(1.0f + en(bfhi(a.y)));
                q1[0] = (1.0f + en(bflo(g.z))) * __builtin_amdgcn_rcpf(1.0f + en(bflo(a.z))); q1[1] = (1.0f + en(bfhi(g.z))) * __builtin_amdgcn_rcpf(1.0f + en(bfhi(a.z)));
                q1[2] = (1.0f + en(bflo(g.w))) * __builtin_amdgcn_rcpf(1.0f + en(bflo(a.w))); q1[3] = (1.0f + en(bfhi(g.w))) * __builtin_amdgcn_rcpf(1.0f + en(bfhi(a.w)));
                acc[ai][bj][m][0] = acc[ai][bj][m][0] * q0; acc[ai][bj][m][1] = acc[ai][bj][m][1] * q1; } }
#undef MC_LOAD
    }
    __device__ __forceinline__ void operator()(const f32x4 (&acc)[2][2][4][2], const Unit& u, int wr, int wc, int fr, int fq) const {
        const int row0 = u.pm * BM + wr * 64 + fr, col0 = u.pn * BM + wc * 32 + 8 * fq;
        u32x4 wg[8][2];
#define MC_LOAD(s_) do { const size_t r_ = (size_t)(row0 + ((s_) >> 2) * HALF + ((s_) & 3) * 16); \
    wg[s_][0] = *(const PG8_GAS u32x4*)(gr + r_ * ldg + col0); wg[s_][1] = *(const PG8_GAS u32x4*)(gr + r_ * ldg + col0 + HALF); } while (0)
#pragma unroll
        for (int s_ = 0; s_ < 4; ++s_) MC_LOAD(s_);
#pragma unroll
        for (int s_ = 0; s_ < 8; ++s_) { const int ai = s_ >> 2, m = s_ & 3; const size_t r = (size_t)(row0 + ai * HALF + m * 16);
#pragma unroll
            for (int bj = 0; bj < 2; ++bj) { const int c = col0 + bj * HALF; const u32x4 g = wg[s_][bj];
                f32x4 s0, s1; s0[0] = __builtin_amdgcn_rcpf(1.0f + en(bflo(g.x))); s0[1] = __builtin_amdgcn_rcpf(1.0f + en(bfhi(g.x))); s0[2] = __builtin_amdgcn_rcpf(1.0f + en(bflo(g.y))); s0[3] = __builtin_amdgcn_rcpf(1.0f + en(bfhi(g.y)));
                s1[0] = __builtin_amdgcn_rcpf(1.0f + en(bflo(g.z))); s1[1] = __builtin_amdgcn_rcpf(1.0f + en(bfhi(g.z))); s1[2] = __builtin_amdgcn_rcpf(1.0f + en(bflo(g.w))); s1[3] = __builtin_amdgcn_rcpf(1.0f + en(bfhi(g.w)));
                const f32x4 v0 = s0 * acc[ai][bj][m][0], v1 = s1 * acc[ai][bj][m][1];
                u32x4 w; w.x = cvt_pk_bf16(v0[0], v0[1]); w.y = cvt_pk_bf16(v0[2], v0[3]); w.z = cvt_pk_bf16(v1[0], v1[1]); w.w = cvt_pk_bf16(v1[2], v1[3]);
                *(PG8_GAS u32x4*)(O + r * ldc + c) = w; }
            if (s_ + 4 < 8) MC_LOAD(s_ + 4); }
#undef MC_LOAD
    }
};
template <class T, class = void> struct has_rs_lds : std::false_type {};
template <class T> struct has_rs_lds<T, std::void_t<decltype(T::RS_LDS)>> : std::true_type {};
template <class Epi, class Desc, bool ALIGN_EPI = false, bool SP2 = false>
__device__ __forceinline__ void gemm_phase(PG8_LAS unsigned char* lds, const Desc& S, const Epi& E, const int tid) {
    const int wid = __builtin_amdgcn_readfirstlane(tid >> 6), lane = tid & 63, wr = wid >> 2, wc = wid & 3, fr = lane & 15, fq = lane >> 4;
    const int K = S.K, nt = K / BK, lda = S.lda, ldb = S.ldb;
    unsigned voffA[2], voffB[2];
#pragma unroll
    for (int i = 0; i < 2; ++i) { int R, C; stage_rc(tid * 16 + i * 8192, R, C); const int Rb = Epi::PERM ? ((R & ~31) + perm32(R & 31)) : R;
        voffA[i] = (unsigned)(R * lda + C) * 2u; voffB[i] = (unsigned)(Rb * ldb + C) * 2u; }
    const size_t kstep = (size_t)(BK * 2);
    const size_t hstepA = (size_t)HALF * lda * 2, hstepB = (size_t)HALF * ldb * 2;
    const unsigned ldsw = (unsigned)wid * 1024u;
    const int aoff = lds_byte(wr * 64 + fr, fq * 8), boff = lds_byte(wc * 32 + fr, fq * 8);
#define PG8_SA(b, h) (((b) * 2 + (h)) * HTB)
#define PG8_SB(b, h) ((4 + (b) * 2 + (h)) * HTB)
#define PG8_STAGE(bufoff, gbase, voff) do { _Pragma("unroll") for (int _i = 0; _i < 2; ++_i) \
        __builtin_amdgcn_global_load_lds((const PG8_GAS unsigned*)((const PG8_GAS char*)(gbase) + (voff)[_i]), (PG8_LAS unsigned*)(lds + (bufoff) + ldsw + _i * 8192), 16, 0, 0); } while (0)
#define PG8_LDA(dst, b, h) do { _Pragma("unroll") for (int m = 0; m < 4; ++m) _Pragma("unroll") for (int k = 0; k < 2; ++k) dst[m][k] = *(const PG8_LAS bf16x8*)(lds + PG8_SA(b, h) + aoff + m * 2048 + k * 1024); } while (0)
#define PG8_LDB(dst, b, h) do { _Pragma("unroll") for (int n = 0; n < 2; ++n) _Pragma("unroll") for (int k = 0; k < 2; ++k) dst[n][k] = *(const PG8_LAS bf16x8*)(lds + PG8_SB(b, h) + boff + n * 2048 + k * 1024); } while (0)
#define PG8_MMA(ai, bj, At, Bt) do { __builtin_amdgcn_s_setprio(1); _Pragma("unroll") for (int m = 0; m < 4; ++m) _Pragma("unroll") for (int n = 0; n < 2; ++n) _Pragma("unroll") for (int k = 0; k < 2; ++k) \
        acc[ai][bj][m][n] = __builtin_amdgcn_mfma_f32_16x16x32_bf16(Bt[n][k], At[m][k], acc[ai][bj][m][n], 0, 0, 0); __builtin_amdgcn_s_setprio(0); } while (0)
#define PG8_WAIT_V(n) asm volatile("s_waitcnt vmcnt(" #n ")" ::: "memory")
#define PG8_WAIT_L(n) asm volatile("s_waitcnt lgkmcnt(" #n ")" ::: "memory")
#define PG8_BAR __builtin_amdgcn_s_barrier()
#define PG8_SCHED __builtin_amdgcn_sched_barrier(0)
    Unit cur, nxt; int ui = 0;
    if (!S.next(0, cur)) return;
    if constexpr (has_rs_lds<Epi>::value) { const PG8_GAS float* rb_ = E.rs_base(cur); if (rb_ != nullptr && wid == 0) __builtin_amdgcn_global_load_lds((const PG8_GAS unsigned*)(rb_ + lane * 4), (PG8_LAS unsigned*)(lds + STAGE_BYTES), 16, 0, 0); }
    f32x4 acc[2][2][4][2];
#pragma unroll
    for (int a = 0; a < 2; ++a)
#pragma unroll
        for (int b = 0; b < 2; ++b)
#pragma unroll
            for (int m = 0; m < 4; ++m)
#pragma unroll
                for (int n = 0; n < 2; ++n) acc[a][b][m][n] = (f32x4){0.f, 0.f, 0.f, 0.f};
    bf16x8 At[4][2], B0[2][2], B1[2][2];
    const PG8_GAS char* cA = (const PG8_GAS char*)S.a_ptr(cur); const PG8_GAS char* cB = (const PG8_GAS char*)S.b_ptr(cur);
    S.a_ready(cur);
    if constexpr (SP2) {
        PG8_STAGE(PG8_SB(0, 0), cB, voffB); PG8_STAGE(PG8_SB(0, 1), cB + hstepB, voffB); PG8_STAGE(PG8_SA(0, 0), cA, voffA); PG8_STAGE(PG8_SA(0, 1), cA + hstepA, voffA);
        if (wr == 1) PG8_BAR;
        PG8_WAIT_V(2); PG8_BAR;
        PG8_STAGE(PG8_SB(1, 0), cB + kstep, voffB); PG8_STAGE(PG8_SA(1, 0), cA + kstep, voffA); PG8_STAGE(PG8_SB(1, 1), cB + hstepB + kstep, voffB);
        PG8_WAIT_V(6); PG8_BAR;
    } else {
        PG8_STAGE(PG8_SB(0, 0), cB, voffB); PG8_STAGE(PG8_SA(0, 0), cA, voffA); PG8_STAGE(PG8_SB(0, 1), cB + hstepB, voffB); PG8_STAGE(PG8_SA(0, 1), cA + hstepA, voffA);
        if (wr == 1) PG8_BAR;
        PG8_WAIT_V(4); PG8_BAR;
        PG8_STAGE(PG8_SB(1, 0), cB + kstep, voffB); PG8_STAGE(PG8_SA(1, 0), cA + kstep, voffA); PG8_STAGE(PG8_SB(1, 1), cB + hstepB + kstep, voffB);
        PG8_WAIT_V(6); PG8_BAR;
    }
    for (;;) {
        const bool has_next = S.next(ui + 1, nxt);
        const PG8_GAS char* nA = has_next ? (const PG8_GAS char*)S.a_ptr(nxt) : cA; const PG8_GAS char* nB = has_next ? (const PG8_GAS char*)S.b_ptr(nxt) : cB;
        for (int t = 0; t < nt; t += 2) {
            const bool last = (t == nt - 2);
            const PG8_GAS char* a1 = cA + (size_t)(t + 1) * kstep;
            const PG8_GAS char* a2 = last ? nA : cA + (size_t)(t + 2) * kstep; const PG8_GAS char* b2 = last ? nB : cB + (size_t)(t + 2) * kstep;
            const PG8_GAS char* a3 = a2 + kstep; const PG8_GAS char* b3 = b2 + kstep;
            if (last && has_next) S.a_ready(nxt);
            if constexpr (Epi::MID_T > 0) { if (t == Epi::MID_T) E.mid(acc, cur, wr, wc, fr, fq); }
            if constexpr (SP2) {
            PG8_LDB(B0, 0, 0); PG8_LDB(B1, 0, 1); PG8_SCHED; PG8_LDA(At, 0, 0); PG8_STAGE(PG8_SA(1, 1), a1 + hstepA, voffA);
            PG8_WAIT_V(8); PG8_WAIT_L(0); PG8_BAR; PG8_MMA(0, 0, At, B0); PG8_MMA(0, 1, At, B1); PG8_BAR; PG8_SCHED;
            PG8_LDA(At, 0, 1); PG8_STAGE(PG8_SB(0, 0), b2, voffB); PG8_STAGE(PG8_SB(0, 1), b2 + hstepB, voffB); PG8_STAGE(PG8_SA(0, 0), a2, voffA);
            PG8_WAIT_V(8); PG8_WAIT_L(0); PG8_BAR; PG8_MMA(1, 0, At, B0); PG8_MMA(1, 1, At, B1); PG8_BAR; PG8_SCHED;
            PG8_LDB(B0, 1, 0); PG8_LDB(B1, 1, 1); PG8_SCHED; PG8_LDA(At, 1, 0); PG8_STAGE(PG8_SA(0, 1), a2 + hstepA, voffA);
            PG8_WAIT_V(8); PG8_WAIT_L(0); PG8_BAR; PG8_MMA(0, 0, At, B0); PG8_MMA(0, 1, At, B1); PG8_BAR; PG8_SCHED;
            PG8_LDA(At, 1, 1); PG8_STAGE(PG8_SB(1, 0), b3, voffB); PG8_STAGE(PG8_SB(1, 1), b3 + hstepB, voffB); PG8_STAGE(PG8_SA(1, 0), a3, voffA);
            PG8_WAIT_V(8); PG8_WAIT_L(0); PG8_BAR; PG8_MMA(1, 0, At, B0); PG8_MMA(1, 1, At, B1); PG8_BAR; PG8_SCHED;
            } else {
            PG8_LDB(B0, 0, 0); PG8_SCHED; PG8_LDA(At, 0, 0); PG8_STAGE(PG8_SA(1, 1), a1 + hstepA, voffA);
            PG8_WAIT_L(8); PG8_BAR; PG8_WAIT_L(0); PG8_MMA(0, 0, At, B0); PG8_BAR; PG8_SCHED;
            PG8_LDB(B1, 0, 1); PG8_STAGE(PG8_SB(0, 0), b2, voffB);
            PG8_BAR; PG8_WAIT_L(0); PG8_MMA(0, 1, At, B1); PG8_BAR;
            PG8_LDA(At, 0, 1); PG8_STAGE(PG8_SA(0, 0), a2, voffA);
            PG8_BAR; PG8_WAIT_L(0); PG8_MMA(1, 0, At, B0); PG8_BAR; PG8_SCHED;
            PG8_STAGE(PG8_SB(0, 1), b2 + hstepB, voffB);
            PG8_WAIT_V(6); PG8_BAR; PG8_MMA(1, 1, At, B1); PG8_BAR;
            PG8_LDB(B0, 1, 0); PG8_SCHED; PG8_LDA(At, 1, 0); PG8_STAGE(PG8_SA(0, 1), a2 + hstepA, voffA);
            PG8_WAIT_L(8); PG8_BAR; PG8_WAIT_L(0); PG8_MMA(0, 0, At, B0); PG8_BAR; PG8_SCHED;
            PG8_LDB(B1, 1, 1); PG8_STAGE(PG8_SB(1, 0), b3, voffB);
            PG8_BAR; PG8_WAIT_L(0); PG8_MMA(0, 1, At, B1); PG8_BAR;
            PG8_LDA(At, 1, 1); PG8_STAGE(PG8_SA(1, 0), a3, voffA);
            PG8_BAR; PG8_WAIT_L(0); PG8_MMA(1, 0, At, B0); PG8_BAR; PG8_SCHED;
            PG8_STAGE(PG8_SB(1, 1), b3 + hstepB, voffB);
            PG8_WAIT_V(6); PG8_BAR; PG8_MMA(1, 1, At, B1); PG8_BAR;
            }
        }
        if constexpr (ALIGN_EPI) { if (wr == 0) PG8_BAR; }
        if constexpr (has_rs_lds<Epi>::value) { E(acc, cur, wr, wc, fr, fq, (const PG8_LAS float*)(lds + STAGE_BYTES + (ui & 1) * 1024)); S.done(cur); } else
        if constexpr (!Epi::AFTER_DRAIN) { E(acc, cur, wr, wc, fr, fq); S.done(cur); }
        if (!has_next) break;
#pragma unroll
        for (int a = 0; a < 2; ++a)
#pragma unroll
            for (int b = 0; b < 2; ++b)
#pragma unroll
                for (int m = 0; m < 4; ++m)
#pragma unroll
                    for (int n = 0; n < 2; ++n) acc[a][b][m][n] = (f32x4){0.f, 0.f, 0.f, 0.f};
        cur = nxt; cA = nA; cB = nB; ++ui;
        if constexpr (has_rs_lds<Epi>::value) { const PG8_GAS float* rb_ = E.rs_base(cur); if (rb_ != nullptr && wid == 0) __builtin_amdgcn_global_load_lds((const PG8_GAS unsigned*)(rb_ + lane * 4), (PG8_LAS unsigned*)(lds + STAGE_BYTES + (ui & 1) * 1024), 16, 0, 0); }
        if constexpr (ALIGN_EPI) { if (wr == 1) PG8_BAR; }
    }
    PG8_WAIT_V(0);
    if constexpr (!ALIGN_EPI) { if (wr == 0) PG8_BAR; }
    PG8_BAR;
    if constexpr (Epi::AFTER_DRAIN) { E.fused(acc, cur, wr, wc, fr, fq, lds, wid, lane); S.done(cur); }
#undef PG8_SA
#undef PG8_SB
#undef PG8_STAGE
#undef PG8_LDA
#undef PG8_LDB
#undef PG8_MMA
#undef PG8_WAIT_V
#undef PG8_WAIT_L
#undef PG8_BAR
#undef PG8_SCHED
}
}

namespace att {
typedef short bf16x8 __attribute__((ext_vector_type(8)));
typedef short s16x4 __attribute__((ext_vector_type(4)));
typedef float f32x16 __attribute__((ext_vector_type(16)));
typedef float f32x8v __attribute__((ext_vector_type(8)));
typedef unsigned u32x4 __attribute__((ext_vector_type(4)));
constexpr int D = 128, NW = 8, QBLK = 32, KVBLK = 64;
constexpr float SCALE = 0.088388347648318440f, LOG2E = 1.4426950408889634f, CS = SCALE * LOG2E;
constexpr int SHM_V = KVBLK * D * 2, SHM_K = KVBLK * D * 2;
constexpr int OFF_V = 0, OFF_K = 2 * SHM_V, OFF_WS = 2 * SHM_V + 2 * SHM_K, OFF_MISC = OFF_WS + NW * 256;
constexpr int OFF_Q = OFF_MISC + 256, OFF_PREF = OFF_Q + NW * 8192, ATT_LDS = OFF_PREF + 516 * 4 + 512 * 4;
constexpr int ATT_LDS_OLD = OFF_PREF;
#define KSWZ(row, colB) ((row) * 256 + ((colB) ^ (((row) & 7) << 4)))
#define SBAR() __builtin_amdgcn_sched_barrier(0)
__device__ __forceinline__ int crow(int r, int hi) { return (r & 3) + 8 * (r >> 2) + 4 * hi; }
__device__ __forceinline__ unsigned cvtpk(float lo, float hi) { unsigned r; asm volatile("v_cvt_pk_bf16_f32 %0, %1, %2" : "=v"(r) : "v"(lo), "v"(hi)); return r; }
__device__ __forceinline__ int v_st(int k, int c) { const int kk = (k & ~0xC) | ((k & 4) << 1) | ((k & 8) >> 1); return ((kk >> 3) * 4 + (c >> 5)) * 512 + ((kk & 7) * 32 + (c & 31)) * 2; }
__device__ __forceinline__ int v_rd_base(int lane) { return ((lane & 3) << 3) | (((lane >> 2) & 3) << 6) | (((lane >> 4) & 1) << 5) | (((lane >> 5) & 1) << 8); }
constexpr int v_rd_off(int d0, int ks, int half) { return d0 * 512 + ks * 4096 + half * 2048; }
template <int OFF> __device__ __forceinline__ s16x4 tr_read(int vb) { s16x4 r; asm volatile("ds_read_b64_tr_b16 %0, %1 offset:%2" : "=&v"(r) : "v"(vb), "i"(OFF) : "memory"); return r; }
template <int D0> __device__ __forceinline__ void pv_one(f32x16& od, int vb, bf16x8 pa0, bf16x8 pa1, bf16x8 pa2, bf16x8 pa3) {
  const s16x4 l0 = tr_read<v_rd_off(D0, 0, 0)>(vb), h0 = tr_read<v_rd_off(D0, 0, 1)>(vb), l1 = tr_read<v_rd_off(D0, 1, 0)>(vb), h1 = tr_read<v_rd_off(D0, 1, 1)>(vb);
  const s16x4 l2 = tr_read<v_rd_off(D0, 2, 0)>(vb), h2 = tr_read<v_rd_off(D0, 2, 1)>(vb), l3 = tr_read<v_rd_off(D0, 3, 0)>(vb), h3 = tr_read<v_rd_off(D0, 3, 1)>(vb);
  asm volatile("s_waitcnt lgkmcnt(0)" ::: "memory"); SBAR();
#define PK(L, H) (bf16x8){L[0], L[1], L[2], L[3], H[0], H[1], H[2], H[3]}
  od = __builtin_amdgcn_mfma_f32_32x32x16_bf16(pa0, PK(l0, h0), od, 0, 0, 0);
  od = __builtin_amdgcn_mfma_f32_32x32x16_bf16(pa1, PK(l1, h1), od, 0, 0, 0);
  od = __builtin_amdgcn_mfma_f32_32x32x16_bf16(pa2, PK(l2, h2), od, 0, 0, 0);
  od = __builtin_amdgcn_mfma_f32_32x32x16_bf16(pa3, PK(l3, h3), od, 0, 0, 0);
#undef PK
}
__device__ __forceinline__ void pv_d0(f32x16* o, int vb, bf16x8 pa0, bf16x8 pa1, bf16x8 pa2, bf16x8 pa3) {
  pv_one<0>(o[0], vb, pa0, pa1, pa2, pa3); pv_one<1>(o[1], vb, pa0, pa1, pa2, pa3); pv_one<2>(o[2], vb, pa0, pa1, pa2, pa3); pv_one<3>(o[3], vb, pa0, pa1, pa2, pa3);
}
__device__ __forceinline__ void qkt(f32x16& p0, f32x16& p1, const char* Ks, const char* Qs, int r32, int hi) {
  p0 = f32x16{}; p1 = f32x16{};
#pragma unroll
  for (int d0 = 0; d0 < 8; ++d0) { const int cb = (d0 * 16 + hi * 8) * 2;
    const bf16x8 b0 = *reinterpret_cast<const bf16x8*>(Ks + KSWZ(r32, cb));
    const bf16x8 b1 = *reinterpret_cast<const bf16x8*>(Ks + KSWZ(32 + r32, cb));
    const bf16x8 q = *reinterpret_cast<const bf16x8*>(Qs + KSWZ(r32, cb));
    p0 = __builtin_amdgcn_mfma_f32_32x32x16_bf16(b0, q, p0, 0, 0, 0);
    p1 = __builtin_amdgcn_mfma_f32_32x32x16_bf16(b1, q, p1, 0, 0, 0); }
}
struct TileInfo { float a0, a1; int diag; };
__device__ __forceinline__ void partialSM(f32x16& p0, f32x16& p1, const TileInfo& ti, float sl2, int rowq, int hi) {
#pragma unroll
  for (int r = 0; r < 16; ++r) { const float kc = (float)((r & 3) + 8 * (r >> 2)); p0[r] = fmaf(sl2, kc, fmaf(p0[r], CS, ti.a0)); p1[r] = fmaf(sl2, kc, fmaf(p1[r], CS, ti.a1)); }
  if (ti.diag >= 0) {
    const int k0 = ti.diag + 4 * hi;
#pragma unroll
    for (int r = 0; r < 16; ++r) { const int kq = k0 + (r & 3) + 8 * (r >> 2); if (kq > rowq) p0[r] = -INFINITY; if (kq + 32 > rowq) p1[r] = -INFINITY; }
  }
#pragma unroll
  for (int r = 0; r < 16; ++r) p0[r] = __builtin_amdgcn_exp2f(p0[r]);
}
__device__ __forceinline__ void finishSM(f32x16& p0, f32x16& p1, float& l_reg, bf16x8& pa0, bf16x8& pa1, bf16x8& pa2, bf16x8& pa3) {
#pragma unroll
  for (int r = 0; r < 16; ++r) p1[r] = __builtin_amdgcn_exp2f(p1[r]);
  float ps = 0;
#pragma unroll
  for (int r = 0; r < 16; ++r) ps += p0[r];
#pragma unroll
  for (int r = 0; r < 16; ++r) ps += p1[r];
  { auto rr = __builtin_amdgcn_permlane32_swap(__float_as_uint(ps), __float_as_uint(ps), false, false);
    ps = __uint_as_float(rr[0]) + __uint_as_float(rr[1]); }
  l_reg += ps;
#define PK4(P, BASE, OUT) do { unsigned a0 = cvtpk(P[BASE + 0], P[BASE + 1]), a1 = cvtpk(P[BASE + 2], P[BASE + 3]);   \
    unsigned b0 = cvtpk(P[BASE + 4], P[BASE + 5]), b1 = cvtpk(P[BASE + 6], P[BASE + 7]);                              \
    auto r0 = __builtin_amdgcn_permlane32_swap(a0, b0, false, false); auto r1 = __builtin_amdgcn_permlane32_swap(a1, b1, false, false); \
    u32x4 w = {r0[0], r1[0], r0[1], r1[1]}; OUT = *reinterpret_cast<bf16x8*>(&w); } while (0)
  PK4(p0, 0, pa0); PK4(p0, 8, pa1); PK4(p1, 0, pa2); PK4(p1, 8, pa3);
#undef PK4
}
#define TOP3_INS(v, i) do { const float v_ = (v); const int i_ = (i); \
    const bool b1_ = v_ > t1 || (v_ == t1 && i_ < i1), b2_ = v_ > t2 || (v_ == t2 && i_ < i2), b3_ = v_ > t3 || (v_ == t3 && i_ < i3); \
    if (b1_) { t3 = t2; i3 = i2; t2 = t1; i2 = i1; t1 = v_; i1 = i_; } else if (b2_) { t3 = t2; i3 = i2; t2 = v_; i2 = i_; } else if (b3_) { t3 = v_; i3 = i_; } } while (0)

__device__ __forceinline__ void attn_unit(int b, int h, int cur, const __attribute__((address_space(1))) unsigned short* __restrict__ QKN, int ldq, int cq, int ck, const __attribute__((address_space(1))) unsigned short* __restrict__ PROJ, int ldp, int cv, int seq, const __attribute__((address_space(1))) float* __restrict__ kmean,
                                          __attribute__((address_space(1))) unsigned short* __restrict__ OA, int ldo, char* lds, int tid, int wpast, float smax2) {
  const int wid = __builtin_amdgcn_readfirstlane(tid >> 6), lane = tid & 63, r32 = lane & 31, hi = lane >> 5;
  char* V_lds = lds + OFF_V; char* K_lds = lds + OFF_K;
  float* wsf = (float*)(lds + OFF_WS) + wid * 64; float* li_l = wsf; float* al_l = wsf + 32;
  volatile int* misc = (volatile int*)(lds + OFF_MISC);
  const float slope = exp2f(-(float)(h + 1)), sl2 = slope * LOG2E;
  const int rowq = wid * QBLK + r32;
  float l_reg = 0; f32x16 o[4] = {};
  const float negm = -(smax2 + sl2 * (float)rowq);
  char* Q_lds = lds + OFF_Q + wid * 8192;
  __syncthreads();
  { const __attribute__((address_space(1))) unsigned short* Qw = QKN + ((size_t)b * seq + cur * 256 + rowq) * ldq + cq + h * D + hi * 8;
#pragma unroll
    for (int d0 = 0; d0 < 8; ++d0) { const bf16x8 qv = *(const __attribute__((address_space(1))) bf16x8*)(Qw + d0 * 16); *reinterpret_cast<bf16x8*>(Q_lds + KSWZ(r32, (d0 * 16 + hi * 8) * 2)) = qv; } }
  asm volatile("s_waitcnt lgkmcnt(0)" ::: "memory");
  unsigned selmask = 0u;
  if (cur > 0) {
    f32x16 g = {};
    const __attribute__((address_space(1))) float* km = kmean + ((size_t)(b * 8 + h) * 32 + r32) * D + hi * 8;
#pragma unroll
    for (int d0 = 0; d0 < 8; ++d0) { const f32x8v x = *(const __attribute__((address_space(1))) f32x8v*)(km + d0 * 16);
      u32x4 wh = {cvtpk(x[0], x[1]), cvtpk(x[2], x[3]), cvtpk(x[4], x[5]), cvtpk(x[6], x[7])};
      float rl[8];
#pragma unroll
      for (int k = 0; k < 4; ++k) { rl[2 * k] = x[2 * k] - __uint_as_float(wh[k] << 16); rl[2 * k + 1] = x[2 * k + 1] - __uint_as_float(wh[k] & 0xffff0000u); }
      u32x4 wl = {cvtpk(rl[0], rl[1]), cvtpk(rl[2], rl[3]), cvtpk(rl[4], rl[5]), cvtpk(rl[6], rl[7])};
      const bf16x8 q = *reinterpret_cast<const bf16x8*>(Q_lds + KSWZ(r32, (d0 * 16 + hi * 8) * 2));
      g = __builtin_amdgcn_mfma_f32_32x32x16_bf16(*reinterpret_cast<bf16x8*>(&wh), q, g, 0, 0, 0);
      g = __builtin_amdgcn_mfma_f32_32x32x16_bf16(*reinterpret_cast<bf16x8*>(&wl), q, g, 0, 0, 0); }
    float t1 = -INFINITY, t2 = -INFINITY, t3 = -INFINITY; int i1 = 64, i2 = 65, i3 = 66;
#pragma unroll
    for (int r = 0; r < 16; ++r) { const int n = crow(r, hi); const float v = n < cur ? g[r] : -INFINITY; TOP3_INS(v, n); }
#define PARTNER_F(x) ({ const auto rr_ = __builtin_amdgcn_permlane32_swap(__float_as_uint(x), __float_as_uint(x), false, false); __uint_as_float(hi ? rr_[0] : rr_[1]); })
#define PARTNER_I(x) ({ const auto rr_ = __builtin_amdgcn_permlane32_swap((unsigned)(x), (unsigned)(x), false, false); (int)(hi ? rr_[0] : rr_[1]); })
    const float u1 = PARTNER_F(t1), u2 = PARTNER_F(t2), u3 = PARTNER_F(t3); const int j1 = PARTNER_I(i1), j2 = PARTNER_I(i2), j3 = PARTNER_I(i3);
#undef PARTNER_F
#undef PARTNER_I
    TOP3_INS(u1, j1); TOP3_INS(u2, j2); TOP3_INS(u3, j3);
    if (t1 > -INFINITY) selmask |= 1u << i1; if (t2 > -INFINITY) selmask |= 1u << i2; if (t3 > -INFINITY) selmask |= 1u << i3;
  }
  if (tid == 0) misc[0] = 0;
  __syncthreads();
  { unsigned wm = selmask;
    wm |= (unsigned)__builtin_amdgcn_ds_swizzle((int)wm, (1 << 10) | 0x1f); wm |= (unsigned)__builtin_amdgcn_ds_swizzle((int)wm, (2 << 10) | 0x1f); wm |= (unsigned)__builtin_amdgcn_ds_swizzle((int)wm, (4 << 10) | 0x1f);
    wm |= (unsigned)__builtin_amdgcn_ds_swizzle((int)wm, (8 << 10) | 0x1f); wm |= (unsigned)__builtin_amdgcn_ds_swizzle((int)wm, (16 << 10) | 0x1f);
    { const auto rr_ = __builtin_amdgcn_permlane32_swap(wm, wm, false, false); wm = rr_[0] | rr_[1]; }
    if (lane == 0 && wm) atomicOr((unsigned*)&misc[0], wm); }
  __syncthreads();
  if (tid == 0) { const unsigned any = (unsigned)misc[0]; int cnt = 0; const int nmin = cur - wpast > 0 ? cur - wpast : 0;
    for (int n = cur - 1; n >= nmin; --n) if ((any >> n) & 1u) { misc[4 + cnt] = n; ++cnt; }
    misc[1] = cnt; }
  __syncthreads();
  const int NT = 4 * (1 + __builtin_amdgcn_readfirstlane(misc[1]));
  const __attribute__((address_space(1))) unsigned short* Kh = QKN + (size_t)b * seq * ldq + ck + h * D; const __attribute__((address_space(1))) unsigned short* Vh = PROJ + (size_t)b * seq * ldp + cv + h * D;
  const int sr = tid >> 4, sc = (tid & 15) * 8, vst0 = v_st(sr, sc), vst1 = v_st(32 + sr, sc);
  const int vb0 = (int)(uintptr_t)V_lds + v_rd_base(lane);
  struct { bf16x8 vs0, vs1, ks0, ks1; } sr_[2];
#define TKEY(j) ((j) < 4 ? cur * 256 + (j) * 64 : __builtin_amdgcn_readfirstlane(misc[4 + (((j) - 4) >> 2)]) * 256 + ((j) & 3) * 64)
#define TINFO(ti, j) do { const int j_ = (j); int kp_; if (j_ < 4) { kp_ = j_ * 64; ti.a0 = sl2 * (float)(kp_ + 4 * hi) + negm; \
        ti.diag = (j_ * 64 + 63 > wid * QBLK) ? j_ * 64 : -1; }     \
      else { const int n_ = __builtin_amdgcn_readfirstlane(misc[4 + ((j_ - 4) >> 2)]); kp_ = (n_ - cur) * 256 + (j_ & 3) * 64; ti.a0 = ((selmask >> n_) & 1u) ? sl2 * (float)(kp_ + 4 * hi) + negm : -INFINITY; ti.diag = -1; } \
      ti.a1 = ti.a0 + 32.f * sl2; } while (0)
#define SLOAD(i, k0) do { const size_t k0_ = (size_t)(k0); sr_[i].vs0 = *(const __attribute__((address_space(1))) bf16x8*)(&Vh[(k0_ + sr) * ldp + sc]); sr_[i].vs1 = *(const __attribute__((address_space(1))) bf16x8*)(&Vh[(k0_ + 32 + sr) * ldp + sc]); \
    sr_[i].ks0 = *(const __attribute__((address_space(1))) bf16x8*)(&Kh[(k0_ + sr) * ldq + sc]); sr_[i].ks1 = *(const __attribute__((address_space(1))) bf16x8*)(&Kh[(k0_ + 32 + sr) * ldq + sc]); } while (0)
#define SWRITE(bb, i) do { *(bf16x8*)(V_lds + (bb) * SHM_V + vst0) = sr_[i].vs0; *(bf16x8*)(V_lds + (bb) * SHM_V + vst1) = sr_[i].vs1; const int kc = sc * 2; \
    *(bf16x8*)(K_lds + (bb) * SHM_K + KSWZ(sr, kc)) = sr_[i].ks0; *(bf16x8*)(K_lds + (bb) * SHM_K + KSWZ(32 + sr, kc)) = sr_[i].ks1; } while (0)
#define SWAIT() asm volatile("s_waitcnt vmcnt(4)" ::: "memory")
  f32x16 pA0, pA1, pB0, pB1; bf16x8 pa0, pa1, pa2, pa3; TileInfo tiA, tiB;
  constexpr int SE = 0, SO = 1;
  SLOAD(SE, TKEY(0)); asm volatile("s_waitcnt vmcnt(0)" ::: "memory"); SWRITE(0, SE); __syncthreads();
  qkt(pA0, pA1, K_lds, Q_lds, r32, hi); TINFO(tiA, 0); partialSM(pA0, pA1, tiA, sl2, rowq, hi);
  SLOAD(SO, TKEY(1)); SLOAD(SE, TKEY(2));
  SWAIT(); SWRITE(1, SO); __syncthreads();
  for (int j = 1; j + 1 < NT; j += 2) {
    SBAR(); qkt(pB0, pB1, K_lds + SHM_K, Q_lds, r32, hi);
    finishSM(pA0, pA1, l_reg, pa0, pa1, pa2, pa3); SBAR();
    SLOAD(SO, TKEY(j + 2 < NT ? j + 2 : j)); SBAR();
    pv_d0(o, vb0, pa0, pa1, pa2, pa3); TINFO(tiB, j); partialSM(pB0, pB1, tiB, sl2, rowq, hi);
    __syncthreads(); SWAIT(); SWRITE(0, SE);
    __syncthreads();
    SBAR(); qkt(pA0, pA1, K_lds, Q_lds, r32, hi);
    finishSM(pB0, pB1, l_reg, pa0, pa1, pa2, pa3); SBAR();
    SLOAD(SE, TKEY(j + 3 < NT ? j + 3 : j)); SBAR();
    pv_d0(o, vb0 + SHM_V, pa0, pa1, pa2, pa3); TINFO(tiA, j + 1); partialSM(pA0, pA1, tiA, sl2, rowq, hi);
    __syncthreads(); SWAIT(); SWRITE(1, SO);
    __syncthreads();
  }
  SBAR(); qkt(pB0, pB1, K_lds + SHM_K, Q_lds, r32, hi);
  finishSM(pA0, pA1, l_reg, pa0, pa1, pa2, pa3); SBAR();
  pv_d0(o, vb0, pa0, pa1, pa2, pa3); TINFO(tiB, NT - 1); partialSM(pB0, pB1, tiB, sl2, rowq, hi);
  __syncthreads();
  finishSM(pB0, pB1, l_reg, pa0, pa1, pa2, pa3); SBAR();
  pv_d0(o, vb0 + SHM_V, pa0, pa1, pa2, pa3);
  asm volatile("s_waitcnt vmcnt(0)" ::: "memory");
  if (hi == 0) li_l[r32] = l_reg; asm volatile("s_waitcnt lgkmcnt(0)" ::: "memory");
  __attribute__((address_space(1))) unsigned short* Ow = OA + ((size_t)b * seq + cur * 256 + wid * QBLK) * ldo + h * D;
#pragma unroll
  for (int r = 0; r < 16; ++r) { const int orow = crow(r, hi); const float rli = __builtin_amdgcn_rcpf(li_l[orow]);
#pragma unroll
    for (int d0 = 0; d0 < 4; ++d0) { const float v = o[d0][r] * rli; unsigned u = __float_as_uint(v); u = (u + 0x7fffu + ((u >> 16) & 1u)) >> 16; Ow[(size_t)orow * ldo + d0 * 32 + r32] = (unsigned short)u; } }
#undef TKEY
#undef TINFO
#undef SLOAD
#undef SWRITE
#undef SWAIT
}
constexpr int LIST_CAP = 8192;
__device__ __forceinline__ void attn_select(int b, int h, int cur, int wv, const __attribute__((address_space(1))) unsigned short* __restrict__ QKN, int ldq, int seq,
                                            const __attribute__((address_space(1))) float* __restrict__ kmean, __attribute__((address_space(1))) unsigned short* __restrict__ LIST,
                                            __attribute__((address_space(1))) unsigned* __restrict__ LCNT, __attribute__((address_space(1))) float* __restrict__ PL, int mtot, int lane, int wpast) {
  const int r32 = lane & 31, hi = lane >> 5, t = cur * 256 + wv * 32 + r32;
  bf16x8 qr[8];
  { const __attribute__((address_space(1))) unsigned short* Qw = QKN + ((size_t)b * seq + t) * ldq + h * D + hi * 8;
#pragma unroll
    for (int d0 = 0; d0 < 8; ++d0) qr[d0] = *(const __attribute__((address_space(1))) bf16x8*)(Qw + d0 * 16); }
  f32x16 g = {};
  const __attribute__((address_space(1))) float* km = kmean + ((size_t)(b * 8 + h) * 32 + r32) * D + hi * 8;
#pragma unroll
  for (int d0 = 0; d0 < 8; ++d0) { const f32x8v x = *(const __attribute__((address_space(1))) f32x8v*)(km + d0 * 16);
    u32x4 wh = {cvtpk(x[0], x[1]), cvtpk(x[2], x[3]), cvtpk(x[4], x[5]), cvtpk(x[6], x[7])};
    float rl[8];
#pragma unroll
    for (int k = 0; k < 4; ++k) { rl[2 * k] = x[2 * k] - __uint_as_float(wh[k] << 16); rl[2 * k + 1] = x[2 * k + 1] - __uint_as_float(wh[k] & 0xffff0000u); }
    u32x4 wl = {cvtpk(rl[0], rl[1]), cvtpk(rl[2], rl[3]), cvtpk(rl[4], rl[5]), cvtpk(rl[6], rl[7])};
    g = __builtin_amdgcn_mfma_f32_32x32x16_bf16(*reinterpret_cast<bf16x8*>(&wh), qr[d0], g, 0, 0, 0);
    g = __builtin_amdgcn_mfma_f32_32x32x16_bf16(*reinterpret_cast<bf16x8*>(&wl), qr[d0], g, 0, 0, 0); }
  float t1 = -INFINITY, t2 = -INFINITY, t3 = -INFINITY; int i1 = 64, i2 = 65, i3 = 66;
#pragma unroll
  for (int r = 0; r < 16; ++r) { const int n = crow(r, hi); const float v = n < cur ? g[r] : -INFINITY; TOP3_INS(v, n); }
#define PARTNER_F(x) ({ const auto rr_ = __builtin_amdgcn_permlane32_swap(__float_as_uint(x), __float_as_uint(x), false, false); __uint_as_float(hi ? rr_[0] : rr_[1]); })
#define PARTNER_I(x) ({ const auto rr_ = __builtin_amdgcn_permlane32_swap((unsigned)(x), (unsigned)(x), false, false); (int)(hi ? rr_[0] : rr_[1]); })
  const float u1 = PARTNER_F(t1), u2 = PARTNER_F(t2), u3 = PARTNER_F(t3); const int j1 = PARTNER_I(i1), j2 = PARTNER_I(i2), j3 = PARTNER_I(i3);
#undef PARTNER_F
#undef PARTNER_I
  TOP3_INS(u1, j1); TOP3_INS(u2, j2); TOP3_INS(u3, j3);
  const int nmin = cur - wpast > 0 ? cur - wpast : 0;
  const bool v1 = t1 > -INFINITY && i1 >= nmin, v2 = t2 > -INFINITY && i2 >= nmin, v3 = t3 > -INFINITY && i3 >= nmin;
  const size_t m = (size_t)b * seq + t;
  if (hi == 0) { if (!v1) PL[((size_t)0 * mtot + m) * 8 + h] = 0.f; if (!v2) PL[((size_t)1 * mtot + m) * 8 + h] = 0.f; if (!v3) PL[((size_t)2 * mtot + m) * 8 + h] = 0.f; }
  unsigned mycnt = 0u;
  for (int n = nmin; n < cur; ++n) { const bool sel = hi == 0 && ((v1 && i1 == n) || (v2 && i2 == n) || (v3 && i3 == n)); const unsigned long long mask = __ballot(sel); if (lane == n) mycnt = (unsigned)__popcll(mask); }
  unsigned mybase = 0u;
  if (mycnt) mybase = __hip_atomic_fetch_add(LCNT + (b * 8 + h) * 32 + lane, mycnt, __ATOMIC_RELAXED, __HIP_MEMORY_SCOPE_AGENT);
  for (int n = nmin; n < cur; ++n) {
    const bool s1 = v1 && i1 == n, s2 = v2 && i2 == n, s3 = v3 && i3 == n, sel = hi == 0 && (s1 || s2 || s3);
    const unsigned long long mask = __ballot(sel);
    const unsigned base = (unsigned)__builtin_amdgcn_readlane((int)mybase, n);
    if (sel) { const unsigned rank = __builtin_amdgcn_mbcnt_hi((unsigned)(mask >> 32), __builtin_amdgcn_mbcnt_lo((unsigned)mask, 0u));
      LIST[(size_t)((b * 8 + h) * 32 + n) * LIST_CAP + base + rank] = (unsigned short)(t | ((s1 ? 0 : s2 ? 1 : 2) << 13)); }
  }
}
__device__ __forceinline__ void attn_block_unit(bool own, int b, int h, int kb, int c0, int cnt, const __attribute__((address_space(1))) unsigned short* __restrict__ LIST,
                                                const __attribute__((address_space(1))) unsigned short* __restrict__ QKN, int ldq, int ck, const __attribute__((address_space(1))) unsigned short* __restrict__ PROJ, int ldp, int cv, int seq,
                                                __attribute__((address_space(1))) unsigned short* __restrict__ P01, __attribute__((address_space(1))) unsigned short* __restrict__ P23,
                                                __attribute__((address_space(1))) float* __restrict__ PL, int mtot, char* lds, int tid, float smax2) {
  const int wid = __builtin_amdgcn_readfirstlane(tid >> 6), lane = tid & 63, r32 = lane & 31, hi = lane >> 5;
  char* V_lds = lds + OFF_V; char* K_lds = lds + OFF_K;
  float* wsf = (float*)(lds + OFF_WS) + wid * 64; float* li_l = wsf; int* tj_l = (int*)(wsf + 32);
  const float slope = exp2f(-(float)(h + 1)), sl2 = slope * LOG2E;
  const int rowq = wid * QBLK + r32;
  const int kpos0 = kb * 256;
  const __attribute__((address_space(1))) unsigned short* Kh = QKN + ((size_t)b * seq + kpos0) * ldq + ck + h * D; const __attribute__((address_space(1))) unsigned short* Vh = PROJ + ((size_t)b * seq + kpos0) * ldp + cv + h * D;
  const int sr = tid >> 4, sc = (tid & 15) * 8, vst0 = v_st(sr, sc), vst1 = v_st(32 + sr, sc);
  const int vb0 = (int)(uintptr_t)V_lds + v_rd_base(lane);
  struct { bf16x8 vs0, vs1, ks0, ks1; } sr_[2];
#define SLOAD(i, k0) do { const size_t k0_ = (size_t)(k0); sr_[i].vs0 = *(const __attribute__((address_space(1))) bf16x8*)(&Vh[(k0_ + sr) * ldp + sc]); sr_[i].vs1 = *(const __attribute__((address_space(1))) bf16x8*)(&Vh[(k0_ + 32 + sr) * ldp + sc]); \
    sr_[i].ks0 = *(const __attribute__((address_space(1))) bf16x8*)(&Kh[(k0_ + sr) * ldq + sc]); sr_[i].ks1 = *(const __attribute__((address_space(1))) bf16x8*)(&Kh[(k0_ + 32 + sr) * ldq + sc]); } while (0)
  int trow, slot; bool valid = true;
  if (own) { trow = kb * 256 + rowq; slot = 3; }
  else { const int idx = c0 + rowq; valid = idx < cnt; const int e = valid ? (int)LIST[(size_t)((b * 8 + h) * 32 + kb) * LIST_CAP + idx] : ((kb + 1) * 256); trow = e & 8191; slot = valid ? (e >> 13) : 0; }
  SLOAD(0, 0);
  bf16x8 qv[8];
  { const __attribute__((address_space(1))) unsigned short* Qw = QKN + ((size_t)b * seq + trow) * ldq + h * D + hi * 8;
#pragma unroll
    for (int d0 = 0; d0 < 8; ++d0) qv[d0] = *(const __attribute__((address_space(1))) bf16x8*)(Qw + d0 * 16); }
  float l_reg = 0; f32x16 o[4] = {};
  char* Q_lds = lds + OFF_Q + wid * 8192;
  __syncthreads();
#pragma unroll
  for (int d0 = 0; d0 < 8; ++d0) *reinterpret_cast<bf16x8*>(Q_lds + KSWZ(r32, (d0 * 16 + hi * 8) * 2)) = qv[d0];
  if (hi == 0) tj_l[r32] = valid ? ((slot << 16) | trow) : -1;
  asm volatile("s_waitcnt lgkmcnt(0)" ::: "memory");
  const float abase = -smax2 - sl2 * (float)(trow - kpos0 - 4 * hi);
#define BTINFO(ti, j) do { ti.a0 = abase + sl2 * (float)(64 * (j)); ti.a1 = ti.a0 + 32.f * sl2; ti.diag = (own && ((j) * 64 + 63 > wid * QBLK)) ? (j) * 64 : -1; } while (0)
#define SWRITE(bb, i) do { *(bf16x8*)(V_lds + (bb) * SHM_V + vst0) = sr_[i].vs0; *(bf16x8*)(V_lds + (bb) * SHM_V + vst1) = sr_[i].vs1; const int kc = sc * 2; \
    *(bf16x8*)(K_lds + (bb) * SHM_K + KSWZ(sr, kc)) = sr_[i].ks0; *(bf16x8*)(K_lds + (bb) * SHM_K + KSWZ(32 + sr, kc)) = sr_[i].ks1; } while (0)
  f32x16 pA0, pA1, pB0, pB1; bf16x8 pa0, pa1, pa2, pa3; TileInfo tiA, tiB;
  asm volatile("s_waitcnt vmcnt(0)" ::: "memory"); SWRITE(0, 0); __syncthreads();
  qkt(pA0, pA1, K_lds, Q_lds, r32, hi); BTINFO(tiA, 0); partialSM(pA0, pA1, tiA, sl2, rowq, hi);
  SLOAD(1, 64); SLOAD(0, 128);
  asm volatile("s_waitcnt vmcnt(4)" ::: "memory"); SWRITE(1, 1); __syncthreads();
  SBAR(); qkt(pB0, pB1, K_lds + SHM_K, Q_lds, r32, hi);
  finishSM(pA0, pA1, l_reg, pa0, pa1, pa2, pa3); SBAR();
  SLOAD(1, 192); SBAR();
  pv_d0(o, vb0, pa0, pa1, pa2, pa3); BTINFO(tiB, 1); partialSM(pB0, pB1, tiB, sl2, rowq, hi);
  __syncthreads(); asm volatile("s_waitcnt vmcnt(4)" ::: "memory"); SWRITE(0, 0);
  __syncthreads();
  SBAR(); qkt(pA0, pA1, K_lds, Q_lds, r32, hi);
  finishSM(pB0, pB1, l_reg, pa0, pa1, pa2, pa3); SBAR();
  pv_d0(o, vb0 + SHM_V, pa0, pa1, pa2, pa3); BTINFO(tiA, 2); partialSM(pA0, pA1, tiA, sl2, rowq, hi);
  __syncthreads(); asm volatile("s_waitcnt vmcnt(0)" ::: "memory"); SWRITE(1, 1);
  __syncthreads();
  SBAR(); qkt(pB0, pB1, K_lds + SHM_K, Q_lds, r32, hi);
  finishSM(pA0, pA1, l_reg, pa0, pa1, pa2, pa3); SBAR();
  pv_d0(o, vb0, pa0, pa1, pa2, pa3); BTINFO(tiB, 3); partialSM(pB0, pB1, tiB, sl2, rowq, hi);
  finishSM(pB0, pB1, l_reg, pa0, pa1, pa2, pa3); SBAR();
  pv_d0(o, vb0 + SHM_V, pa0, pa1, pa2, pa3);
  if (hi == 0) li_l[r32] = l_reg; asm volatile("s_waitcnt lgkmcnt(0)" ::: "memory");
  if (hi == 0 && valid) { PL[((size_t)slot * mtot + (size_t)b * seq + trow) * 8 + h] = l_reg;
    if (own && kb == 0) { const size_t m_ = (size_t)b * seq + trow; PL[((size_t)0 * mtot + m_) * 8 + h] = 0.f; PL[((size_t)1 * mtot + m_) * 8 + h] = 0.f; PL[((size_t)2 * mtot + m_) * 8 + h] = 0.f; } }
#pragma unroll
  for (int r = 0; r < 16; ++r) { const int orow = crow(r, hi); const int e = tj_l[orow]; const float lv = li_l[orow]; const float rli = lv > 0.f ? __builtin_amdgcn_rcpf(lv) : 0.f;
    if (e >= 0) { const int sl = e >> 16; __attribute__((address_space(1))) unsigned short* Ow = (sl < 2 ? P01 : P23) + ((size_t)(sl & 1) * mtot + (size_t)b * seq + (e & 0xffff)) * 1024 + h * D;
#pragma unroll
      for (int d0 = 0; d0 < 4; ++d0) { const float v = o[d0][r] * rli; unsigned u = __float_as_uint(v); u = (u + 0x7fffu + ((u >> 16) & 1u)) >> 16; Ow[d0 * 32 + r32] = (unsigned short)u; } } }
#undef BTINFO
#undef SLOAD
#undef SWRITE
}
__device__ __forceinline__ void qkt_r(f32x16& p0, f32x16& p1, const char* Ks, const bf16x8* qr, int r32, int hi) {
  p0 = f32x16{}; p1 = f32x16{};
#pragma unroll
  for (int d0 = 0; d0 < 8; ++d0) { const int cb = (d0 * 16 + hi * 8) * 2;
    const bf16x8 b0 = *reinterpret_cast<const bf16x8*>(Ks + KSWZ(r32, cb));
    const bf16x8 b1 = *reinterpret_cast<const bf16x8*>(Ks + KSWZ(32 + r32, cb));
    p0 = __builtin_amdgcn_mfma_f32_32x32x16_bf16(b0, qr[d0], p0, 0, 0, 0);
    p1 = __builtin_amdgcn_mfma_f32_32x32x16_bf16(b1, qr[d0], p1, 0, 0, 0); }
}
constexpr int KV4_V = 0, KV4_K = 4 * SHM_V, KV4_WS = 4 * SHM_V + 4 * SHM_K, KV4_END = KV4_WS + NW * 256;
__device__ __forceinline__ void attn_kv_unit(int b, int h, int kb, int seg0, int segn, bool with_own, const __attribute__((address_space(1))) unsigned short* __restrict__ LIST,
                                             const __attribute__((address_space(1))) unsigned short* __restrict__ QKN, int ldq, int ck, const __attribute__((address_space(1))) unsigned short* __restrict__ PROJ, int ldp, int cv, int seq,
                                             __attribute__((address_space(1))) unsigned short* __restrict__ P01, __attribute__((address_space(1))) unsigned short* __restrict__ P23,
                                             __attribute__((address_space(1))) float* __restrict__ PL, int mtot, char* lds, int tid, float smax2) {
  const int wid = __builtin_amdgcn_readfirstlane(tid >> 6), lane = tid & 63, r32 = lane & 31, hi = lane >> 5;
  char* V_lds = lds + KV4_V; char* K_lds = lds + KV4_K;
  float* wsf = (float*)(lds + KV4_WS) + wid * 64; float* li_l = wsf; int* tj_l = (int*)(wsf + 32);
  const float slope = exp2f(-(float)(h + 1)), sl2 = slope * LOG2E;
  const int kpos0 = kb * 256;
  {
    const __attribute__((address_space(1))) unsigned short* Kh = QKN + ((size_t)b * seq + kpos0) * ldq + ck + h * D; const __attribute__((address_space(1))) unsigned short* Vh = PROJ + ((size_t)b * seq + kpos0) * ldp + cv + h * D;
    const int sr = tid >> 4, sc = (tid & 15) * 8, vst0 = v_st(sr, sc), vst1 = v_st(32 + sr, sc), kc = sc * 2;
    bf16x8 kv[4][4];
#pragma unroll
    for (int t = 0; t < 4; ++t) { const size_t k0 = (size_t)(t * 64);
      kv[t][0] = *(const __attribute__((address_space(1))) bf16x8*)(&Vh[(k0 + sr) * ldp + sc]); kv[t][1] = *(const __attribute__((address_space(1))) bf16x8*)(&Vh[(k0 + 32 + sr) * ldp + sc]);
      kv[t][2] = *(const __attribute__((address_space(1))) bf16x8*)(&Kh[(k0 + sr) * ldq + sc]); kv[t][3] = *(const __attribute__((address_space(1))) bf16x8*)(&Kh[(k0 + 32 + sr) * ldq + sc]); }
    __syncthreads();
#pragma unroll
    for (int t = 0; t < 4; ++t) {
      *(bf16x8*)(V_lds + t * SHM_V + vst0) = kv[t][0]; *(bf16x8*)(V_lds + t * SHM_V + vst1) = kv[t][1];
      *(bf16x8*)(K_lds + t * SHM_K + KSWZ(sr, kc)) = kv[t][2]; *(bf16x8*)(K_lds + t * SHM_K + KSWZ(32 + sr, kc)) = kv[t][3]; }
    __syncthreads();
  }
  const int vb0 = (int)(uintptr_t)V_lds + v_rd_base(lane);
  const int nown = with_own ? 8 : 0, ngr = nown + ((segn + 31) >> 5);
#define GRAW(gg, raw, isv) do { raw = 0; isv = true; if ((gg) >= nown) { const int idx_ = seg0 + ((gg) - nown) * 32 + r32; isv = idx_ < seg0 + segn; \
    if (isv) raw = (int)LIST[(size_t)((b * 8 + h) * 32 + kb) * LIST_CAP + idx_]; } } while (0)
#define GDEC(gg, raw, isv, e) do { asm volatile("" : "+v"(raw)); e = (gg) < nown ? ((kpos0 + (gg) * 32 + r32) | (3 << 13) | (1 << 16)) : (isv ? (raw | (1 << 16)) : (kpos0 + 256)); } while (0)
#define LOADQ(e) do { const __attribute__((address_space(1))) unsigned short* Qw_ = QKN + ((size_t)b * seq + ((e) & 8191)) * ldq + h * D + hi * 8; \
    _Pragma("unroll") for (int d0 = 0; d0 < 8; ++d0) qr[d0] = *(const __attribute__((address_space(1))) bf16x8*)(Qw_ + d0 * 16); } while (0)
  int e_cur = 0; bf16x8 qr[8];
  if (wid < ngr) { int raw0_; bool isv0_; GRAW(wid, raw0_, isv0_); GDEC(wid, raw0_, isv0_, e_cur); LOADQ(e_cur); }
  __builtin_amdgcn_s_waitcnt(0x0F70);
  for (int g = wid; g < ngr; g += NW) {
    const bool own = g < nown, has_n = g + NW < ngr;
    int raw_n = 0, e_nxt = 0; bool isv_n = true; if (has_n) GRAW(g + NW, raw_n, isv_n);
    const int trow = e_cur & 8191, slot = (e_cur >> 13) & 3; const bool valid = ((e_cur >> 16) & 1) != 0;
    const int rowq = own ? g * 32 + r32 : 1 << 20;
    const float abase = -smax2 - sl2 * (float)(trow - kpos0 - 4 * hi);
    float l_reg = 0; f32x16 o[4] = {};
    const int nt = own ? (g * 32 + 31) / 64 + 1 : 4;
    f32x16 pA0, pA1, pB0, pB1; bf16x8 pa0, pa1, pa2, pa3; TileInfo ti;
#define KTI(j) do { ti.a0 = abase + sl2 * (float)(64 * (j)); ti.a1 = ti.a0 + 32.f * sl2; ti.diag = (own && ((j) * 64 + 63 > g * 32)) ? (j) * 64 : -1; } while (0)
    qkt_r(pA0, pA1, K_lds, qr, r32, hi); KTI(0); partialSM(pA0, pA1, ti, sl2, rowq, hi);
    if (nt > 1) { SBAR(); qkt_r(pB0, pB1, K_lds + SHM_K, qr, r32, hi); }
    finishSM(pA0, pA1, l_reg, pa0, pa1, pa2, pa3); SBAR();
    pv_d0(o, vb0, pa0, pa1, pa2, pa3);
    if (nt > 1) {
      KTI(1); partialSM(pB0, pB1, ti, sl2, rowq, hi);
      if (nt > 2) { SBAR(); qkt_r(pA0, pA1, K_lds + 2 * SHM_K, qr, r32, hi); }
      finishSM(pB0, pB1, l_reg, pa0, pa1, pa2, pa3); SBAR();
      pv_d0(o, vb0 + SHM_V, pa0, pa1, pa2, pa3);
      if (nt > 2) {
        KTI(2); partialSM(pA0, pA1, ti, sl2, rowq, hi);
        if (nt > 3) { SBAR(); qkt_r(pB0, pB1, K_lds + 3 * SHM_K, qr, r32, hi); if (has_n) { GDEC(g + NW, raw_n, isv_n, e_nxt); LOADQ(e_nxt); } }
        finishSM(pA0, pA1, l_reg, pa0, pa1, pa2, pa3); SBAR();
        pv_d0(o, vb0 + 2 * SHM_V, pa0, pa1, pa2, pa3);
        if (nt > 3) {
          KTI(3); partialSM(pB0, pB1, ti, sl2, rowq, hi);
          finishSM(pB0, pB1, l_reg, pa0, pa1, pa2, pa3); SBAR();
          pv_d0(o, vb0 + 3 * SHM_V, pa0, pa1, pa2, pa3);
        }
      }
    }
#undef KTI
    if (nt < 4 && has_n) { GDEC(g + NW, raw_n, isv_n, e_nxt); LOADQ(e_nxt); }
    __builtin_amdgcn_s_waitcnt(0x0F70);
    if (hi == 0) { li_l[r32] = l_reg; tj_l[r32] = valid ? ((slot << 16) | trow) : -1; }
    asm volatile("s_waitcnt lgkmcnt(0)" ::: "memory");
    if (hi == 0 && valid) { const size_t m_ = (size_t)b * seq + trow; PL[((size_t)slot * mtot + m_) * 8 + h] = l_reg;
      if (own && kb == 0) { PL[((size_t)0 * mtot + m_) * 8 + h] = 0.f; PL[((size_t)1 * mtot + m_) * 8 + h] = 0.f; PL[((size_t)2 * mtot + m_) * 8 + h] = 0.f; } }
#pragma unroll
    for (int r = 0; r < 16; ++r) { const int orow = crow(r, hi); const int e = tj_l[orow]; const float lv = li_l[orow]; const float rli = lv > 0.f ? __builtin_amdgcn_rcpf(lv) : 0.f;
      if (e >= 0) { const int sl = e >> 16; __attribute__((address_space(1))) unsigned short* Ow = (sl < 2 ? P01 : P23) + ((size_t)(sl & 1) * mtot + (size_t)b * seq + (e & 0xffff)) * 1024 + h * D;
#pragma unroll
        for (int d0 = 0; d0 < 4; ++d0) { const float v = o[d0][r] * rli; unsigned u = __float_as_uint(v); u = (u + 0x7fffu + ((u >> 16) & 1u)) >> 16; Ow[d0 * 32 + r32] = (unsigned short)u; } } }
    asm volatile("s_waitcnt lgkmcnt(0)" ::: "memory");
    e_cur = e_nxt;
  }
#undef GRAW
#undef GDEC
#undef LOADQ
}
#undef KSWZ
#undef SBAR
#undef TOP3_INS
}

#ifndef DBG_ATT
#define DBG_ATT 0
#endif
#ifndef MK_ONE_LAUNCH
#define MK_ONE_LAUNCH 1
#endif
#ifndef PG8_SP2
#define PG8_SP2 true
#endif
#ifndef PG8_ALIGN
#define PG8_ALIGN true
#endif
constexpr int NWAVES = 8;
constexpr int BATCH = 2, SEQ = 8192, DM = 2048, DEPTH = 4;
constexpr int M = BATCH * SEQ;
constexpr int AH = 8, AD = 128, AW = 1024, MB = 256, NBLK = SEQ / MB;
constexpr int RH = 4, RDK = 256, RDV = 512;
constexpr int DFF = 5632, NIN = 13312;
constexpr int LDP = 9216, NNAT = 11264, NSWP = 2048;
constexpr int C_QA = 0, C_KA = 1024, C_VA = 2048, C_GR = 3072, C_GA = 5120, C_GT = 7168;
constexpr float EPS = 1e-6f;
constexpr int NPH = 12;
constexpr int NPHASES = DEPTH * NPH;

constexpr size_t MiB = 1u << 20;
constexpr size_t WS_CTL = 0, CTL_ZERO_BYTES = 128 * 1024;
constexpr size_t WS_KMEAN = 1 * MiB;
constexpr size_t WS_W0 = 2 * MiB, WS_W1 = 1232 * MiB;
constexpr size_t WS_WNAT = 0 * MiB, WS_WSWP = 44 * MiB, WS_WOA = 56 * MiB, WS_WOUT = 68 * MiB, WS_WFI = 76 * MiB, WS_WFO = 120 * MiB;
constexpr size_t WS_H = 144 * MiB;
constexpr size_t WS_PROJ = 208 * MiB;
constexpr size_t WS_OA = 496 * MiB, WS_ORR = 528 * MiB, WS_MRG = 592 * MiB, WS_T = 656 * MiB, WS_RET = 784 * MiB;
constexpr size_t WS_ST = WS_T;
constexpr size_t WS_AQ = 912 * MiB;
constexpr size_t WS_BQ = 976 * MiB;
constexpr size_t WS_KB = 1104 * MiB, WS_KTB = 1136 * MiB, WS_QKN = 1168 * MiB, WS_LIST = 1376 * MiB, WS_PL = 1384 * MiB, WS_PS = 1386 * MiB, WS_RS = 1394 * MiB, WS_END = 1395 * MiB;
constexpr size_t WS_P01 = 720 * MiB, WS_P23 = 592 * MiB;
constexpr int CW_BAR = 4096, CW_ATTQ = 8192, CW_DBG = 12288, CW_CVQ = 16384, CW_SCQ = 16384 + 256, CW_LCNT = 20480;

constexpr int RING_OFF = 0, RING_BYTES = 131072;
constexpr int LDS_BYTES = 163840;
constexpr int LDSCTL_OFF = LDS_BYTES - 1024, MISC_OFF = LDSCTL_OFF + 320;

#define GAS __attribute__((address_space(1)))
#define LAS __attribute__((address_space(3)))
typedef unsigned short bf16;
typedef unsigned v4u __attribute__((ext_vector_type(4)));
typedef float f32x4 __attribute__((ext_vector_type(4)));
typedef short bf16x8 __attribute__((ext_vector_type(8)));
typedef GAS unsigned gu32;
typedef GAS unsigned long long gu64;
#define RLX_AGENT __ATOMIC_RELAXED, __HIP_MEMORY_SCOPE_AGENT
#define LDS_WAIT() asm volatile("s_waitcnt lgkmcnt(0)" ::: "memory")
#define VM_WAIT() asm volatile("s_waitcnt vmcnt(0)" ::: "memory")
__device__ __forceinline__ unsigned long long rt() { return __builtin_amdgcn_s_memrealtime(); }
__device__ __forceinline__ unsigned f2bf(float f) { unsigned u = __builtin_bit_cast(unsigned, f); return (u + 0x7fffu + ((u >> 16) & 1u)) >> 16; }
__device__ __forceinline__ unsigned pk2(float lo, float hi) { return f2bf(lo) | (f2bf(hi) << 16); }

#define XB_TMO      128
#define XB_XCNT(j)  (256  + 64 * (j))
#define XB_XSUB(j)  (1280 + 64 * (j))
#define XB_XGEN(j)  (2304 + 64 * (j))
#define XB_TOP      3328
#define XB_TOPGEN   3392
#define XCD_BAR_WORDS 3456
#define XB_SPIN_CAP (1u << 22)

__device__ __forceinline__ unsigned xb_ld(unsigned* p)              { return __hip_atomic_load(p, __ATOMIC_RELAXED, __HIP_MEMORY_SCOPE_AGENT); }
__device__ __forceinline__ unsigned xb_add(unsigned* p, unsigned v) { return __hip_atomic_fetch_add(p, v, __ATOMIC_RELAXED, __HIP_MEMORY_SCOPE_AGENT); }
__device__ __forceinline__ unsigned xb_xcc_id() { return (unsigned)__builtin_amdgcn_s_getreg((3 << 11) | 20) & 0xFu; }
#define XB_SPIN(cond, bar) do { unsigned _sp = 0; while (cond) { __builtin_amdgcn_s_sleep(1); \
    if ((++_sp & 255u) == 0u) { if (xb_ld(&(bar)[XB_TMO])) break; if (_sp > XB_SPIN_CAP) { atomicAdd(&(bar)[XB_TMO], 1u); break; } } } } while (0)

struct XcdBarrier {
    unsigned* bar; unsigned x;
    volatile LAS unsigned* st;
};

__device__ __forceinline__ XcdBarrier xcd_barrier_post(unsigned* bar, volatile LAS unsigned* st) {
    XcdBarrier b; b.bar = bar; b.x = xb_xcc_id(); b.st = st;
    if (threadIdx.x == 0) (void)xb_add(&bar[XB_XCNT(b.x)], 1u);
    return b;
}
__device__ __forceinline__ void xcd_barrier_complete(unsigned* bar, unsigned x, unsigned& nloc, unsigned& nx) {
    const unsigned G = gridDim.x * gridDim.y * gridDim.z;
    unsigned sum, cnt, mine, sp = 0u;
    for (;;) {
        sum = 0u; cnt = 0u; mine = 0u;
#pragma unroll
        for (unsigned j = 0; j < 16; ++j) { const unsigned c = xb_ld(&bar[XB_XCNT(j)]); sum += c; cnt += (c > 0u) ? 1u : 0u; mine = (j == x) ? c : mine; }
        if (sum == G) break;
        __builtin_amdgcn_s_sleep(1);
        if ((++sp & 255u) == 0u) { if (xb_ld(&bar[XB_TMO])) break; if (sp > XB_SPIN_CAP) { atomicAdd(&bar[XB_TMO], 1u); break; } }
    }
    nloc = mine > 0u ? mine : 1u; nx = cnt > 0u ? cnt : 1u;
}

__device__ __forceinline__ void xcd_barrier(const XcdBarrier& b) {
    asm volatile("s_waitcnt vmcnt(0)" ::: "memory");
    __syncthreads();
    if (threadIdx.x == 0) {
        unsigned* bar = b.bar;
        __builtin_amdgcn_s_waitcnt(0);
        unsigned nloc = b.st[0], nx = b.st[1];
        if (nloc == 0u) { xcd_barrier_complete(bar, b.x, nloc, nx); b.st[0] = nloc; b.st[1] = nx; }
        const unsigned old = xb_add(&bar[XB_XSUB(b.x)], 1u);
        const unsigned gen = old / nloc;
        if (old + 1u == (gen + 1u) * nloc) {
            __builtin_amdgcn_fence(__ATOMIC_RELEASE, "agent");
            asm volatile("s_waitcnt vmcnt(0)" ::: "memory");
            const unsigned og = xb_add(&bar[XB_TOP], 1u);
            const unsigned tg = og / nx;
            if (og + 1u == (tg + 1u) * nx) xb_add(&bar[XB_TOPGEN], 1u);
            else XB_SPIN(xb_ld(&bar[XB_TOPGEN]) == tg, bar);
            __builtin_amdgcn_fence(__ATOMIC_ACQUIRE, "agent");
            xb_add(&bar[XB_XGEN(b.x)], 1u);
            asm volatile("s_waitcnt vmcnt(0)" ::: "memory");
        } else {
            XB_SPIN(xb_ld(&bar[XB_XGEN(b.x)]) == gen, bar);
            __builtin_amdgcn_fence(__ATOMIC_ACQUIRE, "agent");
            asm volatile("s_waitcnt vmcnt(0)" ::: "memory");
        }
    }
    __syncthreads();
}

struct Frame {
    LAS unsigned char* lds;
    volatile LAS unsigned* MISC;
    gu32* ctl;
    int tid, lane, wave;
    int vcu, G;
};
#define SWZ_XOR(v, m) __builtin_amdgcn_ds_swizzle((v), ((m) << 10) | 0x1f)
__device__ __forceinline__ float wave_sum(float v) {
    v += __int_as_float(SWZ_XOR(__float_as_int(v), 1)); v += __int_as_float(SWZ_XOR(__float_as_int(v), 2)); v += __int_as_float(SWZ_XOR(__float_as_int(v), 4));
    v += __int_as_float(SWZ_XOR(__float_as_int(v), 8)); v += __int_as_float(SWZ_XOR(__float_as_int(v), 16));
    const auto rr = __builtin_amdgcn_permlane32_swap(__float_as_uint(v), __float_as_uint(v), false, false);
    return __uint_as_float(rr[0]) + __uint_as_float(rr[1]);
}
__device__ __forceinline__ float wave_max(float v) {
    v = fmaxf(v, __int_as_float(SWZ_XOR(__float_as_int(v), 1))); v = fmaxf(v, __int_as_float(SWZ_XOR(__float_as_int(v), 2))); v = fmaxf(v, __int_as_float(SWZ_XOR(__float_as_int(v), 4)));
    v = fmaxf(v, __int_as_float(SWZ_XOR(__float_as_int(v), 8))); v = fmaxf(v, __int_as_float(SWZ_XOR(__float_as_int(v), 16)));
    const auto rr = __builtin_amdgcn_permlane32_swap(__float_as_uint(v), __float_as_uint(v), false, false);
    return fmaxf(__uint_as_float(rr[0]), __uint_as_float(rr[1]));
}
__device__ __forceinline__ unsigned wave_or(unsigned v) {
    v |= (unsigned)SWZ_XOR((int)v, 1); v |= (unsigned)SWZ_XOR((int)v, 2); v |= (unsigned)SWZ_XOR((int)v, 4); v |= (unsigned)SWZ_XOR((int)v, 8); v |= (unsigned)SWZ_XOR((int)v, 16);
    const auto rr = __builtin_amdgcn_permlane32_swap(v, v, false, false);
    return rr[0] | rr[1];
}
__device__ __forceinline__ float bf2f(bf16 b) { return __uint_as_float(((unsigned)b) << 16); }
__device__ __forceinline__ float blo(unsigned w) { return __uint_as_float(w << 16); }
__device__ __forceinline__ float bhi(unsigned w) { return __uint_as_float(w & 0xffff0000u); }

__device__ __forceinline__ void transpose_item(const GAS float* W, int K, int N, int k0, int n0, GAS bf16* WT, int dst_row0, GAS bf16* WT2, int dst2_row0, int ldw, int kofs, LAS float* scr, int lane, const GAS float* gain) {
    const int lr = lane >> 4, lc = (lane & 15) * 4;
    f32x4 v[16];
    const GAS float* src = W + (size_t)(k0 + lr) * N + n0 + lc;
#pragma unroll
    for (int i = 0; i < 16; ++i) v[i] = *(const GAS f32x4*)(src + (size_t)(4 * i) * N);
    if (gain) {
#pragma unroll
        for (int i = 0; i < 16; ++i) { const float gk = gain[k0 + lr + 4 * i]; v[i] = v[i] * gk; } }
#pragma unroll
    for (int i = 0; i < 16; ++i) { LAS float* d = scr + (4 * i + lr) * 65 + lc; d[0] = v[i].x; d[1] = v[i].y; d[2] = v[i].z; d[3] = v[i].w; }
    LDS_WAIT(); asm volatile("" ::: "memory");
    const int kc = lane & 7;
#pragma unroll
    for (int j = 0; j < 8; ++j) { const int n = (lane >> 3) + 8 * j; const LAS float* s = scr + (8 * kc) * 65 + n;
        v4u o; o.x = pk2(s[0 * 65], s[1 * 65]); o.y = pk2(s[2 * 65], s[3 * 65]); o.z = pk2(s[4 * 65], s[5 * 65]); o.w = pk2(s[6 * 65], s[7 * 65]);
        if (WT) *(GAS v4u*)(WT + (size_t)(dst_row0 + n) * ldw + kofs + k0 + 8 * kc) = o;
        if (WT2) *(GAS v4u*)(WT2 + (size_t)(dst2_row0 + n) * ldw + kofs + k0 + 8 * kc) = o; }
    LDS_WAIT(); asm volatile("" ::: "memory");
}
constexpr int I_IN = (DM / 64) * (NIN / 64), I_OA = (AW / 64) * (DM / 64), I_OR = (2048 / 64) * (DM / 64), I_OUT = (DM / 64) * (DM / 64), I_FI = (DM / 64) * (2 * DFF / 64), I_FO = (DFF / 64) * (DM / 64);
constexpr int NCONV = I_IN + I_OA + I_OR + I_OUT + I_FI + I_FO;
static_assert(NCONV % 8 == 0, "conversion items are dealt eight at a time");
__device__ __forceinline__ void convert_item(Frame& F, const float* const* in, int lw, unsigned char* wset, int it) {
    LAS float* scr = (LAS float*)(F.lds + RING_OFF + F.wave * 16896);
    const GAS float* W; int K, N, mode = 0, ldw, kofs = 0; GAS bf16* WT; GAS bf16* WT2 = nullptr; const GAS float* gain = nullptr;
    if (it < I_IN) { W = (const GAS float*)in[1] + (size_t)lw * DM * NIN; K = DM; N = NIN; mode = 2; gain = (const GAS float*)in[7] + (size_t)lw * DM; WT = (GAS bf16*)(wset + WS_WNAT); WT2 = (GAS bf16*)(wset + WS_WSWP); ldw = DM; }
    else if ((it -= I_IN) < I_OA) { W = (const GAS float*)in[2] + (size_t)lw * AW * DM; K = AW; N = DM; WT = (GAS bf16*)(wset + WS_WOA); ldw = 3072; }
    else if ((it -= I_OA) < I_OR) { W = (const GAS float*)in[3] + (size_t)lw * 2048 * DM; K = 2048; N = DM; WT = (GAS bf16*)(wset + WS_WOA); ldw = 3072; kofs = 1024; }
    else if ((it -= I_OR) < I_OUT) { W = (const GAS float*)in[4] + (size_t)lw * DM * DM; K = DM; N = DM; WT = (GAS bf16*)(wset + WS_WOUT); ldw = DM; }
    else if ((it -= I_OUT) < I_FI) { W = (const GAS float*)in[9] + (size_t)lw * DM * 2 * DFF; K = DM; N = 2 * DFF; mode = 1; gain = (const GAS float*)in[8] + (size_t)lw * DM; WT = (GAS bf16*)(wset + WS_WFI); ldw = DM; }
    else { it -= I_FI; W = (const GAS float*)in[10] + (size_t)lw * DFF * DM; K = DFF; N = DM; WT = (GAS bf16*)(wset + WS_WFO); ldw = DFF; }
    const int nblk = N / 64, kb = it / nblk, nb = it % nblk, k0 = 64 * kb, n0 = 64 * nb;
    int dst = n0, dst2 = 0; GAS bf16* w1 = WT; GAS bf16* w2 = nullptr;
    if (mode == 1) { const int isu = n0 >= DFF ? 1 : 0; const int j = n0 - isu * DFF; dst = (j / 128) * 256 + isu * 128 + (j % 128); }
    if (mode == 2) {
        if (n0 < 3072) dst = n0; else if (n0 < 4096) dst = n0 - 3072 + 9216; else if (n0 < 5120) dst = n0 - 4096 + 10240;
        else if (n0 < 7168) { w1 = nullptr; w2 = WT2; dst2 = n0 - 5120; } else dst = n0 - 7168 + 3072; }
    transpose_item(W, K, N, k0, n0, w1, dst, w2, dst2, ldw, kofs, scr, F.lane, gain);
}
__device__ __forceinline__ void rmsnorm_phase(Frame& F, const GAS float* x, const GAS float* g, GAS bf16* out) {
    const int gw = F.vcu * NWAVES + F.wave, NGW = F.G * NWAVES;
    for (int m = gw; m < M; m += 2 * NGW) {
        const bool two = m + NGW < M; const int m1 = two ? m + NGW : m;
        const GAS f32x4* xr0 = (const GAS f32x4*)(x + (size_t)m * DM) + F.lane; const GAS f32x4* xr1 = (const GAS f32x4*)(x + (size_t)m1 * DM) + F.lane;
        f32x4 v0[8], v1[8]; float s0 = 0.f, s1 = 0.f;
#pragma unroll
        for (int j = 0; j < 8; ++j) v0[j] = xr0[64 * j];
#pragma unroll
        for (int j = 0; j < 8; ++j) v1[j] = xr1[64 * j];
#pragma unroll
        for (int j = 0; j < 8; ++j) { s0 += (v0[j].x * v0[j].x + v0[j].y * v0[j].y) + (v0[j].z * v0[j].z + v0[j].w * v0[j].w); s1 += (v1[j].x * v1[j].x + v1[j].y * v1[j].y) + (v1[j].z * v1[j].z + v1[j].w * v1[j].w); }
        const float rstd0 = 1.0f / sqrtf(wave_sum(s0) * (1.f / DM) + EPS), rstd1 = 1.0f / sqrtf(wave_sum(s1) * (1.f / DM) + EPS);
        GAS unsigned long long* o0 = (GAS unsigned long long*)(out + (size_t)m * DM) + F.lane; GAS unsigned long long* o1 = (GAS unsigned long long*)(out + (size_t)m1 * DM) + F.lane;
#pragma unroll
        for (int j = 0; j < 8; ++j) { const f32x4 gg = ((const GAS f32x4*)g)[F.lane + 64 * j];
            o0[64 * j] = (unsigned long long)pk2(v0[j].x * rstd0 * gg.x, v0[j].y * rstd0 * gg.y) | ((unsigned long long)pk2(v0[j].z * rstd0 * gg.z, v0[j].w * rstd0 * gg.w) << 32);
            if (two) o1[64 * j] = (unsigned long long)pk2(v1[j].x * rstd1 * gg.x, v1[j].y * rstd1 * gg.y) | ((unsigned long long)pk2(v1[j].z * rstd1 * gg.z, v1[j].w * rstd1 * gg.w) << 32); }
    }
}
__device__ __forceinline__ float rms_ssq4(const v4u (&w)[4]) { float s = 0.f;
#pragma unroll
    for (int j = 0; j < 4; ++j) s += (blo(w[j].x) * blo(w[j].x) + bhi(w[j].x) * bhi(w[j].x)) + (blo(w[j].y) * blo(w[j].y) + bhi(w[j].y) * bhi(w[j].y)) + (blo(w[j].z) * blo(w[j].z) + bhi(w[j].z) * bhi(w[j].z)) + (blo(w[j].w) * blo(w[j].w) + bhi(w[j].w) * bhi(w[j].w));
    return s; }
__device__ __forceinline__ void rms_store4(const v4u (&w)[4], float rstd, const GAS float* g, GAS bf16* orow, int lane) {
    GAS v4u* o = (GAS v4u*)orow + lane;
#pragma unroll
    for (int j = 0; j < 4; ++j) { const f32x4 g0 = ((const GAS f32x4*)g)[2 * (lane + 64 * j)], g1 = ((const GAS f32x4*)g)[2 * (lane + 64 * j) + 1];
        v4u r; r.x = pk2(blo(w[j].x) * rstd * g0.x, bhi(w[j].x) * rstd * g0.y); r.y = pk2(blo(w[j].y) * rstd * g0.z, bhi(w[j].y) * rstd * g0.w);
        r.z = pk2(blo(w[j].z) * rstd * g1.x, bhi(w[j].z) * rstd * g1.y); r.w = pk2(blo(w[j].w) * rstd * g1.z, bhi(w[j].w) * rstd * g1.w);
        o[64 * j] = r; }
}
__device__ __forceinline__ void rmsnorm_bf16_phase(Frame& F, const GAS bf16* x, const GAS float* g, GAS bf16* out) {
    const int gw = F.vcu * NWAVES + F.wave, NGW = F.G * NWAVES;
    for (int m = gw; m < M; m += 2 * NGW) {
        const bool two = m + NGW < M; const int m1 = two ? m + NGW : m;
        const GAS v4u* xr0 = (const GAS v4u*)(x + (size_t)m * DM) + F.lane; const GAS v4u* xr1 = (const GAS v4u*)(x + (size_t)m1 * DM) + F.lane;
        v4u w0[4], w1[4];
#pragma unroll
        for (int j = 0; j < 4; ++j) w0[j] = xr0[64 * j];
#pragma unroll
        for (int j = 0; j < 4; ++j) w1[j] = xr1[64 * j];
        const float r0 = 1.0f / sqrtf(wave_sum(rms_ssq4(w0)) * (1.f / DM) + EPS), r1 = 1.0f / sqrtf(wave_sum(rms_ssq4(w1)) * (1.f / DM) + EPS);
        rms_store4(w0, r0, g, out + (size_t)m * DM, F.lane);
        if (two) rms_store4(w1, r1, g, out + (size_t)m1 * DM, F.lane);
    }
}
__device__ __forceinline__ void rstd_phase(Frame& F, const GAS float* PS, GAS float* RS) {
    const int sub = F.lane & 7;
    for (int row = (F.vcu * NWAVES * 64 + F.tid) >> 3; row < M; row += F.G * NWAVES * 8) {
        float q = 0.f;
#pragma unroll
        for (int t_ = 0; t_ < 4; ++t_) { const f32x4 p = ((const GAS f32x4*)(PS + (size_t)row * 128))[sub * 4 + t_]; q += (p.x + p.y) + (p.z + p.w); }
        q += __int_as_float(SWZ_XOR(__float_as_int(q), 1)); q += __int_as_float(SWZ_XOR(__float_as_int(q), 2)); q += __int_as_float(SWZ_XOR(__float_as_int(q), 4));
        if (sub == 0) RS[row] = 1.0f / sqrtf(q * (1.f / DM) + EPS);
    }
}
__device__ __forceinline__ void rs_prefill_lds(Frame& F, const GAS float* PS, int panel) {
    LAS float* dst = (LAS float*)(F.lds + RING_OFF + pg8::STAGE_BYTES);
    const int row = F.tid >> 1, half = F.tid & 1;
    const GAS f32x4* p = (const GAS f32x4*)(PS + ((size_t)panel * 256 + row) * 128 + half * 64);
    f32x4 v[16];
#pragma unroll
    for (int j = 0; j < 16; ++j) v[j] = p[j];
    float q = 0.f;
#pragma unroll
    for (int j = 0; j < 16; ++j) q += (v[j].x + v[j].y) + (v[j].z + v[j].w);
    q += __int_as_float(SWZ_XOR(__float_as_int(q), 1));
    const float r = 1.0f / sqrtf(q * (1.f / DM) + EPS);
    if (half == 0) { dst[row] = r; dst[256 + row] = r; }
    __syncthreads();
}
__device__ __forceinline__ void cast_rstd_phase(Frame& F, const GAS float* x, GAS bf16* out, GAS float* RS) {
    const int gw = F.vcu * NWAVES + F.wave, NGW = F.G * NWAVES;
    for (int m = gw; m < M; m += 2 * NGW) {
        const bool two = m + NGW < M; const int m1 = two ? m + NGW : m;
        const GAS f32x4* xr0 = (const GAS f32x4*)(x + (size_t)m * DM) + F.lane; const GAS f32x4* xr1 = (const GAS f32x4*)(x + (size_t)m1 * DM) + F.lane;
        f32x4 v0[8], v1[8]; float s0 = 0.f, s1 = 0.f;
#pragma unroll
        for (int j = 0; j < 8; ++j) v0[j] = xr0[64 * j];
#pragma unroll
        for (int j = 0; j < 8; ++j) v1[j] = xr1[64 * j];
#pragma unroll
        for (int j = 0; j < 8; ++j) { s0 += (v0[j].x * v0[j].x + v0[j].y * v0[j].y) + (v0[j].z * v0[j].z + v0[j].w * v0[j].w); s1 += (v1[j].x * v1[j].x + v1[j].y * v1[j].y) + (v1[j].z * v1[j].z + v1[j].w * v1[j].w); }
        const float rstd0 = 1.0f / sqrtf(wave_sum(s0) * (1.f / DM) + EPS), rstd1 = 1.0f / sqrtf(wave_sum(s1) * (1.f / DM) + EPS);
        GAS unsigned long long* o0 = (GAS unsigned long long*)(out + (size_t)m * DM) + F.lane; GAS unsigned long long* o1 = (GAS unsigned long long*)(out + (size_t)m1 * DM) + F.lane;
#pragma unroll
        for (int j = 0; j < 8; ++j) {
            o0[64 * j] = (unsigned long long)pk2(v0[j].x, v0[j].y) | ((unsigned long long)pk2(v0[j].z, v0[j].w) << 32);
            if (two) o1[64 * j] = (unsigned long long)pk2(v1[j].x, v1[j].y) | ((unsigned long long)pk2(v1[j].z, v1[j].w) << 32); }
        if (F.lane == 0) { RS[m] = rstd0; if (two) RS[m1] = rstd1; }
    }
}
__device__ __forceinline__ void qknorm_phase(Frame& F, const GAS bf16* PROJ, GAS bf16* QKN, const GAS float* qg, const GAS float* kg, GAS float* kmean) {
    LAS float* red = (LAS float*)(F.lds + RING_OFF);
    const int nunits = 2 * BATCH * AH * NBLK;
    const int l16 = F.lane & 15, rs = F.lane >> 4;
    v4u wn[8];
#define QK_SRC(u_) (PROJ + ((size_t)((((u_) >> 1) / NBLK) / AH) * SEQ + (((u_) >> 1) % NBLK) * MB + F.wave * 32 + rs) * LDP + (((u_) & 1) ? C_KA : C_QA) + ((((u_) >> 1) / NBLK) % AH) * AD + l16 * 8)
    if (F.vcu < nunits) { const GAS bf16* src0 = QK_SRC(F.vcu);
#pragma unroll
        for (int st = 0; st < 8; ++st) wn[st] = *(const GAS v4u*)(src0 + (size_t)(4 * st) * LDP); }
    for (int u = F.vcu; u < nunits; u += F.G) {
        const int isk = u & 1, r = u >> 1, n = r % NBLK, bh = r / NBLK, h = bh % AH, b = bh / AH;
        const GAS float* gain = (isk ? kg : qg) + l16 * 8;
        const f32x4 ga = *(const GAS f32x4*)gain, gb = *(const GAS f32x4*)(gain + 4);
        const size_t row0 = (size_t)b * SEQ + n * MB + F.wave * 32 + rs;
        GAS bf16* dst = QKN + row0 * 2048 + (isk ? 1024 : 0) + h * AD + l16 * 8;
        v4u w[8];
#pragma unroll
        for (int st = 0; st < 8; ++st) w[st] = wn[st];
        if (u + F.G < nunits) { const GAS bf16* src1 = QK_SRC(u + F.G);
#pragma unroll
            for (int st = 0; st < 8; ++st) wn[st] = *(const GAS v4u*)(src1 + (size_t)(4 * st) * LDP); }
        float a[8] = {0.f, 0.f, 0.f, 0.f, 0.f, 0.f, 0.f, 0.f};
#pragma unroll
        for (int st = 0; st < 8; ++st) {
            const float x0 = blo(w[st].x), x1 = bhi(w[st].x), x2 = blo(w[st].y), x3 = bhi(w[st].y), x4 = blo(w[st].z), x5 = bhi(w[st].z), x6 = blo(w[st].w), x7 = bhi(w[st].w);
            float q = ((x0 * x0 + x1 * x1) + (x2 * x2 + x3 * x3)) + ((x4 * x4 + x5 * x5) + (x6 * x6 + x7 * x7));
            q += __int_as_float(SWZ_XOR(__float_as_int(q), 1)); q += __int_as_float(SWZ_XOR(__float_as_int(q), 2)); q += __int_as_float(SWZ_XOR(__float_as_int(q), 4)); q += __int_as_float(SWZ_XOR(__float_as_int(q), 8));
            const float rstd = 1.0f / sqrtf(q * (1.f / AD) + EPS);
            v4u o; o.x = pk2(x0 * rstd * ga.x, x1 * rstd * ga.y); o.y = pk2(x2 * rstd * ga.z, x3 * rstd * ga.w); o.z = pk2(x4 * rstd * gb.x, x5 * rstd * gb.y); o.w = pk2(x6 * rstd * gb.z, x7 * rstd * gb.w);
            *(GAS v4u*)(dst + (size_t)(4 * st) * 2048) = o;
            a[0] += blo(o.x); a[1] += bhi(o.x); a[2] += blo(o.y); a[3] += bhi(o.y); a[4] += blo(o.z); a[5] += bhi(o.z); a[6] += blo(o.w); a[7] += bhi(o.w);
        }
        if (isk) {
#pragma unroll
            for (int k = 0; k < 8; ++k) { float v = a[k]; v += __int_as_float(SWZ_XOR(__float_as_int(v), 16));
                const auto rr = __builtin_amdgcn_permlane32_swap(__float_as_uint(v), __float_as_uint(v), false, false); a[k] = __uint_as_float(rr[0]) + __uint_as_float(rr[1]); }
            __syncthreads();
            if (F.lane < 16) {
#pragma unroll
                for (int k = 0; k < 8; ++k) red[F.wave * 128 + l16 * 8 + k] = a[k]; }
            __syncthreads();
            if (F.tid < 128) { float sm = 0.f;
#pragma unroll
                for (int w8 = 0; w8 < 8; ++w8) sm += red[w8 * 128 + F.tid];
                kmean[(size_t)(bh * NBLK + n) * AD + F.tid] = sm * (1.f / MB); }
        }
    }
#undef QK_SRC
}
__device__ __forceinline__ void attn_naive_phase(Frame& F, const GAS bf16* QKN, const GAS bf16* PROJ, const GAS float* kmean, GAS bf16* OA, int wg_lo) {
    LAS float* qf = (LAS float*)(F.lds + RING_OFF + F.wave * 8192);
    LAS float* pb = qf + 128;
    const int lane = F.lane;
    const int nw = (F.G - wg_lo) * NWAVES, w0 = (F.vcu - wg_lo) * NWAVES + F.wave;
    const float scale = 0.08838834764831845f;
    for (int u = w0; u < BATCH * AH * SEQ; u += nw) {
        const int t = u % SEQ, bh = u / SEQ, h = bh % AH, b = bh / AH, cur = t >> 8;
        const size_t m = (size_t)b * SEQ + t;
        const float slope = exp2f(-(float)(h + 1));
        { const unsigned qw = *((const GAS unsigned*)(QKN + m * 2048 + h * AD) + lane); qf[2 * lane] = blo(qw); qf[2 * lane + 1] = bhi(qw); }
        LDS_WAIT(); asm volatile("" ::: "memory");
        float g = -INFINITY;
        if (lane < cur) { const GAS float* km = kmean + (size_t)(bh * NBLK + lane) * AD; float a = 0.f;
            for (int d = 0; d < AD; d += 4) { const f32x4 kv = *(const GAS f32x4*)(km + d); a += qf[d] * kv.x + qf[d + 1] * kv.y + qf[d + 2] * kv.z + qf[d + 3] * kv.w; }
            g = a; }
        int sel0 = 0, sel1 = 0, sel2 = 0; bool val0 = false, val1 = false, val2 = false;
#pragma unroll
        for (int j = 0; j < 3; ++j) {
            const float mx = wave_max(g); const bool v = mx > -INFINITY;
            const unsigned long long bal = __ballot(g == mx);
            const int ln = v ? (__ffsll((long long)bal) - 1) : 0;
            if (v && lane == ln) g = -INFINITY;
            if (j == 0) { sel0 = ln; val0 = v; } else if (j == 1) { sel1 = ln; val1 = v; } else { sel2 = ln; val2 = v; }
        }
        float sc[4][4]; float mx = -INFINITY;
#pragma unroll
        for (int jb = 0; jb < 4; ++jb) {
            const bool v = jb == 0 ? val0 : jb == 1 ? val1 : jb == 2 ? val2 : true;
            const int blk = jb == 0 ? sel0 : jb == 1 ? sel1 : jb == 2 ? sel2 : cur;
#pragma unroll
            for (int i = 0; i < 4; ++i) {
                float s = -INFINITY;
                if (v) {
                    const int kpos = blk * MB + i * 64 + lane;
                    const GAS bf16* krow = QKN + ((size_t)b * SEQ + kpos) * 2048 + 1024 + h * AD;
                    float a = 0.f;
                    for (int d8 = 0; d8 < 16; ++d8) { const v4u kk = *(const GAS v4u*)(krow + d8 * 8); const LAS float* q8 = qf + d8 * 8;
                        a += q8[0] * blo(kk.x) + q8[1] * bhi(kk.x) + q8[2] * blo(kk.y) + q8[3] * bhi(kk.y) + q8[4] * blo(kk.z) + q8[5] * bhi(kk.z) + q8[6] * blo(kk.w) + q8[7] * bhi(kk.w); }
                    s = a * scale - slope * (float)(t - kpos);
                    if (jb == 3 && kpos > t) s = -INFINITY;
                }
                sc[jb][i] = s; mx = fmaxf(mx, s);
            }
        }
        mx = wave_max(mx);
        float sum = 0.f;
#pragma unroll
        for (int jb = 0; jb < 4; ++jb)
#pragma unroll
            for (int i = 0; i < 4; ++i) { const float p = __expf(sc[jb][i] - mx); sum += p; pb[jb * 256 + i * 64 + lane] = p; }
        sum = wave_sum(sum);
        LDS_WAIT(); asm volatile("" ::: "memory");
        float o0 = 0.f, o1 = 0.f;
#pragma unroll
        for (int jb = 0; jb < 4; ++jb) {
            const bool v = jb == 0 ? val0 : jb == 1 ? val1 : jb == 2 ? val2 : true;
            const int blk = jb == 0 ? sel0 : jb == 1 ? sel1 : jb == 2 ? sel2 : cur;
            if (v) {
                const int nk = jb == 3 ? (t - cur * MB + 1) : MB;
                const GAS bf16* vb = PROJ + ((size_t)b * SEQ + blk * MB) * LDP + C_VA + h * AD;
                for (int kk = 0; kk < nk; ++kk) { const float p = pb[jb * 256 + kk]; const unsigned vw = *((const GAS unsigned*)(vb + (size_t)kk * LDP) + lane); o0 += p * blo(vw); o1 += p * bhi(vw); }
            }
        }
        const float inv = 1.0f / sum;
        *((GAS unsigned*)(OA + m * AW + h * AD) + lane) = pk2(o0 * inv, o1 * inv);
        LDS_WAIT(); asm volatile("" ::: "memory");
    }
}
__device__ __forceinline__ void ktrans_phase(Frame& F, const GAS bf16* KB, GAS bf16* KTB) {
    LAS bf16* scr = (LAS bf16*)(F.lds + RING_OFF + F.wave * 9216);
    const int gw = F.vcu * NWAVES + F.wave, NGW = F.G * NWAVES, lr = F.lane >> 3, lc = F.lane & 7;
    for (int it = gw; it < 256 * 16; it += NGW) {
        const int c = it >> 4, jt = (it >> 2) & 3, dt = it & 3;
        const GAS bf16* src = KB + (size_t)c * 65536 + (size_t)(jt * 64) * 256 + dt * 64;
        GAS bf16* dst = KTB + (size_t)c * 65536 + (size_t)(dt * 64) * 256 + jt * 64;
        v4u v[8];
#pragma unroll
        for (int i = 0; i < 8; ++i) v[i] = *(const GAS v4u*)(src + (size_t)(lr + 8 * i) * 256 + lc * 8);
#pragma unroll
        for (int i = 0; i < 8; ++i) *(LAS v4u*)(scr + (lr + 8 * i) * 72 + lc * 8) = v[i];
        LDS_WAIT(); asm volatile("" ::: "memory");
#pragma unroll
        for (int i = 0; i < 8; ++i) { const int d = lr + 8 * i; const LAS bf16* p = scr + (lc * 8) * 72 + d;
            v4u o; o.x = (unsigned)p[0] | ((unsigned)p[72] << 16); o.y = (unsigned)p[2 * 72] | ((unsigned)p[3 * 72] << 16); o.z = (unsigned)p[4 * 72] | ((unsigned)p[5 * 72] << 16); o.w = (unsigned)p[6 * 72] | ((unsigned)p[7 * 72] << 16);
            *(GAS v4u*)(dst + (size_t)d * 256 + lc * 8) = o; }
        LDS_WAIT(); asm volatile("" ::: "memory");
    }
}
__device__ __forceinline__ void scan_item(Frame& F, const GAS bf16* ST, GAS bf16* BQ, int item) {
    { const int idx = item * 512 + F.tid;
        const int bh = idx >> 14, rem = idx & 16383, e = rem >> 5, d8 = rem & 31, h = bh & 3;
        const float gC = exp2f(256.0f * __log2f(1.0f - exp2f(-5.0f - (float)h)));
        float s[8];
#pragma unroll
        for (int k = 0; k < 8; ++k) s[k] = 0.f;
        const GAS bf16* sp = ST + (size_t)bh * 32 * 131072 + (size_t)e * 256 + 8 * d8;
        GAS bf16* bp = BQ + (size_t)bh * 32 * 262144 + (size_t)e * 512 + 256 + 8 * d8;
        for (int n0 = 0; n0 < 32; n0 += 16) {
            v4u kv[16];
#pragma unroll
            for (int k = 0; k < 16; ++k) kv[k] = *(const GAS v4u*)(sp + (size_t)(n0 + k) * 131072);
#pragma unroll
            for (int k = 0; k < 16; ++k) {
                v4u o; o.x = pk2(s[0], s[1]); o.y = pk2(s[2], s[3]); o.z = pk2(s[4], s[5]); o.w = pk2(s[6], s[7]);
                *(GAS v4u*)(bp + (size_t)(n0 + k) * 262144) = o;
                s[0] = s[0] * gC + blo(kv[k].x); s[1] = s[1] * gC + bhi(kv[k].x); s[2] = s[2] * gC + blo(kv[k].y); s[3] = s[3] * gC + bhi(kv[k].y);
                s[4] = s[4] * gC + blo(kv[k].z); s[5] = s[5] * gC + bhi(kv[k].z); s[6] = s[6] * gC + blo(kv[k].w); s[7] = s[7] * gC + bhi(kv[k].w); }
        }
    }
}
__device__ __forceinline__ void attn_phase(Frame& F, char* ldsg, const GAS bf16* QKN, const GAS bf16* PROJ, const GAS float* kmean, GAS bf16* OA, gu32* qctr, const GAS float* qg, const GAS float* kg) {
    const float gq = wave_max(fmaxf(fabsf(qg[2 * F.lane]), fabsf(qg[2 * F.lane + 1]))), gk = wave_max(fmaxf(fabsf(kg[2 * F.lane]), fabsf(kg[2 * F.lane + 1])));
    const float tv = 2.0f * 11.3138f * gq * gk + 25.0f;
    volatile int* misc = (volatile int*)(ldsg + att::OFF_MISC);
    __syncthreads();
    if (F.tid == 0) misc[3] = __float_as_int(tv);
    for (;;) {
        __syncthreads();
        if (F.tid == 0) misc[2] = (int)__hip_atomic_fetch_add(qctr, 1u, RLX_AGENT);
        __syncthreads();
        const int u = __builtin_amdgcn_readfirstlane(misc[2]);
        if (u >= BATCH * AH * NBLK) break;
        const int cur = 31 - (u >> 4), rem = u & 15, h = 7 - (rem >> 1), b = rem & 1;
        const float tnat = __int_as_float(__builtin_amdgcn_readfirstlane(misc[3]));
        const float wf = tnat * exp2f((float)(h + 1)) * (1.0f / 256.0f);
        const int wpast = wf >= 31.0f ? 31 : (int)wf + 1;
        int tl; asm volatile("v_mbcnt_lo_u32_b32 %0, -1, 0\n\tv_mbcnt_hi_u32_b32 %0, -1, %0" : "=v"(tl)); tl += F.wave * 64;
        const float smax2 = (tnat - 25.0f) * 0.5f * 1.02f * att::LOG2E;
        att::attn_unit(b, h, cur, QKN, 2048, 0, 1024, PROJ, LDP, C_VA, SEQ, kmean, OA, 3072, ldsg, tl, wpast, smax2);
    }
}
__device__ __forceinline__ int attn_wpast(float tnat, int h) { const float wf = tnat * exp2f((float)(h + 1)) * (1.0f / 256.0f); return wf >= 31.0f ? 31 : (int)wf + 1; }
__device__ __forceinline__ float attn_tnat(Frame& F, const GAS float* qg, const GAS float* kg) {
    const float gq = wave_max(fmaxf(fabsf(qg[2 * F.lane]), fabsf(qg[2 * F.lane + 1]))), gk = wave_max(fmaxf(fabsf(kg[2 * F.lane]), fabsf(kg[2 * F.lane + 1])));
    return 2.0f * 11.3138f * gq * gk + 25.0f;
}
__device__ __forceinline__ void attn_select_phase(Frame& F, const GAS bf16* QKN, const GAS float* kmean, GAS bf16* LIST, gu32* LCNT, GAS float* PL, const GAS float* qg, const GAS float* kg) {
    const float tnat = attn_tnat(F, qg, kg);
    const int gw = F.vcu * NWAVES + F.wave, NGW = F.G * NWAVES;
    for (int wu = gw; wu < BATCH * AH * (NBLK - 1) * 8; wu += NGW) {
        const int wv = wu & 7, r = wu >> 3, cur = 1 + r % (NBLK - 1), bh = r / (NBLK - 1), h = bh % AH, b = bh / AH;
        att::attn_select(b, h, cur, wv, QKN, 2048, SEQ, kmean, LIST, LCNT, PL, M, F.lane, attn_wpast(tnat, h));
    }
}
__device__ __forceinline__ void attn_gather_phase(Frame& F, char* ldsg, const GAS bf16* QKN, const GAS bf16* PROJ, const GAS bf16* LIST, gu32* LCNT, GAS bf16* P01, GAS bf16* P23, GAS float* PL, gu32* qctr, const GAS float* qg, const GAS float* kg) {
    const float tv = attn_tnat(F, qg, kg);
    volatile int* misc = (volatile int*)(ldsg + att::OFF_MISC);
    volatile int* pref = (volatile int*)(ldsg + att::OFF_PREF);
    volatile int* pcnt = (volatile int*)(ldsg + att::OFF_PREF + 516 * 4);
    __syncthreads();
    { const int c_ = (int)__hip_atomic_load(LCNT + F.tid, RLX_AGENT); pcnt[F.tid] = c_; pref[1 + F.tid] = (c_ + 255) >> 8; }
    if (F.tid == 0) misc[3] = __float_as_int(tv);
    __syncthreads();
    unsigned qn = 0u;
    if (F.tid == 0) { int s_ = 0; pref[0] = 0; for (int i = 1; i <= 512; ++i) { s_ += pref[i]; pref[i] = s_; }
        qn = __hip_atomic_fetch_add(qctr, 1u, RLX_AGENT); }
    for (;;) {
        if (F.tid == 0) { const int q = (int)qn; const int ug = pref[512];
            int li = -1, ch = 0;
            if (q < ug) { int lo_ = 0, hi_ = 512; while (hi_ - lo_ > 1) { const int mid = (lo_ + hi_) >> 1; if (pref[mid] <= q) lo_ = mid; else hi_ = mid; } li = lo_; ch = q - pref[lo_]; }
            else if (q < ug + BATCH * AH * NBLK) { li = 512 + (q - ug); }
            misc[2] = li; misc[5] = ch;
            if (li >= 0) qn = __hip_atomic_fetch_add(qctr, 1u, RLX_AGENT); }
        __syncthreads();
        const int li = __builtin_amdgcn_readfirstlane(misc[2]), ch = __builtin_amdgcn_readfirstlane(misc[5]);
        if (li < 0) break;
        const float tnat = __int_as_float(__builtin_amdgcn_readfirstlane(misc[3]));
        const float smax2 = (tnat - 25.0f) * 0.5f * 1.02f * att::LOG2E;
        int tl; asm volatile("v_mbcnt_lo_u32_b32 %0, -1, 0\n\tv_mbcnt_hi_u32_b32 %0, -1, %0" : "=v"(tl)); tl += F.wave * 64;
        if (li < 512) { const int n = li & 31, bh = li >> 5, h = bh & 7, b = bh >> 3; const int cnt = __builtin_amdgcn_readfirstlane(pcnt[li]);
            att::attn_block_unit(false, b, h, n, ch * 256, cnt, LIST, QKN, 2048, 1024, PROJ, LDP, C_VA, SEQ, P01, P23, PL, M, ldsg, tl, smax2); }
        else { const int u = li - 512, cur = u >> 4, rem = u & 15, h = rem >> 1, b = rem & 1;
            att::attn_block_unit(true, b, h, cur, 0, 256, LIST, QKN, 2048, 1024, PROJ, LDP, C_VA, SEQ, P01, P23, PL, M, ldsg, tl, smax2); }
    }
}
constexpr int SEGR = 1024;
__device__ __forceinline__ void attn_kv_phase(Frame& F, char* ldsg, const GAS bf16* QKN, const GAS bf16* PROJ, const GAS bf16* LIST, gu32* LCNT, GAS bf16* P01, GAS bf16* P23, GAS float* PL, gu32* qctr, const GAS float* qg, const GAS float* kg) {
    const float tv = attn_tnat(F, qg, kg);
    volatile int* pref = (volatile int*)(ldsg + att::KV4_END);
    volatile int* pcnt = (volatile int*)(ldsg + att::KV4_END + 516 * 4);
    volatile unsigned short* utab = (volatile unsigned short*)(ldsg + att::KV4_END + 516 * 4 + 512 * 4);
    volatile int* misc = (volatile int*)(ldsg + att::KV4_END + 516 * 4 + 512 * 4 + 4096);
    __syncthreads();
    unsigned qn = 0u;
    if (F.tid == 0) qn = __hip_atomic_fetch_add(qctr, 1u, RLX_AGENT);
    int pv_;
    { const int i = F.tid, n = i >> 4, r = i & 15, h = 7 - (r >> 1), b = r & 1, lid = (b * 8 + h) * 32 + n;
      const int c_ = n < 31 ? (int)__hip_atomic_load(LCNT + lid, RLX_AGENT) : 0; pcnt[i] = c_; const int ns = (c_ + SEGR - 1) / SEGR; pv_ = ns > 0 ? ns : 1; pref[1 + i] = pv_; }
    if (F.tid == 0) { misc[1] = __float_as_int(tv); pref[0] = 0; }
    for (int off = 1; off < 512; off <<= 1) {
        __syncthreads();
        const int add_ = F.tid >= off ? pref[1 + F.tid - off] : 0;
        __syncthreads();
        pv_ += add_; pref[1 + F.tid] = pv_;
    }
    __syncthreads();
    if (F.tid == 0) { const int s_ = pref[512]; misc[2] = s_ < 2048 ? s_ : 2048; }
    __syncthreads();
    { const int i = F.tid, u0 = pref[i], u1 = pref[i + 1]; for (int u = u0; u < u1 && u < 2048; ++u) utab[u] = (unsigned short)((i << 4) | (u - u0)); }
    __syncthreads();
    for (;;) {
        if (F.tid == 0) { const int q = (int)qn; int code = -1; if (q < misc[2]) { code = utab[q]; qn = __hip_atomic_fetch_add(qctr, 1u, RLX_AGENT); } misc[0] = code; }
        __syncthreads();
        const int code = __builtin_amdgcn_readfirstlane(misc[0]);
        if (code < 0) break;
        const int i = code >> 4, seg = code & 15, n = i >> 4, r = i & 15, h = 7 - (r >> 1), b = r & 1;
        const int cnt = __builtin_amdgcn_readfirstlane(pcnt[i]);
        const int seg0 = seg * SEGR; int segn = cnt - seg0; segn = segn > SEGR ? SEGR : (segn < 0 ? 0 : segn);
        const float tnat = __int_as_float(__builtin_amdgcn_readfirstlane(misc[1]));
        const float smax2 = (tnat - 25.0f) * 0.5f * 1.02f * att::LOG2E;
        int tl; asm volatile("v_mbcnt_lo_u32_b32 %0, -1, 0\n\tv_mbcnt_hi_u32_b32 %0, -1, %0" : "=v"(tl)); tl += F.wave * 64;
        att::attn_kv_unit(b, h, n, seg0, segn, seg == 0, LIST, QKN, 2048, 1024, PROJ, LDP, C_VA, SEQ, P01, P23, PL, M, ldsg, tl, smax2);
    }
}
__device__ __forceinline__ v4u combine_unit(float l0, float l1, float l2, float l3, const v4u w0, const v4u w1, const v4u w2, const v4u w3) {
    const float inv = 1.0f / (((l0 + l1) + l2) + l3);
    const float c0 = l0 * inv, c1 = l1 * inv, c2 = l2 * inv, c3 = l3 * inv;
#define CMB(f, c) ((l0 > 0.f ? c0 * f(w0.c) : 0.f) + (l1 > 0.f ? c1 * f(w1.c) : 0.f) + (l2 > 0.f ? c2 * f(w2.c) : 0.f) + c3 * f(w3.c))
    v4u o;
    o.x = pk2(CMB(blo, x), CMB(bhi, x)); o.y = pk2(CMB(blo, y), CMB(bhi, y)); o.z = pk2(CMB(blo, z), CMB(bhi, z)); o.w = pk2(CMB(blo, w), CMB(bhi, w));
#undef CMB
    return o;
}
__device__ __forceinline__ void attn_combine_phase(Frame& F, const GAS bf16* P01, const GAS bf16* P23, const GAS float* PL, GAS bf16* AC) {
    const int gw = F.vcu * NWAVES + F.wave, NGW = F.G * NWAVES, g4 = F.lane >> 4, l16 = F.lane & 15;
    for (int u4 = gw; u4 < M * AH / 4; u4 += 2 * NGW) {
        const bool two = u4 + NGW < M * AH / 4; const int u4b = two ? u4 + NGW : u4;
        const int ua = u4 * 4 + g4, ub = u4b * 4 + g4; const size_t ma = ua >> 3, mb = ub >> 3; const int ha = ua & 7, hb = ub & 7;
        const float la0 = PL[((size_t)0 * M + ma) * 8 + ha], la1 = PL[((size_t)1 * M + ma) * 8 + ha], la2 = PL[((size_t)2 * M + ma) * 8 + ha], la3 = PL[((size_t)3 * M + ma) * 8 + ha];
        const float lb0 = PL[((size_t)0 * M + mb) * 8 + hb], lb1 = PL[((size_t)1 * M + mb) * 8 + hb], lb2 = PL[((size_t)2 * M + mb) * 8 + hb], lb3 = PL[((size_t)3 * M + mb) * 8 + hb];
        const v4u wa0 = ((const GAS v4u*)(P01 + ((size_t)0 * M + ma) * 1024 + ha * 128))[l16], wa1 = ((const GAS v4u*)(P01 + ((size_t)1 * M + ma) * 1024 + ha * 128))[l16];
        const v4u wa2 = ((const GAS v4u*)(P23 + ((size_t)0 * M + ma) * 1024 + ha * 128))[l16], wa3 = ((const GAS v4u*)(P23 + ((size_t)1 * M + ma) * 1024 + ha * 128))[l16];
        const v4u wb0 = ((const GAS v4u*)(P01 + ((size_t)0 * M + mb) * 1024 + hb * 128))[l16], wb1 = ((const GAS v4u*)(P01 + ((size_t)1 * M + mb) * 1024 + hb * 128))[l16];
        const v4u wb2 = ((const GAS v4u*)(P23 + ((size_t)0 * M + mb) * 1024 + hb * 128))[l16], wb3 = ((const GAS v4u*)(P23 + ((size_t)1 * M + mb) * 1024 + hb * 128))[l16];
        ((GAS v4u*)(AC + ma * 3072 + ha * 128))[l16] = combine_unit(la0, la1, la2, la3, wa0, wa1, wa2, wa3);
        if (two) ((GAS v4u*)(AC + mb * 3072 + hb * 128))[l16] = combine_unit(lb0, lb1, lb2, lb3, wb0, wb1, wb2, wb3);
    }
}
__device__ __forceinline__ void groupnorm_unit(const v4u rw, const v4u gw4, GAS bf16* orow, int lane) {
    float y[8] = {blo(rw.x), bhi(rw.x), blo(rw.y), bhi(rw.y), blo(rw.z), bhi(rw.z), blo(rw.w), bhi(rw.w)};
    const float g[8] = {blo(gw4.x), bhi(gw4.x), blo(gw4.y), bhi(gw4.y), blo(gw4.z), bhi(gw4.z), blo(gw4.w), bhi(gw4.w)};
    const float mean = wave_sum(((y[0] + y[1]) + (y[2] + y[3])) + ((y[4] + y[5]) + (y[6] + y[7]))) * (1.f / RDV);
    float q = 0.f;
#pragma unroll
    for (int k = 0; k < 8; ++k) { y[k] -= mean; q += y[k] * y[k]; }
    const float rstd = 1.0f / sqrtf(wave_sum(q) * (1.f / RDV) + EPS);
    v4u o; o.x = pk2(y[0] * rstd * pg8::siluf_(g[0]), y[1] * rstd * pg8::siluf_(g[1])); o.y = pk2(y[2] * rstd * pg8::siluf_(g[2]), y[3] * rstd * pg8::siluf_(g[3]));
    o.z = pk2(y[4] * rstd * pg8::siluf_(g[4]), y[5] * rstd * pg8::siluf_(g[5])); o.w = pk2(y[6] * rstd * pg8::siluf_(g[6]), y[7] * rstd * pg8::siluf_(g[7]));
    ((GAS v4u*)orow)[lane] = o;
}
__device__ __forceinline__ void groupnorm_phase(Frame& F, const GAS bf16* RET, const GAS bf16* PROJ, GAS bf16* ORR) {
    const int gw = F.vcu * NWAVES + F.wave, NGW = F.G * NWAVES;
    for (int u0 = gw; u0 < M * RH; u0 += 4 * NGW) {
        v4u rw[4], gg[4]; int uu[4];
#pragma unroll
        for (int j = 0; j < 4; ++j) { const int u = u0 + j * NGW; uu[j] = u < M * RH ? u : u0; const size_t m = uu[j] >> 2; const int h = uu[j] & 3;
            rw[j] = ((const GAS v4u*)(RET + m * 2048 + h * RDV))[F.lane]; gg[j] = ((const GAS v4u*)(PROJ + m * LDP + C_GR + h * RDV))[F.lane]; }
#pragma unroll
        for (int j = 0; j < 4; ++j) { const size_t m = uu[j] >> 2; const int h = uu[j] & 3;
            if (j == 0 || u0 + j * NGW < M * RH) groupnorm_unit(rw[j], gg[j], ORR + m * 3072 + 1024 + h * RDV, F.lane); }
    }
}

__device__ __forceinline__ void groupnorm_own_chunks(Frame& F, const GAS bf16* RET, const GAS bf16* PROJ, GAS bf16* ORR) {
    for (int c = (int)blockIdx.x; c < BATCH * RH * (SEQ / 256); c += F.G) {
        const int b = c >> 7, h = (c >> 5) & 3, n = c & 31;
        for (int k0 = 0; k0 < 256 / NWAVES; k0 += 4) {
            v4u rw[4], gg[4];
#pragma unroll
            for (int j = 0; j < 4; ++j) { const size_t m = (size_t)b * SEQ + n * 256 + F.wave + NWAVES * (k0 + j);
                rw[j] = ((const GAS v4u*)(RET + m * 2048 + h * RDV))[F.lane]; gg[j] = ((const GAS v4u*)(PROJ + m * LDP + C_GR + h * RDV))[F.lane]; }
#pragma unroll
            for (int j = 0; j < 4; ++j) { const size_t m = (size_t)b * SEQ + n * 256 + F.wave + NWAVES * (k0 + j); groupnorm_unit(rw[j], gg[j], ORR + m * 3072 + 1024 + h * RDV, F.lane); }
        }
    }
}

struct Args { const float* in[11]; float* out; unsigned char* ws; int ph_lo, ph_hi; };
__global__ void __launch_bounds__(NWAVES * 64, 2) hybrid_fwd(Args args) {
    extern __shared__ __attribute__((aligned(16))) unsigned char lds[];
    Frame F;
    F.lds = (LAS unsigned char*)lds;
    F.MISC = (volatile LAS unsigned*)(F.lds + MISC_OFF);
    F.tid = threadIdx.x; F.lane = F.tid & 63; F.wave = __builtin_amdgcn_readfirstlane(F.tid >> 6);
    F.G = gridDim.x; { const int bx = blockIdx.x; F.vcu = (F.G % 8 == 0) ? (bx % 8) * (F.G / 8) + bx / 8 : bx; }
    unsigned char* ws = args.ws;
    F.ctl = (gu32*)(ws + WS_CTL);
    for (int u = F.tid; u < (LDS_BYTES - LDSCTL_OFF) / 4; u += NWAVES * 64) ((LAS unsigned*)(F.lds + LDSCTL_OFF))[u] = 0u;
    __syncthreads();
    XcdBarrier bar; bar.bar = (unsigned*)(F.ctl + CW_BAR); bar.x = 0; bar.st = nullptr;
    if (MK_ONE_LAUNCH) bar = xcd_barrier_post((unsigned*)(F.ctl + CW_BAR), F.MISC + 8);
    const int lo = args.ph_lo, hi = args.ph_hi;
#define IN(k) (lo <= (k) && (k) < hi)
#define SEAM(k) do { if (MK_ONE_LAUNCH && IN((k) + 1)) { XcdBarrier b2_ = bar; b2_.bar = (unsigned*)(WSP() + WS_CTL) + CW_BAR; { unsigned x_ = bar.x; asm volatile("" : "+s"(x_)); b2_.x = x_; } xcd_barrier(b2_); } } while (0)
#define WSP() ({ unsigned char* p_ = args.ws; asm volatile("" : "+s"(p_)); (unsigned char*)(GAS unsigned char*)p_; })
#define PTRS() { int ln_; asm volatile("v_mbcnt_lo_u32_b32 %0, -1, 0\n\tv_mbcnt_hi_u32_b32 %0, -1, %0" : "=v"(ln_)); F.lane = ln_; F.tid = F.wave * 64 + ln_; }     \
    unsigned char* const w_ = WSP(); \
    GAS float* const kmean = (GAS float*)(w_ + WS_KMEAN); \
    unsigned char* const wset_ = w_ + ((l & 1) ? WS_W1 : WS_W0); \
    GAS bf16*const Wnat_t = (GAS bf16*)(wset_ + WS_WNAT), *const Wswp_t = (GAS bf16*)(wset_ + WS_WSWP), *const Wcat_t = (GAS bf16*)(wset_ + WS_WOA), *const Wout_t = (GAS bf16*)(wset_ + WS_WOUT), *const Wfi_t = (GAS bf16*)(wset_ + WS_WFI), *const Wfo_t = (GAS bf16*)(wset_ + WS_WFO); \
    GAS bf16*const H = (GAS bf16*)(w_ + WS_H), *const PROJ = (GAS bf16*)(w_ + WS_PROJ), *const ACT = (GAS bf16*)(w_ + WS_PROJ), *const AC = (GAS bf16*)(w_ + WS_OA), *const MRG = (GAS bf16*)(w_ + WS_MRG); \
    GAS bf16*const RET = (GAS bf16*)(w_ + WS_RET), *const ST = (GAS bf16*)(w_ + WS_ST); \
    GAS bf16*const LIST = (GAS bf16*)(w_ + WS_LIST), *const P01 = (GAS bf16*)(w_ + WS_P01), *const P23 = (GAS bf16*)(w_ + WS_P23); GAS float*const PL = (GAS float*)(w_ + WS_PL); (void)LIST; (void)P01; (void)P23; (void)PL; \
    GAS float*const PS = (GAS float*)(w_ + WS_PS); GAS float*const RS = (GAS float*)(w_ + WS_RS); (void)PS; (void)RS; \
    GAS bf16*const QKN = (GAS bf16*)(w_ + WS_QKN); (void)QKN; GAS bf16*const XR = (GAS bf16*)(w_ + WS_RET + 64 * MiB); (void)XR;     \
    GAS bf16*const AQ = (GAS bf16*)(w_ + WS_AQ), *const BQ = (GAS bf16*)(w_ + WS_BQ), *const KB = (GAS bf16*)(w_ + WS_KB), *const KTB = (GAS bf16*)(w_ + WS_KTB); \
    (void)kmean; (void)Wnat_t; (void)Wswp_t; (void)Wcat_t; (void)Wout_t; (void)Wfi_t; (void)Wfo_t; (void)H; (void)PROJ; (void)ACT; (void)AC; (void)MRG; (void)RET; (void)ST; (void)AQ; (void)BQ; (void)KB; (void)KTB
    const bool own_panel = MK_ONE_LAUNCH && F.G == 256;
    const int team_panel = 8 * ((int)blockIdx.x & 7) + (((int)blockIdx.x >> 3) & 7);
    for (int l = 0; l < DEPTH; ++l) {
        const int pb = l * NPH;
        const GAS float* x_in = (const GAS float*)args.in[0]; GAS float* xres = (GAS float*)args.out;
        const GAS float* xcur = (l == 0) ? x_in : (const GAS float*)xres;
        if (IN(pb + 0) && l == 0) { PTRS();
            const int gw = F.vcu * NWAVES + F.wave, NGW = F.G * NWAVES;
            for (int it = gw; it < NCONV; it += NGW) convert_item(F, args.in, 0, wset_, it);
            __syncthreads();
        }
        if (IN(pb + 1)) { PTRS(); if (l == 0) { cast_rstd_phase(F, x_in, H, RS); SEAM(pb + 1); } else if (!own_panel) { rstd_phase(F, PS, RS); SEAM(pb + 1); } }
        if (IN(pb + 2)) { PTRS();
            const bool pre_ = own_panel && l > 0; if (pre_) rs_prefill_lds(F, PS, team_panel);
            { pg8::ProjDesc D{l == 0 ? (const GAS bf16*)H : (const GAS bf16*)XR, Wnat_t, Wswp_t, DM, DM, DM, {}, {}, 0}; D.On.init(M, NNAT, F.G, (int)blockIdx.x); D.Os.init(NSWP, M, F.G, (int)blockIdx.x, true); D.nnat = (D.On.nwg - (int)blockIdx.x + F.G - 1) / F.G;
              pg8::EpiProjBoth E{{PROJ, LDP, AQ, KB, pre_ ? (const GAS float*)nullptr : (const GAS float*)RS, QKN, (const GAS float*)args.in[5] + (size_t)l * AD, (const GAS float*)args.in[6] + (size_t)l * AD, kmean,
                                   (LAS float*)(F.lds + RING_OFF + pg8::STAGE_BYTES + 2048), EPS}, {KTB, BQ, RS}};
              pg8::gemm_phase<pg8::EpiProjBoth, pg8::ProjDesc, PG8_ALIGN, PG8_SP2>(F.lds + RING_OFF, D, E, F.tid); }
            SEAM(pb + 2);
        }
        if (IN(pb + 3)) { PTRS();
            ktrans_phase(F, KB, KTB);
            __syncthreads();
            if (MK_ONE_LAUNCH) { XcdBarrier b2_ = bar; b2_.bar = (unsigned*)(WSP() + WS_CTL) + CW_BAR; { unsigned x_ = bar.x; asm volatile("" : "+s"(x_)); b2_.x = x_; } xcd_barrier(b2_); }
            attn_select_phase(F, QKN, kmean, LIST, F.ctl + CW_LCNT + 512 * l, PL, (const GAS float*)args.in[5] + (size_t)l * AD, (const GAS float*)args.in[6] + (size_t)l * AD);
            __syncthreads();
            { const int c_ = (int)blockIdx.x; pg8::RetDesc D{AQ + 256, KB, BQ, KTB, 256, 512, 256, F.G, c_, c_ < 256 ? (256 - c_ + F.G - 1) / F.G : 0};
              pg8::EpiRetBoth E{{AQ}, {ST}};
              pg8::gemm_phase<pg8::EpiRetBoth, pg8::RetDesc, PG8_ALIGN, PG8_SP2>(F.lds + RING_OFF, D, E, F.tid); }
            SEAM(pb + 3);
        }
        if (IN(pb + 4)) { PTRS();
            attn_kv_phase(F, (char*)lds, QKN, PROJ, LIST, F.ctl + CW_LCNT + 512 * l, P01, P23, PL, F.ctl + CW_ATTQ + 64 * l, (const GAS float*)args.in[5] + (size_t)l * AD, (const GAS float*)args.in[6] + (size_t)l * AD);
            { int ln_; asm volatile("v_mbcnt_lo_u32_b32 %0, -1, 0\n\tv_mbcnt_hi_u32_b32 %0, -1, %0" : "=v"(ln_)); F.lane = ln_; F.tid = F.wave * 64 + ln_; }
            for (;;) {
                __syncthreads();
                if (F.tid == 0) F.MISC[16] = __hip_atomic_fetch_add(F.ctl + CW_SCQ + 64 * l, 1u, RLX_AGENT);
                __syncthreads();
                const int it = (int)__builtin_amdgcn_readfirstlane(F.MISC[16]);
                if (it >= BATCH * RH * RDV * 32 / 512) break;
                scan_item(F, ST, BQ, it);
            }
            if (l + 1 < DEPTH) {
                unsigned char* const wnext = w_ + (((l + 1) & 1) ? WS_W1 : WS_W0);
                unsigned qn_ = 0u;
                __syncthreads();
                if (F.tid == 0) qn_ = __hip_atomic_fetch_add(F.ctl + CW_CVQ + 64 * l, 1u, RLX_AGENT);
                for (int rnd = 0;; ++rnd) {
                    if (F.tid == 0) F.MISC[16 + (rnd & 1)] = qn_;
                    __syncthreads();
                    const int tk = (int)__builtin_amdgcn_readfirstlane(F.MISC[16 + (rnd & 1)]);
                    if (tk * 8 >= NCONV) break;
                    if (F.tid == 0) qn_ = __hip_atomic_fetch_add(F.ctl + CW_CVQ + 64 * l, 1u, RLX_AGENT);
                    convert_item(F, args.in, l + 1, wnext, tk * 8 + F.wave);
                }
            }
            SEAM(pb + 4);
        }
        if (IN(pb + 5)) { PTRS();
            pg8::BatchDesc D{AQ, BQ, 512, 512, 512, 131072, 262144, 0, 131072, 512, 2, F.G, (int)blockIdx.x, 1};
            pg8::EpiO E{RET, SEQ};
            pg8::gemm_phase<pg8::EpiO, pg8::BatchDesc, PG8_ALIGN, PG8_SP2>(F.lds + RING_OFF, D, E, F.tid);
            VM_WAIT(); __syncthreads();
            groupnorm_own_chunks(F, RET, PROJ, AC);
            attn_combine_phase(F, P01, P23, PL, AC);
            SEAM(pb + 5);
        }
        if (IN(pb + 7)) { PTRS();
            pg8::PlainDesc D{AC, Wcat_t, 3072, 3072, 3072, {}}; D.O.init(M, DM, F.G, (int)blockIdx.x);
            pg8::EpiMergeCat E{PROJ + C_GA, PROJ + C_GT, LDP, MRG, DM};
            pg8::gemm_phase<pg8::EpiMergeCat, pg8::PlainDesc, PG8_ALIGN, PG8_SP2>(F.lds + RING_OFF, D, E, F.tid);
            SEAM(pb + 7);
        }
        if (IN(pb + 8)) { PTRS();
            pg8::PlainDesc D{MRG, Wout_t, DM, DM, DM, {}}; D.O.init(M, DM, F.G, (int)blockIdx.x);
            pg8::EpiRes E{l == 0 ? (const GAS void*)x_in : (const GAS void*)XR, (GAS void*)XR, DM, l == 0, false, PS};
            pg8::gemm_phase<pg8::EpiRes, pg8::PlainDesc, PG8_ALIGN, PG8_SP2>(F.lds + RING_OFF, D, E, F.tid);
            SEAM(pb + 8);
        }
        if (IN(pb + 9) && !own_panel) { PTRS(); rstd_phase(F, PS, RS); SEAM(pb + 9); }
        if (IN(pb + 10)) { PTRS(); if (own_panel) rs_prefill_lds(F, PS, team_panel);
            pg8::PlainDesc D{XR, Wfi_t, DM, DM, DM, {}}; D.O.init(M, 2 * DFF, F.G, (int)blockIdx.x);
            pg8::EpiSwiGLU E{ACT, DFF, own_panel ? (const GAS float*)nullptr : (const GAS float*)RS};
            pg8::gemm_phase<pg8::EpiSwiGLU, pg8::PlainDesc, PG8_ALIGN, PG8_SP2>(F.lds + RING_OFF, D, E, F.tid);
            SEAM(pb + 10);
        }
        if (IN(pb + 11)) { PTRS();
            pg8::PlainDesc D{ACT, Wfo_t, DFF, DFF, DFF, {}}; D.O.init(M, DM, F.G, (int)blockIdx.x);
            pg8::EpiRes E{(const GAS void*)XR, l == DEPTH - 1 ? (GAS void*)xres : (GAS void*)XR, DM, false, l == DEPTH - 1, l == DEPTH - 1 ? (GAS float*)nullptr : PS};
            pg8::gemm_phase<pg8::EpiRes, pg8::PlainDesc, PG8_ALIGN, PG8_SP2>(F.lds + RING_OFF, D, E, F.tid);
            SEAM(pb + 11);
        }
    }
#undef IN
#undef PTRS
#undef WSP
#undef SEAM
}

extern "C" void kernel_launch(void* const* d_in, const int* in_sizes, int n_in, void* d_out, int out_size, void* d_ws, size_t ws_size, hipStream_t stream) {
    static int grid = 0;
    if (grid == 0) {
        if (n_in != 11 || in_sizes[0] != M * DM || out_size != M * DM || ws_size < WS_END) { fprintf(stderr, "kernel_launch: shape/workspace mismatch: n_in %d in0 %d out %d ws %zu (need %zu)\n", n_in, n_in > 0 ? in_sizes[0] : -1, out_size, ws_size, (size_t)WS_END); grid = -1; return; }
        int dev = 0, cus = 0, per_cu = 0;
        if (hipGetDevice(&dev) != hipSuccess || hipDeviceGetAttribute(&cus, hipDeviceAttributeMultiprocessorCount, dev) != hipSuccess) { grid = -1; return; }
        if (hipFuncSetAttribute((const void*)hybrid_fwd, hipFuncAttributeMaxDynamicSharedMemorySize, LDS_BYTES) != hipSuccess) { fprintf(stderr, "kernel_launch: hipFuncSetAttribute failed\n"); grid = -1; return; }
        if (hipOccupancyMaxActiveBlocksPerMultiprocessor(&per_cu, (const void*)hybrid_fwd, NWAVES * 64, LDS_BYTES) != hipSuccess || per_cu < 1)
            fprintf(stderr, "kernel_launch: note: occupancy query reports %d workgroups per CU\n", per_cu);
        (void)hipGetLastError();
        grid = cus;
    }
    if (grid < 0) return;
    if (hipMemsetAsync((char*)d_ws + WS_CTL, 0, CTL_ZERO_BYTES, stream) != hipSuccess) return;
    Args a{};
    for (int i = 0; i < 11; ++i) a.in[i] = (const float*)d_in[i];
    a.out = (float*)d_out; a.ws = (unsigned char*)d_ws;
#if MK_ONE_LAUNCH
    a.ph_lo = 0; a.ph_hi = NPHASES;
    hipLaunchKernelGGL(hybrid_fwd, dim3(grid), dim3(NWAVES * 64), LDS_BYTES, stream, a);
#else
    for (int p = 0; p < NPHASES; ++p) { a.ph_lo = p; a.ph_hi = p + 1; hipLaunchKernelGGL(hybrid_fwd, dim3(grid), dim3(NWAVES * 64), LDS_BYTES, stream, a); }
#endif
    const hipError_t le = hipPeekAtLastError();
    if (le != hipSuccess) fprintf(stderr, "kernel_launch: launch failed: %s\n", hipGetErrorName(le));
}
```

```cpp
#include <hip/hip_runtime.h>
#include <cstdio>
#include <cstdint>
#include <type_traits>
namespace pg8 {
#define PG8_LAS __attribute__((address_space(3)))
#define PG8_GAS __attribute__((address_space(1)))
typedef unsigned short bf16_t;
typedef short bf16x8 __attribute__((ext_vector_type(8)));
typedef float f32x4 __attribute__((ext_vector_type(4)));
typedef unsigned u32x4 __attribute__((ext_vector_type(4)));
constexpr int BM = 256, BK = 64, HALF = 128, HTB = HALF * BK * 2  , STAGE_BYTES = 8 * HTB, NXCD = 8, WGM = 8;

__host__ __device__ __forceinline__ int lds_byte(int r, int c) { const int st = (r >> 4) * 2 + (c >> 5), rr = r & 15, cc = c & 31, ob = rr * 64 + cc * 2; return st * 1024 + (ob ^ (((ob >> 9) & 1) << 5)); }
__host__ __device__ __forceinline__ void stage_rc(int b, int& R, int& C) { const int st = b / 1024, sb = b % 1024, swz = sb ^ (((sb >> 9) & 1) << 5); R = (st >> 1) * 16 + swz / 64; C = (st & 1) * 32 + (swz % 64) / 2; }
__host__ __device__ __forceinline__ int perm32(int rho) { const int n = rho >> 4, i = rho & 15; return 8 * (i >> 2) + 4 * n + (i & 3); }

struct Unit { int pm, pn; };
struct StaticOrder {
    int nM, nN, nwg, G, c; bool sw;
    __host__ __device__ void init(int M, int N, int G_, int c_, bool sw_ = false) { nM = M / BM; nN = N / BM; nwg = nM * nN; G = G_; c = c_; sw = sw_ && (nwg % NXCD == 0) && (nN % NXCD == 0); }
    __host__ __device__ bool next(int i, Unit& u) const {
        const long L = (long)i * G + c; if (L >= nwg) return false;
        int wgid = (int)L; { const int q = nwg / NXCD, r = nwg % NXCD, xcd = wgid % NXCD, off = wgid / NXCD; wgid = (xcd < r ? xcd * (q + 1) : r * (q + 1) + (xcd - r) * q) + off; }
        if (sw) { const int q = nwg / NXCD, per = nN / NXCD, xcd = wgid / q, off = wgid % q; u.pm = off / per; u.pn = xcd * per + off % per; return true; }
        const int nig = WGM * nN, gid = wgid / nig, fm = gid * WGM, gsz = (nM - fm) < WGM ? (nM - fm) : WGM;
        u.pm = fm + ((wgid % nig) % gsz); u.pn = (wgid % nig) / gsz; return true;
    }
};
struct PlainDesc {
    const PG8_GAS bf16_t* A; const PG8_GAS bf16_t* Bt; int K, lda, ldb; StaticOrder O;
    __device__ __forceinline__ bool next(int i, Unit& u) const { return O.next(i, u); }
    __device__ __forceinline__ const PG8_GAS bf16_t* a_ptr(const Unit& u) const { return A + (size_t)u.pm * BM * lda; }
    __device__ __forceinline__ const PG8_GAS bf16_t* b_ptr(const Unit& u) const { return Bt + (size_t)u.pn * BM * ldb; }
    __device__ __forceinline__ void a_ready(const Unit&) const {}
    __device__ __forceinline__ void done(const Unit&) const {}
};
struct BatchDesc {
    const PG8_GAS bf16_t* A; const PG8_GAS bf16_t* Bt; int K, lda, ldb; size_t sA, sB, tA, tB; int nunits, ntile, G, c, own_batches;
    __device__ __forceinline__ bool next(int i, Unit& u) const {
        if (own_batches) { u.pm = c + (i / ntile) * G; u.pn = i % ntile; return u.pm * ntile < nunits; }
        const int L = i * G + c; if (L >= nunits) return false; u.pm = L / ntile; u.pn = L % ntile; return true; }
    __device__ __forceinline__ const PG8_GAS bf16_t* a_ptr(const Unit& u) const { return A + (size_t)u.pm * sA + (size_t)u.pn * tA; }
    __device__ __forceinline__ const PG8_GAS bf16_t* b_ptr(const Unit& u) const { return Bt + (size_t)u.pm * sB + (size_t)u.pn * tB; }
    __device__ __forceinline__ void a_ready(const Unit&) const {}
    __device__ __forceinline__ void done(const Unit&) const {}
};

constexpr int SWP_MARK = 4096;
struct ProjDesc {
    const PG8_GAS bf16_t* H; const PG8_GAS bf16_t* Wnat; const PG8_GAS bf16_t* Wswp; int K, lda, ldb; StaticOrder On, Os; int nnat;
    __device__ __forceinline__ bool next(int i, Unit& u) const {
        if (i < nnat) return On.next(i, u);
        if (!Os.next(i - nnat, u)) return false;
        u.pn += SWP_MARK; return true; }
    __device__ __forceinline__ const PG8_GAS bf16_t* a_ptr(const Unit& u) const { return u.pn >= SWP_MARK ? Wswp + (size_t)u.pm * BM * lda : H + (size_t)u.pm * BM * lda; }
    __device__ __forceinline__ const PG8_GAS bf16_t* b_ptr(const Unit& u) const { return u.pn >= SWP_MARK ? H + (size_t)(u.pn - SWP_MARK) * BM * ldb : Wnat + (size_t)u.pn * BM * ldb; }
    __device__ __forceinline__ void a_ready(const Unit&) const {}
    __device__ __forceinline__ void done(const Unit&) const {}
};

struct RetDesc {
    const PG8_GAS bf16_t* AQq; const PG8_GAS bf16_t* KB; const PG8_GAS bf16_t* BQ; const PG8_GAS bf16_t* KTB; int K, lda, ldb, G, c, ns, own;
    __device__ __forceinline__ bool next(int i, Unit& u) const {
        if (own) { if (i >= 3) return false; u.pm = c; u.pn = i == 0 ? SWP_MARK : i - 1; return true; }
        if (i < ns) { u.pm = i * G + c; u.pn = SWP_MARK; return true; }
        const int L = (i - ns) * G + c; if (L >= 512) return false; u.pm = L >> 1; u.pn = L & 1; return true; }
    __device__ __forceinline__ const PG8_GAS bf16_t* a_ptr(const Unit& u) const { return u.pn >= SWP_MARK ? AQq + (size_t)u.pm * 131072 : BQ + (size_t)u.pm * 262144 + (size_t)u.pn * 131072; }
    __device__ __forceinline__ const PG8_GAS bf16_t* b_ptr(const Unit& u) const { return u.pn >= SWP_MARK ? KB + (size_t)u.pm * 65536 : KTB + (size_t)u.pm * 65536; }
    __device__ __forceinline__ void a_ready(const Unit&) const {}
    __device__ __forceinline__ void done(const Unit&) const {}
};

__device__ __forceinline__ unsigned cvt_pk_bf16(float lo, float hi) { unsigned r; asm volatile("v_cvt_pk_bf16_f32 %0, %1, %2" : "=v"(r) : "v"(lo), "v"(hi)); return r; }
__device__ __forceinline__ float bflo(unsigned w) { return __uint_as_float(w << 16); }
__device__ __forceinline__ float bfhi(unsigned w) { return __uint_as_float(w & 0xffff0000u); }
__device__ __forceinline__ float sigmoidf_(float x) { return __builtin_amdgcn_rcpf(1.0f + __expf(-x)); }
__device__ __forceinline__ float siluf_(float x) { return x * sigmoidf_(x); }
typedef unsigned u32x2 __attribute__((ext_vector_type(2)));

struct EpiProj {
    static constexpr bool PERM = true, AFTER_DRAIN = false; static constexpr int MID_T = 0;
    PG8_GAS bf16_t* O; int ldc;
    __device__ __forceinline__ void operator()(const f32x4 (&acc)[2][2][4][2], const Unit& u, int wr, int wc, int fr, int fq) const {
        const int row0 = u.pm * BM + wr * 64 + fr, col0 = u.pn * BM + wc * 32 + 8 * fq;
#pragma unroll
        for (int ai = 0; ai < 2; ++ai)
#pragma unroll
            for (int m = 0; m < 4; ++m) { PG8_GAS bf16_t* rowp = O + (size_t)(row0 + ai * HALF + m * 16) * ldc + col0;
#pragma unroll
                for (int bj = 0; bj < 2; ++bj) { const f32x4 v0 = acc[ai][bj][m][0], v1 = acc[ai][bj][m][1];
                    u32x4 w; w.x = cvt_pk_bf16(v0[0], v0[1]); w.y = cvt_pk_bf16(v0[2], v0[3]); w.z = cvt_pk_bf16(v1[0], v1[1]); w.w = cvt_pk_bf16(v1[2], v1[3]);
                    *(PG8_GAS u32x4*)(rowp + bj * HALF) = w; } }
    }
};
struct EpiSigMulF32 {
    static constexpr bool PERM = false, AFTER_DRAIN = false; static constexpr int MID_T = 0;
    const PG8_GAS bf16_t* gate; int ldg; PG8_GAS float* T; int ldc;
    __device__ __forceinline__ void operator()(const f32x4 (&acc)[2][2][4][2], const Unit& u, int wr, int wc, int fr, int fq) const {
        const int row0 = u.pm * BM + wr * 64 + fr, col0 = u.pn * BM + wc * 32 + 4 * fq;
#pragma unroll
        for (int ai = 0; ai < 2; ++ai)
#pragma unroll
            for (int m = 0; m < 4; ++m) { const size_t r = (size_t)(row0 + ai * HALF + m * 16);
#pragma unroll
                for (int bj = 0; bj < 2; ++bj)
#pragma unroll
                    for (int n = 0; n < 2; ++n) { const int c = col0 + bj * HALF + n * 16;
                        const u32x2 gw = *(const PG8_GAS u32x2*)(gate + r * ldg + c);
                        f32x4 s; s[0] = sigmoidf_(bflo(gw.x)); s[1] = sigmoidf_(bfhi(gw.x)); s[2] = sigmoidf_(bflo(gw.y)); s[3] = sigmoidf_(bfhi(gw.y));
                        *(PG8_GAS f32x4*)(T + r * ldc + c) = acc[ai][bj][m][n] * s; } }
    }
};
struct EpiMerge {
    static constexpr bool PERM = true, AFTER_DRAIN = false; static constexpr int MID_T = 0;
    const PG8_GAS float* T; int ldt; const PG8_GAS bf16_t* gate; int ldg; PG8_GAS bf16_t* O; int ldc;
    __device__ __forceinline__ void operator()(const f32x4 (&acc)[2][2][4][2], const Unit& u, int wr, int wc, int fr, int fq) const {
        const int row0 = u.pm * BM + wr * 64 + fr, col0 = u.pn * BM + wc * 32 + 8 * fq;
#pragma unroll
        for (int ai = 0; ai < 2; ++ai)
#pragma unroll
            for (int m = 0; m < 4; ++m) { const size_t r = (size_t)(row0 + ai * HALF + m * 16);
#pragma unroll
                for (int bj = 0; bj < 2; ++bj) { const int c = col0 + bj * HALF;
                    const u32x4 gw = *(const PG8_GAS u32x4*)(gate + r * ldg + c);
                    const f32x4 t0 = *(const PG8_GAS f32x4*)(T + r * ldt + c), t1 = *(const PG8_GAS f32x4*)(T + r * ldt + c + 4);
                    f32x4 s0, s1; s0[0] = sigmoidf_(bflo(gw.x)); s0[1] = sigmoidf_(bfhi(gw.x)); s0[2] = sigmoidf_(bflo(gw.y)); s0[3] = sigmoidf_(bfhi(gw.y));
                    s1[0] = sigmoidf_(bflo(gw.z)); s1[1] = sigmoidf_(bfhi(gw.z)); s1[2] = sigmoidf_(bflo(gw.w)); s1[3] = sigmoidf_(bfhi(gw.w));
                    const f32x4 v0 = t0 + s0 * acc[ai][bj][m][0], v1 = t1 + s1 * acc[ai][bj][m][1];
                    u32x4 w; w.x = cvt_pk_bf16(v0[0], v0[1]); w.y = cvt_pk_bf16(v0[2], v0[3]); w.z = cvt_pk_bf16(v1[0], v1[1]); w.w = cvt_pk_bf16(v1[2], v1[3]);
                    *(PG8_GAS u32x4*)(O + r * ldc + c) = w; } }
    }
};
struct EpiRes {
    static constexpr bool PERM = true, AFTER_DRAIN = false; static constexpr int MID_T = 0;
    const PG8_GAS void* base; PG8_GAS void* out; int ldc; bool base_f32, out_f32; PG8_GAS float* ps;
    __device__ __forceinline__ static float ssq8(const u32x4 w) { return ((bflo(w.x) * bflo(w.x) + bfhi(w.x) * bfhi(w.x)) + (bflo(w.y) * bflo(w.y) + bfhi(w.y) * bfhi(w.y))) + ((bflo(w.z) * bflo(w.z) + bfhi(w.z) * bfhi(w.z)) + (bflo(w.w) * bflo(w.w) + bfhi(w.w) * bfhi(w.w))); }
    __device__ __forceinline__ void put_ps(float q, int row, int slot, int fq) const {
        ps[(size_t)row * 128 + slot * 4 + fq] = q;
    }
    __device__ __forceinline__ void operator()(const f32x4 (&acc)[2][2][4][2], const Unit& u, int wr, int wc, int fr, int fq) const {
        const int row0 = u.pm * BM + wr * 64 + fr, col0 = u.pn * BM + wc * 32 + 8 * fq, slot = u.pn * 4 + wc;
        if (base_f32) {
#pragma unroll
            for (int ai = 0; ai < 2; ++ai) {
                f32x4 v[4][2][2];
#pragma unroll
                for (int m = 0; m < 4; ++m) { const size_t off = (size_t)(row0 + ai * HALF + m * 16) * ldc + col0;
#pragma unroll
                    for (int bj = 0; bj < 2; ++bj) { v[m][bj][0] = *(const PG8_GAS f32x4*)((const PG8_GAS float*)base + off + bj * HALF); v[m][bj][1] = *(const PG8_GAS f32x4*)((const PG8_GAS float*)base + off + bj * HALF + 4); } }
#pragma unroll
                for (int m = 0; m < 4; ++m) { const size_t off = (size_t)(row0 + ai * HALF + m * 16) * ldc + col0; float q = 0.f;
#pragma unroll
                    for (int bj = 0; bj < 2; ++bj) { const f32x4 v0 = v[m][bj][0] + acc[ai][bj][m][0], v1 = v[m][bj][1] + acc[ai][bj][m][1];
                        if (out_f32) { *(PG8_GAS f32x4*)((PG8_GAS float*)out + off + bj * HALF) = v0; *(PG8_GAS f32x4*)((PG8_GAS float*)out + off + bj * HALF + 4) = v1; }
                        else { u32x4 w; w.x = cvt_pk_bf16(v0[0], v0[1]); w.y = cvt_pk_bf16(v0[2], v0[3]); w.z = cvt_pk_bf16(v1[0], v1[1]); w.w = cvt_pk_bf16(v1[2], v1[3]); q += ssq8(w);
                            *(PG8_GAS u32x4*)((PG8_GAS bf16_t*)out + off + bj * HALF) = w; } }
                    if (ps) put_ps(q, row0 + ai * HALF + m * 16, slot, fq); }
            }
        } else {
            u32x4 w[8][2];
#define ER_LOAD(s_) do { const size_t off_ = (size_t)(row0 + ((s_) >> 2) * HALF + ((s_) & 3) * 16) * ldc + col0; \
    w[s_][0] = *(const PG8_GAS u32x4*)((const PG8_GAS bf16_t*)base + off_); w[s_][1] = *(const PG8_GAS u32x4*)((const PG8_GAS bf16_t*)base + off_ + HALF); } while (0)
#pragma unroll
            for (int s_ = 0; s_ < 4; ++s_) ER_LOAD(s_);
#pragma unroll
            for (int s_ = 0; s_ < 8; ++s_) { const int ai = s_ >> 2, m = s_ & 3; const size_t off = (size_t)(row0 + ai * HALF + m * 16) * ldc + col0; float q = 0.f;
#pragma unroll
                for (int bj = 0; bj < 2; ++bj) { const u32x4 b = w[s_][bj];
                    const f32x4 v0 = (f32x4){bflo(b.x), bfhi(b.x), bflo(b.y), bfhi(b.y)} + acc[ai][bj][m][0], v1 = (f32x4){bflo(b.z), bfhi(b.z), bflo(b.w), bfhi(b.w)} + acc[ai][bj][m][1];
                    if (out_f32) { *(PG8_GAS f32x4*)((PG8_GAS float*)out + off + bj * HALF) = v0; *(PG8_GAS f32x4*)((PG8_GAS float*)out + off + bj * HALF + 4) = v1; }
                    else { u32x4 o; o.x = cvt_pk_bf16(v0[0], v0[1]); o.y = cvt_pk_bf16(v0[2], v0[3]); o.z = cvt_pk_bf16(v1[0], v1[1]); o.w = cvt_pk_bf16(v1[2], v1[3]); q += ssq8(o);
                        *(PG8_GAS u32x4*)((PG8_GAS bf16_t*)out + off + bj * HALF) = o; } }
                if (s_ + 4 < 8) ER_LOAD(s_ + 4);
                if (ps) put_ps(q, row0 + ai * HALF + m * 16, slot, fq); }
#undef ER_LOAD
        }
    }
};
struct EpiSwiGLU {
    static constexpr bool PERM = true, AFTER_DRAIN = false; static constexpr int MID_T = 0;
    PG8_GAS bf16_t* O; int ldc; const PG8_GAS float* rs;
    static constexpr bool RS_LDS = true;
    __device__ __forceinline__ const PG8_GAS float* rs_base(const Unit& u) const { return rs ? rs + (size_t)u.pm * BM : (const PG8_GAS float*)nullptr; }
    __device__ __forceinline__ void operator()(const f32x4 (&acc)[2][2][4][2], const Unit& u, int wr, int wc, int fr, int fq, const PG8_LAS float* rsl) const {
        const int row0 = u.pm * BM + wr * 64 + fr, col0 = u.pn * HALF + wc * 32 + 8 * fq;
        float rsv[2][4];
#pragma unroll
        for (int ai = 0; ai < 2; ++ai)
#pragma unroll
            for (int m = 0; m < 4; ++m) rsv[ai][m] = rsl[wr * 64 + fr + ai * HALF + m * 16];
#pragma unroll
        for (int ai = 0; ai < 2; ++ai)
#pragma unroll
            for (int m = 0; m < 4; ++m) { PG8_GAS bf16_t* rowp = O + (size_t)(row0 + ai * HALF + m * 16) * ldc + col0; const float r_ = rsv[ai][m];
                const f32x4 g0 = acc[ai][0][m][0] * r_, g1 = acc[ai][0][m][1] * r_, u0 = acc[ai][1][m][0] * r_, u1 = acc[ai][1][m][1] * r_;
                f32x4 v0, v1;
#pragma unroll
                for (int j = 0; j < 4; ++j) { v0[j] = siluf_(g0[j]) * u0[j]; v1[j] = siluf_(g1[j]) * u1[j]; }
                u32x4 w; w.x = cvt_pk_bf16(v0[0], v0[1]); w.y = cvt_pk_bf16(v0[2], v0[3]); w.z = cvt_pk_bf16(v1[0], v1[1]); w.w = cvt_pk_bf16(v1[2], v1[3]);
                *(PG8_GAS u32x4*)rowp = w; }
    }
};

struct EpiProjNat {
    static constexpr bool PERM = true, AFTER_DRAIN = false; static constexpr int MID_T = 0;
    PG8_GAS bf16_t* PROJ; int ldp; PG8_GAS bf16_t* AQ; PG8_GAS bf16_t* KB; const PG8_GAS float* rs;
    PG8_GAS bf16_t* QKN; const PG8_GAS float* qg; const PG8_GAS float* kg; PG8_GAS float* kmean; PG8_LAS float* xl; float eps;
    __device__ __forceinline__ static float dpp_row_sum(float x) {
        x += __builtin_bit_cast(float, __builtin_amdgcn_update_dpp(0, __builtin_bit_cast(int, x), 0xB1, 0xf, 0xf, true));
        x += __builtin_bit_cast(float, __builtin_amdgcn_update_dpp(0, __builtin_bit_cast(int, x), 0x4E, 0xf, 0xf, true));
        x += __builtin_bit_cast(float, __builtin_amdgcn_update_dpp(0, __builtin_bit_cast(int, x), 0x141, 0xf, 0xf, true));
        x += __builtin_bit_cast(float, __builtin_amdgcn_update_dpp(0, __builtin_bit_cast(int, x), 0x140, 0xf, 0xf, true));
        return x; }
    __device__ __forceinline__ void qk(const f32x4 (&acc)[2][2][4][2], const Unit& u, int wr, int wc, int fr, int fq, const PG8_LAS float* rsl) const {
        const int isk = u.pn >= 4 ? 1 : 0, h0 = 2 * (u.pn & 3);
        PG8_LAS float* SS = xl;
        PG8_LAS float* KM = xl + 4096;
        const PG8_GAS float* gp = (isk ? kg : qg) + wc * 32 + fq * 8;
        const f32x4 ga = *(const PG8_GAS f32x4*)gp, gb = *(const PG8_GAS f32x4*)(gp + 4);
        float rsv[2][4];
#pragma unroll
        for (int ai = 0; ai < 2; ++ai)
#pragma unroll
            for (int m = 0; m < 4; ++m) rsv[ai][m] = rsl[wr * 64 + fr + ai * HALF + m * 16];
#pragma unroll
        for (int ai = 0; ai < 2; ++ai)
#pragma unroll
            for (int m = 0; m < 4; ++m) { const int rowl = wr * 64 + fr + ai * HALF + m * 16; const float r_ = rsv[ai][m];
#pragma unroll
                for (int bj = 0; bj < 2; ++bj) { const f32x4 a = acc[ai][bj][m][0] * r_, b = acc[ai][bj][m][1] * r_;
                    float q = ((a[0] * a[0] + a[1] * a[1]) + (a[2] * a[2] + a[3] * a[3])) + ((b[0] * b[0] + b[1] * b[1]) + (b[2] * b[2] + b[3] * b[3]));
                    unsigned qa_ = __builtin_bit_cast(unsigned, q), qb_ = qa_; asm volatile("" : "+v"(qb_));
                    const auto rr = __builtin_amdgcn_permlane32_swap(qa_, qb_, false, false);
                    { const unsigned r0_ = rr[0], r1_ = rr[1]; q = __builtin_bit_cast(float, r0_) + __builtin_bit_cast(float, r1_); }
                    asm volatile("" : "+v"(q));
                    SS[((rowl * 2 + bj) * 4 + wc) * 2 + (fq & 1)] = q; } }
        __syncthreads();
#pragma unroll
        for (int bj = 0; bj < 2; ++bj) {
            float rn[2][4], cs[8];
#pragma unroll
            for (int k = 0; k < 8; ++k) cs[k] = 0.f;
#pragma unroll
            for (int ai = 0; ai < 2; ++ai)
#pragma unroll
                for (int m = 0; m < 4; ++m) { const int rowl = wr * 64 + fr + ai * HALF + m * 16;
                    const f32x4 s0 = *(const PG8_LAS f32x4*)(SS + (rowl * 2 + bj) * 8), s1 = *(const PG8_LAS f32x4*)(SS + (rowl * 2 + bj) * 8 + 4);
                    const float tot = ((s0[0] + s0[1]) + (s0[2] + s0[3])) + ((s1[0] + s1[1]) + (s1[2] + s1[3]));
                    rn[ai][m] = rsv[ai][m] * (1.0f / __builtin_sqrtf(tot * (1.f / 128.f) + eps)); }
#pragma unroll
            for (int ai = 0; ai < 2; ++ai)
#pragma unroll
                for (int m = 0; m < 4; ++m) { const size_t row = (size_t)u.pm * BM + wr * 64 + fr + ai * HALF + m * 16;
                    const float s_ = rn[ai][m]; const f32x4 v0 = acc[ai][bj][m][0] * s_ * ga, v1 = acc[ai][bj][m][1] * s_ * gb;
                    u32x4 w; w.x = cvt_pk_bf16(v0[0], v0[1]); w.y = cvt_pk_bf16(v0[2], v0[3]); w.z = cvt_pk_bf16(v1[0], v1[1]); w.w = cvt_pk_bf16(v1[2], v1[3]);
                    *(PG8_GAS u32x4*)(QKN + row * 2048 + (isk ? 1024 : 0) + (h0 + bj) * 128 + wc * 32 + fq * 8) = w;
                    cs[0] += bflo(w.x); cs[1] += bfhi(w.x); cs[2] += bflo(w.y); cs[3] += bfhi(w.y); cs[4] += bflo(w.z); cs[5] += bfhi(w.z); cs[6] += bflo(w.w); cs[7] += bfhi(w.w); }
            if (isk) {
#pragma unroll
                for (int k = 0; k < 8; ++k) { float t_ = dpp_row_sum(cs[k]); asm volatile("" : "+v"(t_)); if (fr == 0) KM[wr * 256 + bj * 128 + wc * 32 + fq * 8 + k] = t_; } }
        }
        if (isk) {
            __syncthreads();
            const int tid_ = ((wr * 4 + wc) * 4 + fq) * 16 + fr;
            if (tid_ < 256) { const int b_ = u.pm >> 5, n_ = u.pm & 31;
                kmean[(size_t)((b_ * 8 + h0 + (tid_ >> 7)) * 32 + n_) * 128 + (tid_ & 127)] = (KM[tid_] + KM[256 + tid_]) * (1.f / 256.f); }
        }
    }
    __device__ __forceinline__ void operator()(const f32x4 (&acc)[2][2][4][2], const Unit& u, int wr, int wc, int fr, int fq, const PG8_LAS float* rsl) const {
        if (u.pn < 8) { qk(acc, u, wr, wc, fr, fq, rsl); return; }
        PG8_GAS bf16_t* base; int ldc;
        float rsv[2][4];
#pragma unroll
        for (int ai = 0; ai < 2; ++ai)
#pragma unroll
            for (int m = 0; m < 4; ++m) rsv[ai][m] = rsl[wr * 64 + fr + ai * HALF + m * 16];
        if (u.pn < 36) { base = PROJ + (size_t)u.pm * BM * ldp + u.pn * BM; ldc = ldp; }
        else { const int isk = u.pn >= 40, h = (u.pn - 36) & 3, c = ((u.pm >> 5) * 4 + h) * 32 + (u.pm & 31);
            if (isk) { base = KB + (size_t)c * 65536; ldc = 256; } else { base = AQ + (size_t)c * 131072 + 256; ldc = 512; } }
        const int row0 = wr * 64 + fr, col0 = wc * 32 + 8 * fq;
#pragma unroll
        for (int ai = 0; ai < 2; ++ai)
#pragma unroll
            for (int m = 0; m < 4; ++m) { PG8_GAS bf16_t* rowp = base + (size_t)(row0 + ai * HALF + m * 16) * ldc + col0; const float r_ = rsv[ai][m];
#pragma unroll
                for (int bj = 0; bj < 2; ++bj) { const f32x4 v0 = acc[ai][bj][m][0] * r_, v1 = acc[ai][bj][m][1] * r_;
                    u32x4 w; w.x = cvt_pk_bf16(v0[0], v0[1]); w.y = cvt_pk_bf16(v0[2], v0[3]); w.z = cvt_pk_bf16(v1[0], v1[1]); w.w = cvt_pk_bf16(v1[2], v1[3]);
                    *(PG8_GAS u32x4*)(rowp + bj * HALF) = w; } }
    }
};
struct EpiSwap {
    static constexpr bool PERM = true, AFTER_DRAIN = false; static constexpr int MID_T = 0;
    PG8_GAS bf16_t* KTB; PG8_GAS bf16_t* BQ; const PG8_GAS float* rs;
    __device__ __forceinline__ void operator()(const f32x4 (&acc)[2][2][4][2], const Unit& u, int wr, int wc, int fr, int fq, const PG8_LAS float* rsl) const {
        const int b = u.pn >> 5, n = u.pn & 31; PG8_GAS bf16_t* base; int ldc; float lg = 0.f, mul = 1.f;
        { const int h = u.pm >> 1, half = u.pm & 1, c = (b * 4 + h) * 32 + n; base = BQ + (size_t)c * 262144 + (size_t)half * 131072; ldc = 512;
            lg = -__log2f(1.0f - exp2f(-5.0f - (float)h)); mul = 0.0625f; }
        asm volatile("" : "+v"(fr), "+v"(fq));
        const int row0 = wr * 64 + fr, col0 = wc * 32 + 8 * fq;
        f32x4 sc[2][2];
#pragma unroll
        for (int bj = 0; bj < 2; ++bj)
#pragma unroll
            for (int n2 = 0; n2 < 2; ++n2)
#pragma unroll
                for (int k = 0; k < 4; ++k) sc[bj][n2][k] = mul * exp2f(lg * (float)(col0 + bj * HALF + 4 * n2 + k + 1)) * rsl[col0 + bj * HALF + 4 * n2 + k];
#pragma unroll
        for (int ai = 0; ai < 2; ++ai)
#pragma unroll
            for (int m = 0; m < 4; ++m) { PG8_GAS bf16_t* rowp = base + (size_t)(row0 + ai * HALF + m * 16) * ldc + col0;
#pragma unroll
                for (int bj = 0; bj < 2; ++bj) { const f32x4 v0 = acc[ai][bj][m][0] * sc[bj][0], v1 = acc[ai][bj][m][1] * sc[bj][1];
                    u32x4 w; w.x = cvt_pk_bf16(v0[0], v0[1]); w.y = cvt_pk_bf16(v0[2], v0[3]); w.z = cvt_pk_bf16(v1[0], v1[1]); w.w = cvt_pk_bf16(v1[2], v1[3]);
                    *(PG8_GAS u32x4*)(rowp + bj * HALF) = w; } }
    }
};
struct EpiProjBoth {
    static constexpr bool PERM = true, AFTER_DRAIN = false; static constexpr int MID_T = 0;
    EpiProjNat N; EpiSwap S;
    static constexpr bool RS_LDS = true;
    __device__ __forceinline__ const PG8_GAS float* rs_base(const Unit& u) const { return N.rs ? N.rs + (size_t)(u.pn >= SWP_MARK ? u.pn - SWP_MARK : u.pm) * BM : (const PG8_GAS float*)nullptr; }
    __device__ __forceinline__ void operator()(const f32x4 (&acc)[2][2][4][2], const Unit& u, int wr, int wc, int fr, int fq, const PG8_LAS float* rsl) const {
        if (u.pn >= SWP_MARK) { Unit v = u; v.pn -= SWP_MARK; S(acc, v, wr, wc, fr, fq, rsl); } else N(acc, u, wr, wc, fr, fq, rsl);
    }
};
struct EpiS {
    static constexpr bool PERM = true, AFTER_DRAIN = false; static constexpr int MID_T = 0;
    PG8_GAS bf16_t* AQ;
    __device__ __forceinline__ void operator()(const f32x4 (&acc)[2][2][4][2], const Unit& u, int wr, int wc, int fr, int fq) const {
        PG8_GAS bf16_t* base = AQ + (size_t)u.pm * 131072;
        asm volatile("" : "+v"(fr), "+v"(fq));
        const int row0 = wr * 64 + fr, col0 = wc * 32 + 8 * fq;
#pragma unroll
        for (int ai = 0; ai < 2; ++ai)
#pragma unroll
            for (int m = 0; m < 4; ++m) { const int i = row0 + ai * HALF + m * 16; PG8_GAS bf16_t* rowp = base + (size_t)i * 512 + col0;
#pragma unroll
                for (int bj = 0; bj < 2; ++bj) { f32x4 v0 = acc[ai][bj][m][0], v1 = acc[ai][bj][m][1]; const int j0 = col0 + bj * HALF;
#pragma unroll
                    for (int k = 0; k < 4; ++k) { if (j0 + k > i) v0[k] = 0.f; if (j0 + 4 + k > i) v1[k] = 0.f; }
                    u32x4 w; w.x = cvt_pk_bf16(v0[0], v0[1]); w.y = cvt_pk_bf16(v0[2], v0[3]); w.z = cvt_pk_bf16(v1[0], v1[1]); w.w = cvt_pk_bf16(v1[2], v1[3]);
                    *(PG8_GAS u32x4*)(rowp + bj * HALF) = w; } }
    }
};
struct EpiKV {
    static constexpr bool PERM = true, AFTER_DRAIN = false; static constexpr int MID_T = 0;
    PG8_GAS bf16_t* ST;
    __device__ __forceinline__ void operator()(const f32x4 (&acc)[2][2][4][2], const Unit& u, int wr, int wc, int fr, int fq) const {
        const int h = (u.pm >> 5) & 3; const float gC = exp2f(256.0f * __log2f(1.0f - exp2f(-5.0f - (float)h)));
        PG8_GAS bf16_t* base = ST + (size_t)u.pm * 131072 + (size_t)u.pn * 65536;
        const int row0 = wr * 64 + fr, col0 = wc * 32 + 8 * fq;
#pragma unroll
        for (int ai = 0; ai < 2; ++ai)
#pragma unroll
            for (int m = 0; m < 4; ++m) { PG8_GAS bf16_t* rowp = base + (size_t)(row0 + ai * HALF + m * 16) * 256 + col0;
#pragma unroll
                for (int bj = 0; bj < 2; ++bj) { const f32x4 v0 = acc[ai][bj][m][0] * gC, v1 = acc[ai][bj][m][1] * gC;
                    u32x4 w; w.x = cvt_pk_bf16(v0[0], v0[1]); w.y = cvt_pk_bf16(v0[2], v0[3]); w.z = cvt_pk_bf16(v1[0], v1[1]); w.w = cvt_pk_bf16(v1[2], v1[3]);
                    *(PG8_GAS u32x4*)(rowp + bj * HALF) = w; } }
    }
};
struct EpiRetBoth {
    static constexpr bool PERM = true, AFTER_DRAIN = false; static constexpr int MID_T = 0;
    EpiS S; EpiKV KV;
    __device__ __forceinline__ void operator()(const f32x4 (&acc)[2][2][4][2], const Unit& u, int wr, int wc, int fr, int fq) const {
        if (u.pn >= SWP_MARK) S(acc, u, wr, wc, fr, fq); else KV(acc, u, wr, wc, fr, fq);
    }
};
struct EpiO {
    static constexpr bool PERM = true, AFTER_DRAIN = false; static constexpr int MID_T = 0;
    PG8_GAS bf16_t* RET; int seq;
    __device__ __forceinline__ void operator()(const f32x4 (&acc)[2][2][4][2], const Unit& u, int wr, int wc, int fr, int fq) const {
        const int c = u.pm, b = c >> 7, h = (c >> 5) & 3, n = c & 31; const float lg = __log2f(1.0f - exp2f(-5.0f - (float)h));
        PG8_GAS bf16_t* base = RET + ((size_t)b * seq + n * 256) * 2048 + h * 512 + u.pn * 256;
        asm volatile("" : "+v"(fr), "+v"(fq));
        const int row0 = wr * 64 + fr, col0 = wc * 32 + 8 * fq;
#pragma unroll
        for (int ai = 0; ai < 2; ++ai)
#pragma unroll
            for (int m = 0; m < 4; ++m) { const int i = row0 + ai * HALF + m * 16; const float rs = exp2f(lg * (float)(i + 1)); PG8_GAS bf16_t* rowp = base + (size_t)i * 2048 + col0;
#pragma unroll
                for (int bj = 0; bj < 2; ++bj) { const f32x4 v0 = acc[ai][bj][m][0] * rs, v1 = acc[ai][bj][m][1] * rs;
                    u32x4 w; w.x = cvt_pk_bf16(v0[0], v0[1]); w.y = cvt_pk_bf16(v0[2], v0[3]); w.z = cvt_pk_bf16(v1[0], v1[1]); w.w = cvt_pk_bf16(v1[2], v1[3]);
                    *(PG8_GAS u32x4*)(rowp + bj * HALF) = w; } }
    }
};
struct EpiMergeCat {
    static constexpr bool PERM = true, AFTER_DRAIN = false; static constexpr int MID_T = 16;
    const PG8_GAS bf16_t* ga; const PG8_GAS bf16_t* gr; int ldg; PG8_GAS bf16_t* O; int ldc;
    __device__ __forceinline__ static float en(float g) { return __expf(fminf(-g, 80.0f)); }
    __device__ __forceinline__ void mid(f32x4 (&acc)[2][2][4][2], const Unit& u, int wr, int wc, int fr, int fq) const {
        asm volatile("" : "+v"(fr), "+v"(fq));
        const int row0 = u.pm * BM + wr * 64 + fr, col0 = u.pn * BM + wc * 32 + 8 * fq;
        u32x4 wa[8][2], wg[8][2];
#define MC_LOAD(s_) do { const size_t r_ = (size_t)(row0 + ((s_) >> 2) * HALF + ((s_) & 3) * 16); \
    wa[s_][0] = *(const PG8_GAS u32x4*)(ga + r_ * ldg + col0); wa[s_][1] = *(const PG8_GAS u32x4*)(ga + r_ * ldg + col0 + HALF); \
    wg[s_][0] = *(const PG8_GAS u32x4*)(gr + r_ * ldg + col0); wg[s_][1] = *(const PG8_GAS u32x4*)(gr + r_ * ldg + col0 + HALF); } while (0)
        MC_LOAD(0); MC_LOAD(1); MC_LOAD(2);
#pragma unroll
        for (int s_ = 0; s_ < 8; ++s_) { const int ai = s_ >> 2, m = s_ & 3;
            if (s_ + 3 < 8) MC_LOAD(s_ + 3);
#pragma unroll
            for (int bj = 0; bj < 2; ++bj) { const u32x4 a = wa[s_][bj], g = wg[s_][bj];
                f32x4 q0, q1;
                q0[0] = (1.0f + en(bflo(g.x))) * __builtin_amdgcn_rcpf(1.0f + en(bflo(a.x))); q0[1] = (1.0f + en(bfhi(g.x))) * __builtin_amdgcn_rcpf(1.0f + en(bfhi(a.x)));
                q0[2] = (1.0f + en(bflo(g.y))) * __builtin_amdgcn_rcpf(1.0f + en(bflo(a.y))); q0[3] = (1.0f + en(bfhi(g.y))) * __builtin_amdgcn_rcpf(1.0f + en(bfhi(a.y)));
                q1[0] = (1.0f + en(bflo(g.z))) * __builtin_amdgcn_rcpf(1.0f + en(bflo(a.z))); q1[1] = (1.0f + en(bfhi(g.z))) * __builtin_amdgcn_rcpf(1.0f + en(bfhi(a.z)));
                q1[2] = (1.0f + en(bflo(g.w))) * __builtin_amdgcn_rcpf(1.0f + en(bflo(a.w))); q1[3] = (1.0f + en(bfhi(g.w))) * __builtin_amdgcn_rcpf(1.0f + en(bfhi(a.w)));
                acc[ai][bj][m][0] = acc[ai][bj][m][0] * q0; acc[ai][bj][m][1] = acc[ai][bj][m][1] * q1; } }
#undef MC_LOAD
    }
    __device__ __forceinline__ void operator()(const f32x4 (&acc)[2][2][4][2], const Unit& u, int wr, int wc, int fr, int fq) const {
        const int row0 = u.pm * BM + wr * 64 + fr, col0 = u.pn * BM + wc * 32 + 8 * fq;
        u32x4 wg[8][2];
#define MC_LOAD(s_) do { const size_t r_ = (size_t)(row0 + ((s_) >> 2) * HALF + ((s_) & 3) * 16); \
    wg[s_][0] = *(const PG8_GAS u32x4*)(gr + r_ * ldg + col0); wg[s_][1] = *(const PG8_GAS u32x4*)(gr + r_ * ldg + col0 + HALF); } while (0)
#pragma unroll
        for (int s_ = 0; s_ < 4; ++s_) MC_LOAD(s_);
#pragma unroll
        for (int s_ = 0; s_ < 8; ++s_) { const int ai = s_ >> 2, m = s_ & 3; const size_t r = (size_t)(row0 + ai * HALF + m * 16);
#pragma unroll
            for (int bj = 0; bj < 2; ++bj) { const int c = col0 + bj * HALF; const u32x4 g = wg[s_][bj];
                f32x4 s0, s1; s0[0] = __builtin_amdgcn_rcpf(1.0f + en(bflo(g.x))); s0[1] = __builtin_amdgcn_rcpf(1.0f + en(bfhi(g.x))); s0[2] = __builtin_amdgcn_rcpf(1.0f + en(bflo(g.y))); s0[3] = __builtin_amdgcn_rcpf(1.0f + en(bfhi(g.y)));
                s1[0] = __builtin_amdgcn_rcpf(1.0f + en(bflo(g.z))); s1[1] = __builtin_amdgcn_rcpf(1.0f + en(bfhi(g.z))); s1[2] = __builtin_amdgcn_rcpf(1.0f + en(bflo(g.w))); s1[3] = __builtin_amdgcn_rcpf(1.0f + en(bfhi(g.w)));
                const f32x4 v0 = s0 * acc[ai][bj][m][0], v1 = s1 * acc[ai][bj][m][1];
                u32x4 w; w.x = cvt_pk_bf16(v0[0], v0[1]); w.y = cvt_pk_bf16(v0[2], v0[3]); w.z = cvt_pk_bf16(v1[0], v1[1]); w.w = cvt_pk_bf16(v1[2], v1[3]);
                *(PG8_GAS u32x4*)(O + r * ldc + c) = w; }
            if (s_ + 4 < 8) MC_LOAD(s_ + 4); }
#undef MC_LOAD
    }
};
template <class T, class = void> struct has_rs_lds : std::false_type {};
template <class T> struct has_rs_lds<T, std::void_t<decltype(T::RS_LDS)>> : std::true_type {};
template <class Epi, class Desc, bool ALIGN_EPI = false, bool SP2 = false>
__device__ __forceinline__ void gemm_phase(PG8_LAS unsigned char* lds, const Desc& S, const Epi& E, const int tid) {
    const int wid = __builtin_amdgcn_readfirstlane(tid >> 6), lane = tid & 63, wr = wid >> 2, wc = wid & 3, fr = lane & 15, fq = lane >> 4;
    const int K = S.K, nt = K / BK, lda = S.lda, ldb = S.ldb;
    unsigned voffA[2], voffB[2];
#pragma unroll
    for (int i = 0; i < 2; ++i) { int R, C; stage_rc(tid * 16 + i * 8192, R, C); const int Rb = Epi::PERM ? ((R & ~31) + perm32(R & 31)) : R;
        voffA[i] = (unsigned)(R * lda + C) * 2u; voffB[i] = (unsigned)(Rb * ldb + C) * 2u; }
    const size_t kstep = (size_t)(BK * 2);
    const size_t hstepA = (size_t)HALF * lda * 2, hstepB = (size_t)HALF * ldb * 2;
    const unsigned ldsw = (unsigned)wid * 1024u;
    const int aoff = lds_byte(wr * 64 + fr, fq * 8), boff = lds_byte(wc * 32 + fr, fq * 8);
#define PG8_SA(b, h) (((b) * 2 + (h)) * HTB)
#define PG8_SB(b, h) ((4 + (b) * 2 + (h)) * HTB)
#define PG8_STAGE(bufoff, gbase, voff) do { _Pragma("unroll") for (int _i = 0; _i < 2; ++_i) \
        __builtin_amdgcn_global_load_lds((const PG8_GAS unsigned*)((const PG8_GAS char*)(gbase) + (voff)[_i]), (PG8_LAS unsigned*)(lds + (bufoff) + ldsw + _i * 8192), 16, 0, 0); } while (0)
#define PG8_LDA(dst, b, h) do { _Pragma("unroll") for (int m = 0; m < 4; ++m) _Pragma("unroll") for (int k = 0; k < 2; ++k) dst[m][k] = *(const PG8_LAS bf16x8*)(lds + PG8_SA(b, h) + aoff + m * 2048 + k * 1024); } while (0)
#define PG8_LDB(dst, b, h) do { _Pragma("unroll") for (int n = 0; n < 2; ++n) _Pragma("unroll") for (int k = 0; k < 2; ++k) dst[n][k] = *(const PG8_LAS bf16x8*)(lds + PG8_SB(b, h) + boff + n * 2048 + k * 1024); } while (0)
#define PG8_MMA(ai, bj, At, Bt) do { __builtin_amdgcn_s_setprio(1); _Pragma("unroll") for (int m = 0; m < 4; ++m) _Pragma("unroll") for (int n = 0; n < 2; ++n) _Pragma("unroll") for (int k = 0; k < 2; ++k) \
        acc[ai][bj][m][n] = __builtin_amdgcn_mfma_f32_16x16x32_bf16(Bt[n][k], At[m][k], acc[ai][bj][m][n], 0, 0, 0); __builtin_amdgcn_s_setprio(0); } while (0)
#define PG8_WAIT_V(n) asm volatile("s_waitcnt vmcnt(" #n ")" ::: "memory")
#define PG8_WAIT_L(n) asm volatile("s_waitcnt lgkmcnt(" #n ")" ::: "memory")
#define PG8_BAR __builtin_amdgcn_s_barrier()
#define PG8_SCHED __builtin_amdgcn_sched_barrier(0)
    Unit cur, nxt; int ui = 0;
    if (!S.next(0, cur)) return;
    if constexpr (has_rs_lds<Epi>::value) { const PG8_GAS float* rb_ = E.rs_base(cur); if (rb_ != nullptr && wid == 0) __builtin_amdgcn_global_load_lds((const PG8_GAS unsigned*)(rb_ + lane * 4), (PG8_LAS unsigned*)(lds + STAGE_BYTES), 16, 0, 0); }
    f32x4 acc[2][2][4][2];
#pragma unroll
    for (int a = 0; a < 2; ++a)
#pragma unroll
        for (int b = 0; b < 2; ++b)
#pragma unroll
            for (int m = 0; m < 4; ++m)
#pragma unroll
                for (int n = 0; n < 2; ++n) acc[a][b][m][n] = (f32x4){0.f, 0.f, 0.f, 0.f};
    bf16x8 At[4][2], B0[2][2], B1[2][2];
    const PG8_GAS char* cA = (const PG8_GAS char*)S.a_ptr(cur); const PG8_GAS char* cB = (const PG8_GAS char*)S.b_ptr(cur);
    S.a_ready(cur);
    if constexpr (SP2) {
        PG8_STAGE(PG8_SB(0, 0), cB, voffB); PG8_STAGE(PG8_SB(0, 1), cB + hstepB, voffB); PG8_STAGE(PG8_SA(0, 0), cA, voffA); PG8_STAGE(PG8_SA(0, 1), cA + hstepA, voffA);
        if (wr == 1) PG8_BAR;
        PG8_WAIT_V(2); PG8_BAR;
        PG8_STAGE(PG8_SB(1, 0), cB + kstep, voffB); PG8_STAGE(PG8_SA(1, 0), cA + kstep, voffA); PG8_STAGE(PG8_SB(1, 1), cB + hstepB + kstep, voffB);
        PG8_WAIT_V(6); PG8_BAR;
    } else {
        PG8_STAGE(PG8_SB(0, 0), cB, voffB); PG8_STAGE(PG8_SA(0, 0), cA, voffA); PG8_STAGE(PG8_SB(0, 1), cB + hstepB, voffB); PG8_STAGE(PG8_SA(0, 1), cA + hstepA, voffA);
        if (wr == 1) PG8_BAR;
        PG8_WAIT_V(4); PG8_BAR;
        PG8_STAGE(PG8_SB(1, 0), cB + kstep, voffB); PG8_STAGE(PG8_SA(1, 0), cA + kstep, voffA); PG8_STAGE(PG8_SB(1, 1), cB + hstepB + kstep, voffB);
        PG8_WAIT_V(6); PG8_BAR;
    }
    for (;;) {
        const bool has_next = S.next(ui + 1, nxt);
        const PG8_GAS char* nA = has_next ? (const PG8_GAS char*)S.a_ptr(nxt) : cA; const PG8_GAS char* nB = has_next ? (const PG8_GAS char*)S.b_ptr(nxt) : cB;
        for (int t = 0; t < nt; t += 2) {
            const bool last = (t == nt - 2);
            const PG8_GAS char* a1 = cA + (size_t)(t + 1) * kstep;
            const PG8_GAS char* a2 = last ? nA : cA + (size_t)(t + 2) * kstep; const PG8_GAS char* b2 = last ? nB : cB + (size_t)(t + 2) * kstep;
            const PG8_GAS char* a3 = a2 + kstep; const PG8_GAS char* b3 = b2 + kstep;
            if (last && has_next) S.a_ready(nxt);
            if constexpr (Epi::MID_T > 0) { if (t == Epi::MID_T) E.mid(acc, cur, wr, wc, fr, fq); }
            if constexpr (SP2) {
            PG8_LDB(B0, 0, 0); PG8_LDB(B1, 0, 1); PG8_SCHED; PG8_LDA(At, 0, 0); PG8_STAGE(PG8_SA(1, 1), a1 + hstepA, voffA);
            PG8_WAIT_V(8); PG8_WAIT_L(0); PG8_BAR; PG8_MMA(0, 0, At, B0); PG8_MMA(0, 1, At, B1); PG8_BAR; PG8_SCHED;
            PG8_LDA(At, 0, 1); PG8_STAGE(PG8_SB(0, 0), b2, voffB); PG8_STAGE(PG8_SB(0, 1), b2 + hstepB, voffB); PG8_STAGE(PG8_SA(0, 0), a2, voffA);
            PG8_WAIT_V(8); PG8_WAIT_L(0); PG8_BAR; PG8_MMA(1, 0, At, B0); PG8_MMA(1, 1, At, B1); PG8_BAR; PG8_SCHED;
            PG8_LDB(B0, 1, 0); PG8_LDB(B1, 1, 1); PG8_SCHED; PG8_LDA(At, 1, 0); PG8_STAGE(PG8_SA(0, 1), a2 + hstepA, voffA);
            PG8_WAIT_V(8); PG8_WAIT_L(0); PG8_BAR; PG8_MMA(0, 0, At, B0); PG8_MMA(0, 1, At, B1); PG8_BAR; PG8_SCHED;
            PG8_LDA(At, 1, 1); PG8_STAGE(PG8_SB(1, 0), b3, voffB); PG8_STAGE(PG8_SB(1, 1), b3 + hstepB, voffB); PG8_STAGE(PG8_SA(1, 0), a3, voffA);
            PG8_WAIT_V(8); PG8_WAIT_L(0); PG8_BAR; PG8_MMA(1, 0, At, B0); PG8_MMA(1, 1, At, B1); PG8_BAR; PG8_SCHED;
            } else {
            PG8_LDB(B0, 0, 0); PG8_SCHED; PG8_LDA(At, 0, 0); PG8_STAGE(PG8_SA(1, 1), a1 + hstepA, voffA);
            PG8_WAIT_L(8); PG8_BAR; PG8_WAIT_L(0); PG8_MMA(0, 0, At, B0); PG8_BAR; PG8_SCHED;
            PG8_LDB(B1, 0, 1); PG8_STAGE(PG8_SB(0, 0), b2, voffB);
            PG8_BAR; PG8_WAIT_L(0); PG8_MMA(0, 1, At, B1); PG8_BAR;
            PG8_LDA(At, 0, 1); PG8_STAGE(PG8_SA(0, 0), a2, voffA);
            PG8_BAR; PG8_WAIT_L(0); PG8_MMA(1, 0, At, B0); PG8_BAR; PG8_SCHED;
            PG8_STAGE(PG8_SB(0, 1), b2 + hstepB, voffB);
            PG8_WAIT_V(6); PG8_BAR; PG8_MMA(1, 1, At, B1); PG8_BAR;
            PG8_LDB(B0, 1, 0); PG8_SCHED; PG8_LDA(At, 1, 0); PG8_STAGE(PG8_SA(0, 1), a2 + hstepA, voffA);
            PG8_WAIT_L(8); PG8_BAR; PG8_WAIT_L(0); PG8_MMA(0, 0, At, B0); PG8_BAR; PG8_SCHED;
            PG8_LDB(B1, 1, 1); PG8_STAGE(PG8_SB(1, 0), b3, voffB);
            PG8_BAR; PG8_WAIT_L(0); PG8_MMA(0, 1, At, B1); PG8_BAR;
            PG8_LDA(At, 1, 1); PG8_STAGE(PG8_SA(1, 0), a3, voffA);
            PG8_BAR; PG8_WAIT_L(0); PG8_MMA(1, 0, At, B0); PG8_BAR; PG8_SCHED;
            PG8_STAGE(PG8_SB(1, 1), b3 + hstepB, voffB);
            PG8_WAIT_V(6); PG8_BAR; PG8_MMA(1, 1, At, B1); PG8_BAR;
            }
        }
        if constexpr (ALIGN_EPI) { if (wr == 0) PG8_BAR; }
        if constexpr (has_rs_lds<Epi>::value) { E(acc, cur, wr, wc, fr, fq, (const PG8_LAS float*)(lds + STAGE_BYTES + (ui & 1) * 1024)); S.done(cur); } else
        if constexpr (!Epi::AFTER_DRAIN) { E(acc, cur, wr, wc, fr, fq); S.done(cur); }
        if (!has_next) break;
#pragma unroll
        for (int a = 0; a < 2; ++a)
#pragma unroll
            for (int b = 0; b < 2; ++b)
#pragma unroll
                for (int m = 0; m < 4; ++m)
#pragma unroll
                    for (int n = 0; n < 2; ++n) acc[a][b][m][n] = (f32x4){0.f, 0.f, 0.f, 0.f};
        cur = nxt; cA = nA; cB = nB; ++ui;
        if constexpr (has_rs_lds<Epi>::value) { const PG8_GAS float* rb_ = E.rs_base(cur); if (rb_ != nullptr && wid == 0) __builtin_amdgcn_global_load_lds((const PG8_GAS unsigned*)(rb_ + lane * 4), (PG8_LAS unsigned*)(lds + STAGE_BYTES + (ui & 1) * 1024), 16, 0, 0); }
        if constexpr (ALIGN_EPI) { if (wr == 1) PG8_BAR; }
    }
    PG8_WAIT_V(0);
    if constexpr (!ALIGN_EPI) { if (wr == 0) PG8_BAR; }
    PG8_BAR;
    if constexpr (Epi::AFTER_DRAIN) { E.fused(acc, cur, wr, wc, fr, fq, lds, wid, lane); S.done(cur); }
#undef PG8_SA
#undef PG8_SB
#undef PG8_STAGE
#undef PG8_LDA
#undef PG8_LDB
#undef PG8_MMA
#undef PG8_WAIT_V
#undef PG8_WAIT_L
#undef PG8_BAR
#undef PG8_SCHED
}
}

namespace att {
typedef short bf16x8 __attribute__((ext_vector_type(8)));
typedef short s16x4 __attribute__((ext_vector_type(4)));
typedef float f32x16 __attribute__((ext_vector_type(16)));
typedef float f32x8v __attribute__((ext_vector_type(8)));
typedef unsigned u32x4 __attribute__((ext_vector_type(4)));
constexpr int D = 128, NW = 8, QBLK = 32, KVBLK = 64;
constexpr float SCALE = 0.088388347648318440f, LOG2E = 1.4426950408889634f, CS = SCALE * LOG2E;
constexpr int SHM_V = KVBLK * D * 2, SHM_K = KVBLK * D * 2;
constexpr int OFF_V = 0, OFF_K = 2 * SHM_V, OFF_WS = 2 * SHM_V + 2 * SHM_K, OFF_MISC = OFF_WS + NW * 256;
constexpr int OFF_Q = OFF_MISC + 256, OFF_PREF = OFF_Q + NW * 8192, ATT_LDS = OFF_PREF + 516 * 4 + 512 * 4;
constexpr int ATT_LDS_OLD = OFF_PREF;
#define KSWZ(row, colB) ((row) * 256 + ((colB) ^ (((row) & 7) << 4)))
#define SBAR() __builtin_amdgcn_sched_barrier(0)
__device__ __forceinline__ int crow(int r, int hi) { return (r & 3) + 8 * (r >> 2) + 4 * hi; }
__device__ __forceinline__ unsigned cvtpk(float lo, float hi) { unsigned r; asm volatile("v_cvt_pk_bf16_f32 %0, %1, %2" : "=v"(r) : "v"(lo), "v"(hi)); return r; }
__device__ __forceinline__ int v_st(int k, int c) { const int kk = (k & ~0xC) | ((k & 4) << 1) | ((k & 8) >> 1); return ((kk >> 3) * 4 + (c >> 5)) * 512 + ((kk & 7) * 32 + (c & 31)) * 2; }
__device__ __forceinline__ int v_rd_base(int lane) { return ((lane & 3) << 3) | (((lane >> 2) & 3) << 6) | (((lane >> 4) & 1) << 5) | (((lane >> 5) & 1) << 8); }
constexpr int v_rd_off(int d0, int ks, int half) { return d0 * 512 + ks * 4096 + half * 2048; }
template <int OFF> __device__ __forceinline__ s16x4 tr_read(int vb) { s16x4 r; asm volatile("ds_read_b64_tr_b16 %0, %1 offset:%2" : "=&v"(r) : "v"(vb), "i"(OFF) : "memory"); return r; }
template <int D0> __device__ __forceinline__ void pv_one(f32x16& od, int vb, bf16x8 pa0, bf16x8 pa1, bf16x8 pa2, bf16x8 pa3) {
  const s16x4 l0 = tr_read<v_rd_off(D0, 0, 0)>(vb), h0 = tr_read<v_rd_off(D0, 0, 1)>(vb), l1 = tr_read<v_rd_off(D0, 1, 0)>(vb), h1 = tr_read<v_rd_off(D0, 1, 1)>(vb);
  const s16x4 l2 = tr_read<v_rd_off(D0, 2, 0)>(vb), h2 = tr_read<v_rd_off(D0, 2, 1)>(vb), l3 = tr_read<v_rd_off(D0, 3, 0)>(vb), h3 = tr_read<v_rd_off(D0, 3, 1)>(vb);
  asm volatile("s_waitcnt lgkmcnt(0)" ::: "memory"); SBAR();
#define PK(L, H) (bf16x8){L[0], L[1], L[2], L[3], H[0], H[1], H[2], H[3]}
  od = __builtin_amdgcn_mfma_f32_32x32x16_bf16(pa0, PK(l0, h0), od, 0, 0, 0);
  od = __builtin_amdgcn_mfma_f32_32x32x16_bf16(pa1, PK(l1, h1), od, 0, 0, 0);
  od = __builtin_amdgcn_mfma_f32_32x32x16_bf16(pa2, PK(l2, h2), od, 0, 0, 0);
  od = __builtin_amdgcn_mfma_f32_32x32x16_bf16(pa3, PK(l3, h3), od, 0, 0, 0);
#undef PK
}
__device__ __forceinline__ void pv_d0(f32x16* o, int vb, bf16x8 pa0, bf16x8 pa1, bf16x8 pa2, bf16x8 pa3) {
  pv_one<0>(o[0], vb, pa0, pa1, pa2, pa3); pv_one<1>(o[1], vb, pa0, pa1, pa2, pa3); pv_one<2>(o[2], vb, pa0, pa1, pa2, pa3); pv_one<3>(o[3], vb, pa0, pa1, pa2, pa3);
}
__device__ __forceinline__ void qkt(f32x16& p0, f32x16& p1, const char* Ks, const char* Qs, int r32, int hi) {
  p0 = f32x16{}; p1 = f32x16{};
#pragma unroll
  for (int d0 = 0; d0 < 8; ++d0) { const int cb = (d0 * 16 + hi * 8) * 2;
    const bf16x8 b0 = *reinterpret_cast<const bf16x8*>(Ks + KSWZ(r32, cb));
    const bf16x8 b1 = *reinterpret_cast<const bf16x8*>(Ks + KSWZ(32 + r32, cb));
    const bf16x8 q = *reinterpret_cast<const bf16x8*>(Qs + KSWZ(r32, cb));
    p0 = __builtin_amdgcn_mfma_f32_32x32x16_bf16(b0, q, p0, 0, 0, 0);
    p1 = __builtin_amdgcn_mfma_f32_32x32x16_bf16(b1, q, p1, 0, 0, 0); }
}
struct TileInfo { float a0, a1; int diag; };
__device__ __forceinline__ void partialSM(f32x16& p0, f32x16& p1, const TileInfo& ti, float sl2, int rowq, int hi) {
#pragma unroll
  for (int r = 0; r < 16; ++r) { const float kc = (float)((r & 3) + 8 * (r >> 2)); p0[r] = fmaf(sl2, kc, fmaf(p0[r], CS, ti.a0)); p1[r] = fmaf(sl2, kc, fmaf(p1[r], CS, ti.a1)); }
  if (ti.diag >= 0) {
    const int k0 = ti.diag + 4 * hi;
#pragma unroll
    for (int r = 0; r < 16; ++r) { const int kq = k0 + (r & 3) + 8 * (r >> 2); if (kq > rowq) p0[r] = -INFINITY; if (kq + 32 > rowq) p1[r] = -INFINITY; }
  }
#pragma unroll
  for (int r = 0; r < 16; ++r) p0[r] = __builtin_amdgcn_exp2f(p0[r]);
}
__device__ __forceinline__ void finishSM(f32x16& p0, f32x16& p1, float& l_reg, bf16x8& pa0, bf16x8& pa1, bf16x8& pa2, bf16x8& pa3) {
#pragma unroll
  for (int r = 0; r < 16; ++r) p1[r] = __builtin_amdgcn_exp2f(p1[r]);
  float ps = 0;
#pragma unroll
  for (int r = 0; r < 16; ++r) ps += p0[r];
#pragma unroll
  for (int r = 0; r < 16; ++r) ps += p1[r];
  { auto rr = __builtin_amdgcn_permlane32_swap(__float_as_uint(ps), __float_as_uint(ps), false, false);
    ps = __uint_as_float(rr[0]) + __uint_as_float(rr[1]); }
  l_reg += ps;
#define PK4(P, BASE, OUT) do { unsigned a0 = cvtpk(P[BASE + 0], P[BASE + 1]), a1 = cvtpk(P[BASE + 2], P[BASE + 3]);   \
    unsigned b0 = cvtpk(P[BASE + 4], P[BASE + 5]), b1 = cvtpk(P[BASE + 6], P[BASE + 7]);                              \
    auto r0 = __builtin_amdgcn_permlane32_swap(a0, b0, false, false); auto r1 = __builtin_amdgcn_permlane32_swap(a1, b1, false, false); \
    u32x4 w = {r0[0], r1[0], r0[1], r1[1]}; OUT = *reinterpret_cast<bf16x8*>(&w); } while (0)
  PK4(p0, 0, pa0); PK4(p0, 8, pa1); PK4(p1, 0, pa2); PK4(p1, 8, pa3);
#undef PK4
}
#define TOP3_INS(v, i) do { const float v_ = (v); const int i_ = (i); \
    const bool b1_ = v_ > t1 || (v_ == t1 && i_ < i1), b2_ = v_ > t2 || (v_ == t2 && i_ < i2), b3_ = v_ > t3 || (v_ == t3 && i_ < i3); \
    if (b1_) { t3 = t2; i3 = i2; t2 = t1; i2 = i1; t1 = v_; i1 = i_; } else if (b2_) { t3 = t2; i3 = i2; t2 = v_; i2 = i_; } else if (b3_) { t3 = v_; i3 = i_; } } while (0)

__device__ __forceinline__ void attn_unit(int b, int h, int cur, const __attribute__((address_space(1))) unsigned short* __restrict__ QKN, int ldq, int cq, int ck, const __attribute__((address_space(1))) unsigned short* __restrict__ PROJ, int ldp, int cv, int seq, const __attribute__((address_space(1))) float* __restrict__ kmean,
                                          __attribute__((address_space(1))) unsigned short* __restrict__ OA, int ldo, char* lds, int tid, int wpast, float smax2) {
  const int wid = __builtin_amdgcn_readfirstlane(tid >> 6), lane = tid & 63, r32 = lane & 31, hi = lane >> 5;
  char* V_lds = lds + OFF_V; char* K_lds = lds + OFF_K;
  float* wsf = (float*)(lds + OFF_WS) + wid * 64; float* li_l = wsf; float* al_l = wsf + 32;
  volatile int* misc = (volatile int*)(lds + OFF_MISC);
  const float slope = exp2f(-(float)(h + 1)), sl2 = slope * LOG2E;
  const int rowq = wid * QBLK + r32;
  float l_reg = 0; f32x16 o[4] = {};
  const float negm = -(smax2 + sl2 * (float)rowq);
  char* Q_lds = lds + OFF_Q + wid * 8192;
  __syncthreads();
  { const __attribute__((address_space(1))) unsigned short* Qw = QKN + ((size_t)b * seq + cur * 256 + rowq) * ldq + cq + h * D + hi * 8;
#pragma unroll
    for (int d0 = 0; d0 < 8; ++d0) { const bf16x8 qv = *(const __attribute__((address_space(1))) bf16x8*)(Qw + d0 * 16); *reinterpret_cast<bf16x8*>(Q_lds + KSWZ(r32, (d0 * 16 + hi * 8) * 2)) = qv; } }
  asm volatile("s_waitcnt lgkmcnt(0)" ::: "memory");
  unsigned selmask = 0u;
  if (cur > 0) {
    f32x16 g = {};
    const __attribute__((address_space(1))) float* km = kmean + ((size_t)(b * 8 + h) * 32 + r32) * D + hi * 8;
#pragma unroll
    for (int d0 = 0; d0 < 8; ++d0) { const f32x8v x = *(const __attribute__((address_space(1))) f32x8v*)(km + d0 * 16);
      u32x4 wh = {cvtpk(x[0], x[1]), cvtpk(x[2], x[3]), cvtpk(x[4], x[5]), cvtpk(x[6], x[7])};
      float rl[8];
#pragma unroll
      for (int k = 0; k < 4; ++k) { rl[2 * k] = x[2 * k] - __uint_as_float(wh[k] << 16); rl[2 * k + 1] = x[2 * k + 1] - __uint_as_float(wh[k] & 0xffff0000u); }
      u32x4 wl = {cvtpk(rl[0], rl[1]), cvtpk(rl[2], rl[3]), cvtpk(rl[4], rl[5]), cvtpk(rl[6], rl[7])};
      const bf16x8 q = *reinterpret_cast<const bf16x8*>(Q_lds + KSWZ(r32, (d0 * 16 + hi * 8) * 2));
      g = __builtin_amdgcn_mfma_f32_32x32x16_bf16(*reinterpret_cast<bf16x8*>(&wh), q, g, 0, 0, 0);
      g = __builtin_amdgcn_mfma_f32_32x32x16_bf16(*reinterpret_cast<bf16x8*>(&wl), q, g, 0, 0, 0); }
    float t1 = -INFINITY, t2 = -INFINITY, t3 = -INFINITY; int i1 = 64, i2 = 65, i3 = 66;
#pragma unroll
    for (int r = 0; r < 16; ++r) { const int n = crow(r, hi); const float v = n < cur ? g[r] : -INFINITY; TOP3_INS(v, n); }
#define PARTNER_F(x) ({ const auto rr_ = __builtin_amdgcn_permlane32_swap(__float_as_uint(x), __float_as_uint(x), false, false); __uint_as_float(hi ? rr_[0] : rr_[1]); })
#define PARTNER_I(x) ({ const auto rr_ = __builtin_amdgcn_permlane32_swap((unsigned)(x), (unsigned)(x), false, false); (int)(hi ? rr_[0] : rr_[1]); })
    const float u1 = PARTNER_F(t1), u2 = PARTNER_F(t2), u3 = PARTNER_F(t3); const int j1 = PARTNER_I(i1), j2 = PARTNER_I(i2), j3 = PARTNER_I(i3);
#undef PARTNER_F
#undef PARTNER_I
    TOP3_INS(u1, j1); TOP3_INS(u2, j2); TOP3_INS(u3, j3);
    if (t1 > -INFINITY) selmask |= 1u << i1; if (t2 > -INFINITY) selmask |= 1u << i2; if (t3 > -INFINITY) selmask |= 1u << i3;
  }
  if (tid == 0) misc[0] = 0;
  __syncthreads();
  { unsigned wm = selmask;
    wm |= (unsigned)__builtin_amdgcn_ds_swizzle((int)wm, (1 << 10) | 0x1f); wm |= (unsigned)__builtin_amdgcn_ds_swizzle((int)wm, (2 << 10) | 0x1f); wm |= (unsigned)__builtin_amdgcn_ds_swizzle((int)wm, (4 << 10) | 0x1f);
    wm |= (unsigned)__builtin_amdgcn_ds_swizzle((int)wm, (8 << 10) | 0x1f); wm |= (unsigned)__builtin_amdgcn_ds_swizzle((int)wm, (16 << 10) | 0x1f);
    { const auto rr_ = __builtin_amdgcn_permlane32_swap(wm, wm, false, false); wm = rr_[0] | rr_[1]; }
    if (lane == 0 && wm) atomicOr((unsigned*)&misc[0], wm); }
  __syncthreads();
  if (tid == 0) { const unsigned any = (unsigned)misc[0]; int cnt = 0; const int nmin = cur - wpast > 0 ? cur - wpast : 0;
    for (int n = cur - 1; n >= nmin; --n) if ((any >> n) & 1u) { misc[4 + cnt] = n; ++cnt; }
    misc[1] = cnt; }
  __syncthreads();
  const int NT = 4 * (1 + __builtin_amdgcn_readfirstlane(misc[1]));
  const __attribute__((address_space(1))) unsigned short* Kh = QKN + (size_t)b * seq * ldq + ck + h * D; const __attribute__((address_space(1))) unsigned short* Vh = PROJ + (size_t)b * seq * ldp + cv + h * D;
  const int sr = tid >> 4, sc = (tid & 15) * 8, vst0 = v_st(sr, sc), vst1 = v_st(32 + sr, sc);
  const int vb0 = (int)(uintptr_t)V_lds + v_rd_base(lane);
  struct { bf16x8 vs0, vs1, ks0, ks1; } sr_[2];
#define TKEY(j) ((j) < 4 ? cur * 256 + (j) * 64 : __builtin_amdgcn_readfirstlane(misc[4 + (((j) - 4) >> 2)]) * 256 + ((j) & 3) * 64)
#define TINFO(ti, j) do { const int j_ = (j); int kp_; if (j_ < 4) { kp_ = j_ * 64; ti.a0 = sl2 * (float)(kp_ + 4 * hi) + negm; \
        ti.diag = (j_ * 64 + 63 > wid * QBLK) ? j_ * 64 : -1; }     \
      else { const int n_ = __builtin_amdgcn_readfirstlane(misc[4 + ((j_ - 4) >> 2)]); kp_ = (n_ - cur) * 256 + (j_ & 3) * 64; ti.a0 = ((selmask >> n_) & 1u) ? sl2 * (float)(kp_ + 4 * hi) + negm : -INFINITY; ti.diag = -1; } \
      ti.a1 = ti.a0 + 32.f * sl2; } while (0)
#define SLOAD(i, k0) do { const size_t k0_ = (size_t)(k0); sr_[i].vs0 = *(const __attribute__((address_space(1))) bf16x8*)(&Vh[(k0_ + sr) * ldp + sc]); sr_[i].vs1 = *(const __attribute__((address_space(1))) bf16x8*)(&Vh[(k0_ + 32 + sr) * ldp + sc]); \
    sr_[i].ks0 = *(const __attribute__((address_space(1))) bf16x8*)(&Kh[(k0_ + sr) * ldq + sc]); sr_[i].ks1 = *(const __attribute__((address_space(1))) bf16x8*)(&Kh[(k0_ + 32 + sr) * ldq + sc]); } while (0)
#define SWRITE(bb, i) do { *(bf16x8*)(V_lds + (bb) * SHM_V + vst0) = sr_[i].vs0; *(bf16x8*)(V_lds + (bb) * SHM_V + vst1) = sr_[i].vs1; const int kc = sc * 2; \
    *(bf16x8*)(K_lds + (bb) * SHM_K + KSWZ(sr, kc)) = sr_[i].ks0; *(bf16x8*)(K_lds + (bb) * SHM_K + KSWZ(32 + sr, kc)) = sr_[i].ks1; } while (0)
#define SWAIT() asm volatile("s_waitcnt vmcnt(4)" ::: "memory")
  f32x16 pA0, pA1, pB0, pB1; bf16x8 pa0, pa1, pa2, pa3; TileInfo tiA, tiB;
  constexpr int SE = 0, SO = 1;
  SLOAD(SE, TKEY(0)); asm volatile("s_waitcnt vmcnt(0)" ::: "memory"); SWRITE(0, SE); __syncthreads();
  qkt(pA0, pA1, K_lds, Q_lds, r32, hi); TINFO(tiA, 0); partialSM(pA0, pA1, tiA, sl2, rowq, hi);
  SLOAD(SO, TKEY(1)); SLOAD(SE, TKEY(2));
  SWAIT(); SWRITE(1, SO); __syncthreads();
  for (int j = 1; j + 1 < NT; j += 2) {
    SBAR(); qkt(pB0, pB1, K_lds + SHM_K, Q_lds, r32, hi);
    finishSM(pA0, pA1, l_reg, pa0, pa1, pa2, pa3); SBAR();
    SLOAD(SO, TKEY(j + 2 < NT ? j + 2 : j)); SBAR();
    pv_d0(o, vb0, pa0, pa1, pa2, pa3); TINFO(tiB, j); partialSM(pB0, pB1, tiB, sl2, rowq, hi);
    __syncthreads(); SWAIT(); SWRITE(0, SE);
    __syncthreads();
    SBAR(); qkt(pA0, pA1, K_lds, Q_lds, r32, hi);
    finishSM(pB0, pB1, l_reg, pa0, pa1, pa2, pa3); SBAR();
    SLOAD(SE, TKEY(j + 3 < NT ? j + 3 : j)); SBAR();
    pv_d0(o, vb0 + SHM_V, pa0, pa1, pa2, pa3); TINFO(tiA, j + 1); partialSM(pA0, pA1, tiA, sl2, rowq, hi);
    __syncthreads(); SWAIT(); SWRITE(1, SO);
    __syncthreads();
  }
  SBAR(); qkt(pB0, pB1, K_lds + SHM_K, Q_lds, r32, hi);
  finishSM(pA0, pA1, l_reg, pa0, pa1, pa2, pa3); SBAR();
  pv_d0(o, vb0, pa0, pa1, pa2, pa3); TINFO(tiB, NT - 1); partialSM(pB0, pB1, tiB, sl2, rowq, hi);
  __syncthreads();
  finishSM(pB0, pB1, l_reg, pa0, pa1, pa2, pa3); SBAR();
  pv_d0(o, vb0 + SHM_V, pa0, pa1, pa2, pa3);
  asm volatile("s_waitcnt vmcnt(0)" ::: "memory");
  if (hi == 0) li_l[r32] = l_reg; asm volatile("s_waitcnt lgkmcnt(0)" ::: "memory");
  __attribute__((address_space(1))) unsigned short* Ow = OA + ((size_t)b * seq + cur * 256 + wid * QBLK) * ldo + h * D;
#pragma unroll
  for (int r = 0; r < 16; ++r) { const int orow = crow(r, hi); const float rli = __builtin_amdgcn_rcpf(li_l[orow]);
#pragma unroll
    for (int d0 = 0; d0 < 4; ++d0) { const float v = o[d0][r] * rli; unsigned u = __float_as_uint(v); u = (u + 0x7fffu + ((u >> 16) & 1u)) >> 16; Ow[(size_t)orow * ldo + d0 * 32 + r32] = (unsigned short)u; } }
#undef TKEY
#undef TINFO
#undef SLOAD
#undef SWRITE
#undef SWAIT
}
constexpr int LIST_CAP = 8192;
__device__ __forceinline__ void attn_select(int b, int h, int cur, int wv, const __attribute__((address_space(1))) unsigned short* __restrict__ QKN, int ldq, int seq,
                                            const __attribute__((address_space(1))) float* __restrict__ kmean, __attribute__((address_space(1))) unsigned short* __restrict__ LIST,
                                            __attribute__((address_space(1))) unsigned* __restrict__ LCNT, __attribute__((address_space(1))) float* __restrict__ PL, int mtot, int lane, int wpast) {
  const int r32 = lane & 31, hi = lane >> 5, t = cur * 256 + wv * 32 + r32;
  bf16x8 qr[8];
  { const __attribute__((address_space(1))) unsigned short* Qw = QKN + ((size_t)b * seq + t) * ldq + h * D + hi * 8;
#pragma unroll
    for (int d0 = 0; d0 < 8; ++d0) qr[d0] = *(const __attribute__((address_space(1))) bf16x8*)(Qw + d0 * 16); }
  f32x16 g = {};
  const __attribute__((address_space(1))) float* km = kmean + ((size_t)(b * 8 + h) * 32 + r32) * D + hi * 8;
#pragma unroll
  for (int d0 = 0; d0 < 8; ++d0) { const f32x8v x = *(const __attribute__((address_space(1))) f32x8v*)(km + d0 * 16);
    u32x4 wh = {cvtpk(x[0], x[1]), cvtpk(x[2], x[3]), cvtpk(x[4], x[5]), cvtpk(x[6], x[7])};
    float rl[8];
#pragma unroll
    for (int k = 0; k < 4; ++k) { rl[2 * k] = x[2 * k] - __uint_as_float(wh[k] << 16); rl[2 * k + 1] = x[2 * k + 1] - __uint_as_float(wh[k] & 0xffff0000u); }
    u32x4 wl = {cvtpk(rl[0], rl[1]), cvtpk(rl[2], rl[3]), cvtpk(rl[4], rl[5]), cvtpk(rl[6], rl[7])};
    g = __builtin_amdgcn_mfma_f32_32x32x16_bf16(*reinterpret_cast<bf16x8*>(&wh), qr[d0], g, 0, 0, 0);
    g = __builtin_amdgcn_mfma_f32_32x32x16_bf16(*reinterpret_cast<bf16x8*>(&wl), qr[d0], g, 0, 0, 0); }
  float t1 = -INFINITY, t2 = -INFINITY, t3 = -INFINITY; int i1 = 64, i2 = 65, i3 = 66;
#pragma unroll
  for (int r = 0; r < 16; ++r) { const int n = crow(r, hi); const float v = n < cur ? g[r] : -INFINITY; TOP3_INS(v, n); }
#define PARTNER_F(x) ({ const auto rr_ = __builtin_amdgcn_permlane32_swap(__float_as_uint(x), __float_as_uint(x), false, false); __uint_as_float(hi ? rr_[0] : rr_[1]); })
#define PARTNER_I(x) ({ const auto rr_ = __builtin_amdgcn_permlane32_swap((unsigned)(x), (unsigned)(x), false, false); (int)(hi ? rr_[0] : rr_[1]); })
  const float u1 = PARTNER_F(t1), u2 = PARTNER_F(t2), u3 = PARTNER_F(t3); const int j1 = PARTNER_I(i1), j2 = PARTNER_I(i2), j3 = PARTNER_I(i3);
#undef PARTNER_F
#undef PARTNER_I
  TOP3_INS(u1, j1); TOP3_INS(u2, j2); TOP3_INS(u3, j3);
  const int nmin = cur - wpast > 0 ? cur - wpast : 0;
  const bool v1 = t1 > -INFINITY && i1 >= nmin, v2 = t2 > -INFINITY && i2 >= nmin, v3 = t3 > -INFINITY && i3 >= nmin;
  const size_t m = (size_t)b * seq + t;
  if (hi == 0) { if (!v1) PL[((size_t)0 * mtot + m) * 8 + h] = 0.f; if (!v2) PL[((size_t)1 * mtot + m) * 8 + h] = 0.f; if (!v3) PL[((size_t)2 * mtot + m) * 8 + h] = 0.f; }
  unsigned mycnt = 0u;
  for (int n = nmin; n < cur; ++n) { const bool sel = hi == 0 && ((v1 && i1 == n) || (v2 && i2 == n) || (v3 && i3 == n)); const unsigned long long mask = __ballot(sel); if (lane == n) mycnt = (unsigned)__popcll(mask); }
  unsigned mybase = 0u;
  if (mycnt) mybase = __hip_atomic_fetch_add(LCNT + (b * 8 + h) * 32 + lane, mycnt, __ATOMIC_RELAXED, __HIP_MEMORY_SCOPE_AGENT);
  for (int n = nmin; n < cur; ++n) {
    const bool s1 = v1 && i1 == n, s2 = v2 && i2 == n, s3 = v3 && i3 == n, sel = hi == 0 && (s1 || s2 || s3);
    const unsigned long long mask = __ballot(sel);
    const unsigned base = (unsigned)__builtin_amdgcn_readlane((int)mybase, n);
    if (sel) { const unsigned rank = __builtin_amdgcn_mbcnt_hi((unsigned)(mask >> 32), __builtin_amdgcn_mbcnt_lo((unsigned)mask, 0u));
      LIST[(size_t)((b * 8 + h) * 32 + n) * LIST_CAP + base + rank] = (unsigned short)(t | ((s1 ? 0 : s2 ? 1 : 2) << 13)); }
  }
}
__device__ __forceinline__ void attn_block_unit(bool own, int b, int h, int kb, int c0, int cnt, const __attribute__((address_space(1))) unsigned short* __restrict__ LIST,
                                                const __attribute__((address_space(1))) unsigned short* __restrict__ QKN, int ldq, int ck, const __attribute__((address_space(1))) unsigned short* __restrict__ PROJ, int ldp, int cv, int seq,
                                                __attribute__((address_space(1))) unsigned short* __restrict__ P01, __attribute__((address_space(1))) unsigned short* __restrict__ P23,
                                                __attribute__((address_space(1))) float* __restrict__ PL, int mtot, char* lds, int tid, float smax2) {
  const int wid = __builtin_amdgcn_readfirstlane(tid >> 6), lane = tid & 63, r32 = lane & 31, hi = lane >> 5;
  char* V_lds = lds + OFF_V; char* K_lds = lds + OFF_K;
  float* wsf = (float*)(lds + OFF_WS) + wid * 64; float* li_l = wsf; int* tj_l = (int*)(wsf + 32);
  const float slope = exp2f(-(float)(h + 1)), sl2 = slope * LOG2E;
  const int rowq = wid * QBLK + r32;
  const int kpos0 = kb * 256;
  const __attribute__((address_space(1))) unsigned short* Kh = QKN + ((size_t)b * seq + kpos0) * ldq + ck + h * D; const __attribute__((address_space(1))) unsigned short* Vh = PROJ + ((size_t)b * seq + kpos0) * ldp + cv + h * D;
  const int sr = tid >> 4, sc = (tid & 15) * 8, vst0 = v_st(sr, sc), vst1 = v_st(32 + sr, sc);
  const int vb0 = (int)(uintptr_t)V_lds + v_rd_base(lane);
  struct { bf16x8 vs0, vs1, ks0, ks1; } sr_[2];
#define SLOAD(i, k0) do { const size_t k0_ = (size_t)(k0); sr_[i].vs0 = *(const __attribute__((address_space(1))) bf16x8*)(&Vh[(k0_ + sr) * ldp + sc]); sr_[i].vs1 = *(const __attribute__((address_space(1))) bf16x8*)(&Vh[(k0_ + 32 + sr) * ldp + sc]); \
    sr_[i].ks0 = *(const __attribute__((address_space(1))) bf16x8*)(&Kh[(k0_ + sr) * ldq + sc]); sr_[i].ks1 = *(const __attribute__((address_space(1))) bf16x8*)(&Kh[(k0_ + 32 + sr) * ldq + sc]); } while (0)
  int trow, slot; bool valid = true;
  if (own) { trow = kb * 256 + rowq; slot = 3; }
  else { const int idx = c0 + rowq; valid = idx < cnt; const int e = valid ? (int)LIST[(size_t)((b * 8 + h) * 32 + kb) * LIST_CAP + idx] : ((kb + 1) * 256); trow = e & 8191; slot = valid ? (e >> 13) : 0; }
  SLOAD(0, 0);
  bf16x8 qv[8];
  { const __attribute__((address_space(1))) unsigned short* Qw = QKN + ((size_t)b * seq + trow) * ldq + h * D + hi * 8;
#pragma unroll
    for (int d0 = 0; d0 < 8; ++d0) qv[d0] = *(const __attribute__((address_space(1))) bf16x8*)(Qw + d0 * 16); }
  float l_reg = 0; f32x16 o[4] = {};
  char* Q_lds = lds + OFF_Q + wid * 8192;
  __syncthreads();
#pragma unroll
  for (int d0 = 0; d0 < 8; ++d0) *reinterpret_cast<bf16x8*>(Q_lds + KSWZ(r32, (d0 * 16 + hi * 8) * 2)) = qv[d0];
  if (hi == 0) tj_l[r32] = valid ? ((slot << 16) | trow) : -1;
  asm volatile("s_waitcnt lgkmcnt(0)" ::: "memory");
  const float abase = -smax2 - sl2 * (float)(trow - kpos0 - 4 * hi);
#define BTINFO(ti, j) do { ti.a0 = abase + sl2 * (float)(64 * (j)); ti.a1 = ti.a0 + 32.f * sl2; ti.diag = (own && ((j) * 64 + 63 > wid * QBLK)) ? (j) * 64 : -1; } while (0)
#define SWRITE(bb, i) do { *(bf16x8*)(V_lds + (bb) * SHM_V + vst0) = sr_[i].vs0; *(bf16x8*)(V_lds + (bb) * SHM_V + vst1) = sr_[i].vs1; const int kc = sc * 2; \
    *(bf16x8*)(K_lds + (bb) * SHM_K + KSWZ(sr, kc)) = sr_[i].ks0; *(bf16x8*)(K_lds + (bb) * SHM_K + KSWZ(32 + sr, kc)) = sr_[i].ks1; } while (0)
  f32x16 pA0, pA1, pB0, pB1; bf16x8 pa0, pa1, pa2, pa3; TileInfo tiA, tiB;
  asm volatile("s_waitcnt vmcnt(0)" ::: "memory"); SWRITE(0, 0); __syncthreads();
  qkt(pA0, pA1, K_lds, Q_lds, r32, hi); BTINFO(tiA, 0); partialSM(pA0, pA1, tiA, sl2, rowq, hi);
  SLOAD(1, 64); SLOAD(0, 128);
  asm volatile("s_waitcnt vmcnt(4)" ::: "memory"); SWRITE(1, 1); __syncthreads();
  SBAR(); qkt(pB0, pB1, K_lds + SHM_K, Q_lds, r32, hi);
  finishSM(pA0, pA1, l_reg, pa0, pa1, pa2, pa3); SBAR();
  SLOAD(1, 192); SBAR();
  pv_d0(o, vb0, pa0, pa1, pa2, pa3); BTINFO(tiB, 1); partialSM(pB0, pB1, tiB, sl2, rowq, hi);
  __syncthreads(); asm volatile("s_waitcnt vmcnt(4)" ::: "memory"); SWRITE(0, 0);
  __syncthreads();
  SBAR(); qkt(pA0, pA1, K_lds, Q_lds, r32, hi);
  finishSM(pB0, pB1, l_reg, pa0, pa1, pa2, pa3); SBAR();
  pv_d0(o, vb0 + SHM_V, pa0, pa1, pa2, pa3); BTINFO(tiA, 2); partialSM(pA0, pA1, tiA, sl2, rowq, hi);
  __syncthreads(); asm volatile("s_waitcnt vmcnt(0)" ::: "memory"); SWRITE(1, 1);
  __syncthreads();
  SBAR(); qkt(pB0, pB1, K_lds + SHM_K, Q_lds, r32, hi);
  finishSM(pA0, pA1, l_reg, pa0, pa1, pa2, pa3); SBAR();
  pv_d0(o, vb0, pa0, pa1, pa2, pa3); BTINFO(tiB, 3); partialSM(pB0, pB1, tiB, sl2, rowq, hi);
  finishSM(pB0, pB1, l_reg, pa0, pa1, pa2, pa3); SBAR();
  pv_d0(o, vb0 + SHM_V, pa0, pa1, pa2, pa3);
  if (hi == 0) li_l[r32] = l_reg; asm volatile("s_waitcnt lgkmcnt(0)" ::: "memory");
  if (hi == 0 && valid) { PL[((size_t)slot * mtot + (size_t)b * seq + trow) * 8 + h] = l_reg;
    if (own && kb == 0) { const size_t m_ = (size_t)b * seq + trow; PL[((size_t)0 * mtot + m_) * 8 + h] = 0.f; PL[((size_t)1 * mtot + m_) * 8 + h] = 0.f; PL[((size_t)2 * mtot + m_) * 8 + h] = 0.f; } }
#pragma unroll
  for (int r = 0; r < 16; ++r) { const int orow = crow(r, hi); const int e = tj_l[orow]; const float lv = li_l[orow]; const float rli = lv > 0.f ? __builtin_amdgcn_rcpf(lv) : 0.f;
    if (e >= 0) { const int sl = e >> 16; __attribute__((address_space(1))) unsigned short* Ow = (sl < 2 ? P01 : P23) + ((size_t)(sl & 1) * mtot + (size_t)b * seq + (e & 0xffff)) * 1024 + h * D;
#pragma unroll
      for (int d0 = 0; d0 < 4; ++d0) { const float v = o[d0][r] * rli; unsigned u = __float_as_uint(v); u = (u + 0x7fffu + ((u >> 16) & 1u)) >> 16; Ow[d0 * 32 + r32] = (unsigned short)u; } } }
#undef BTINFO
#undef SLOAD
#undef SWRITE
}
__device__ __forceinline__ void qkt_r(f32x16& p0, f32x16& p1, const char* Ks, const bf16x8* qr, int r32, int hi) {
  p0 = f32x16{}; p1 = f32x16{};
#pragma unroll
  for (int d0 = 0; d0 < 8; ++d0) { const int cb = (d0 * 16 + hi * 8) * 2;
    const bf16x8 b0 = *reinterpret_cast<const bf16x8*>(Ks + KSWZ(r32, cb));
    const bf16x8 b1 = *reinterpret_cast<const bf16x8*>(Ks + KSWZ(32 + r32, cb));
    p0 = __builtin_amdgcn_mfma_f32_32x32x16_bf16(b0, qr[d0], p0, 0, 0, 0);
    p1 = __builtin_amdgcn_mfma_f32_32x32x16_bf16(b1, qr[d0], p1, 0, 0, 0); }
}
constexpr int KV4_V = 0, KV4_K = 4 * SHM_V, KV4_WS = 4 * SHM_V + 4 * SHM_K, KV4_END = KV4_WS + NW * 256;
__device__ __forceinline__ void attn_kv_unit(int b, int h, int kb, int seg0, int segn, bool with_own, const __attribute__((address_space(1))) unsigned short* __restrict__ LIST,
                                             const __attribute__((address_space(1))) unsigned short* __restrict__ QKN, int ldq, int ck, const __attribute__((address_space(1))) unsigned short* __restrict__ PROJ, int ldp, int cv, int seq,
                                             __attribute__((address_space(1))) unsigned short* __restrict__ P01, __attribute__((address_space(1))) unsigned short* __restrict__ P23,
                                             __attribute__((address_space(1))) float* __restrict__ PL, int mtot, char* lds, int tid, float smax2) {
  const int wid = __builtin_amdgcn_readfirstlane(tid >> 6), lane = tid & 63, r32 = lane & 31, hi = lane >> 5;
  char* V_lds = lds + KV4_V; char* K_lds = lds + KV4_K;
  float* wsf = (float*)(lds + KV4_WS) + wid * 64; float* li_l = wsf; int* tj_l = (int*)(wsf + 32);
  const float slope = exp2f(-(float)(h + 1)), sl2 = slope * LOG2E;
  const int kpos0 = kb * 256;
  {
    const __attribute__((address_space(1))) unsigned short* Kh = QKN + ((size_t)b * seq + kpos0) * ldq + ck + h * D; const __attribute__((address_space(1))) unsigned short* Vh = PROJ + ((size_t)b * seq + kpos0) * ldp + cv + h * D;
    const int sr = tid >> 4, sc = (tid & 15) * 8, vst0 = v_st(sr, sc), vst1 = v_st(32 + sr, sc), kc = sc * 2;
    bf16x8 kv[4][4];
#pragma unroll
    for (int t = 0; t < 4; ++t) { const size_t k0 = (size_t)(t * 64);
      kv[t][0] = *(const __attribute__((address_space(1))) bf16x8*)(&Vh[(k0 + sr) * ldp + sc]); kv[t][1] = *(const __attribute__((address_space(1))) bf16x8*)(&Vh[(k0 + 32 + sr) * ldp + sc]);
      kv[t][2] = *(const __attribute__((address_space(1))) bf16x8*)(&Kh[(k0 + sr) * ldq + sc]); kv[t][3] = *(const __attribute__((address_space(1))) bf16x8*)(&Kh[(k0 + 32 + sr) * ldq + sc]); }
    __syncthreads();
#pragma unroll
    for (int t = 0; t < 4; ++t) {
      *(bf16x8*)(V_lds + t * SHM_V + vst0) = kv[t][0]; *(bf16x8*)(V_lds + t * SHM_V + vst1) = kv[t][1];
      *(bf16x8*)(K_lds + t * SHM_K + KSWZ(sr, kc)) = kv[t][2]; *(bf16x8*)(K_lds + t * SHM_K + KSWZ(32 + sr, kc)) = kv[t][3]; }
    __syncthreads();
  }
  const int vb0 = (int)(uintptr_t)V_lds + v_rd_base(lane);
  const int nown = with_own ? 8 : 0, ngr = nown + ((segn + 31) >> 5);
#define GRAW(gg, raw, isv) do { raw = 0; isv = true; if ((gg) >= nown) { const int idx_ = seg0 + ((gg) - nown) * 32 + r32; isv = idx_ < seg0 + segn; \
    if (isv) raw = (int)LIST[(size_t)((b * 8 + h) * 32 + kb) * LIST_CAP + idx_]; } } while (0)
#define GDEC(gg, raw, isv, e) do { asm volatile("" : "+v"(raw)); e = (gg) < nown ? ((kpos0 + (gg) * 32 + r32) | (3 << 13) | (1 << 16)) : (isv ? (raw | (1 << 16)) : (kpos0 + 256)); } while (0)
#define LOADQ(e) do { const __attribute__((address_space(1))) unsigned short* Qw_ = QKN + ((size_t)b * seq + ((e) & 8191)) * ldq + h * D + hi * 8; \
    _Pragma("unroll") for (int d0 = 0; d0 < 8; ++d0) qr[d0] = *(const __attribute__((address_space(1))) bf16x8*)(Qw_ + d0 * 16); } while (0)
  int e_cur = 0; bf16x8 qr[8];
  if (wid < ngr) { int raw0_; bool isv0_; GRAW(wid, raw0_, isv0_); GDEC(wid, raw0_, isv0_, e_cur); LOADQ(e_cur); }
  __builtin_amdgcn_s_waitcnt(0x0F70);
  for (int g = wid; g < ngr; g += NW) {
    const bool own = g < nown, has_n = g + NW < ngr;
    int raw_n = 0, e_nxt = 0; bool isv_n = true; if (has_n) GRAW(g + NW, raw_n, isv_n);
    const int trow = e_cur & 8191, slot = (e_cur >> 13) & 3; const bool valid = ((e_cur >> 16) & 1) != 0;
    const int rowq = own ? g * 32 + r32 : 1 << 20;
    const float abase = -smax2 - sl2 * (float)(trow - kpos0 - 4 * hi);
    float l_reg = 0; f32x16 o[4] = {};
    const int nt = own ? (g * 32 + 31) / 64 + 1 : 4;
    f32x16 pA0, pA1, pB0, pB1; bf16x8 pa0, pa1, pa2, pa3; TileInfo ti;
#define KTI(j) do { ti.a0 = abase + sl2 * (float)(64 * (j)); ti.a1 = ti.a0 + 32.f * sl2; ti.diag = (own && ((j) * 64 + 63 > g * 32)) ? (j) * 64 : -1; } while (0)
    qkt_r(pA0, pA1, K_lds, qr, r32, hi); KTI(0); partialSM(pA0, pA1, ti, sl2, rowq, hi);
    if (nt > 1) { SBAR(); qkt_r(pB0, pB1, K_lds + SHM_K, qr, r32, hi); }
    finishSM(pA0, pA1, l_reg, pa0, pa1, pa2, pa3); SBAR();
    pv_d0(o, vb0, pa0, pa1, pa2, pa3);
    if (nt > 1) {
      KTI(1); partialSM(pB0, pB1, ti, sl2, rowq, hi);
      if (nt > 2) { SBAR(); qkt_r(pA0, pA1, K_lds + 2 * SHM_K, qr, r32, hi); }
      finishSM(pB0, pB1, l_reg, pa0, pa1, pa2, pa3); SBAR();
      pv_d0(o, vb0 + SHM_V, pa0, pa1, pa2, pa3);
      if (nt > 2) {
        KTI(2); partialSM(pA0, pA1, ti, sl2, rowq, hi);
        if (nt > 3) { SBAR(); qkt_r(pB0, pB1, K_lds + 3 * SHM_K, qr, r32, hi); if (has_n) { GDEC(g + NW, raw_n, isv_n, e_nxt); LOADQ(e_nxt); } }
        finishSM(pA0, pA1, l_reg, pa0, pa1, pa2, pa3); SBAR();
        pv_d0(o, vb0 + 2 * SHM_V, pa0, pa1, pa2, pa3);
        if (nt > 3) {
          KTI(3); partialSM(pB0, pB1, ti, sl2, rowq, hi);
          finishSM(pB0, pB1, l_reg, pa0, pa1, pa2, pa3); SBAR();
          pv_d0(o, vb0 + 3 * SHM_V, pa0, pa1, pa2, pa3);
        }
      }
    }
#undef KTI
    if (nt < 4 && has_n) { GDEC(g + NW, raw_n, isv_n, e_nxt); LOADQ(e_nxt); }
    __builtin_amdgcn_s_waitcnt(0x0F70);
    if (hi == 0) { li_l[r32] = l_reg; tj_l[r32] = valid ? ((slot << 16) | trow) : -1; }
    asm volatile("s_waitcnt lgkmcnt(0)" ::: "memory");
    if (hi == 0 && valid) { const size_t m_ = (size_t)b * seq + trow; PL[((size_t)slot * mtot + m_) * 8 + h] = l_reg;
      if (own && kb == 0) { PL[((size_t)0 * mtot + m_) * 8 + h] = 0.f; PL[((size_t)1 * mtot + m_) * 8 + h] = 0.f; PL[((size_t)2 * mtot + m_) * 8 + h] = 0.f; } }
#pragma unroll
    for (int r = 0; r < 16; ++r) { const int orow = crow(r, hi); const int e = tj_l[orow]; const float lv = li_l[orow]; const float rli = lv > 0.f ? __builtin_amdgcn_rcpf(lv) : 0.f;
      if (e >= 0) { const int sl = e >> 16; __attribute__((address_space(1))) unsigned short* Ow = (sl < 2 ? P01 : P23) + ((size_t)(sl & 1) * mtot + (size_t)b * seq + (e & 0xffff)) * 1024 + h * D;
#pragma unroll
        for (int d0 = 0; d0 < 4; ++d0) { const float v = o[d0][r] * rli; unsigned u = __float_as_uint(v); u = (u + 0x7fffu + ((u >> 16) & 1u)) >> 16; Ow[d0 * 32 + r32] = (unsigned short)u; } } }
    asm volatile("s_waitcnt lgkmcnt(0)" ::: "memory");
    e_cur = e_nxt;
  }
#undef GRAW
#undef GDEC
#undef LOADQ
}
#undef KSWZ
#undef SBAR
#undef TOP3_INS
}

#ifndef DBG_ATT
#define DBG_ATT 0
#endif
#ifndef MK_ONE_LAUNCH
#define MK_ONE_LAUNCH 1
#endif
#ifndef PG8_SP2
#define PG8_SP2 true
#endif
#ifndef PG8_ALIGN
#define PG8_ALIGN true
#endif
constexpr int NWAVES = 8;
constexpr int BATCH = 2, SEQ = 8192, DM = 2048, DEPTH = 4;
constexpr int M = BATCH * SEQ;
constexpr int AH = 8, AD = 128, AW = 1024, MB = 256, NBLK = SEQ / MB;
constexpr int RH = 4, RDK = 256, RDV = 512;
constexpr int DFF = 5632, NIN = 13312;
constexpr int LDP = 9216, NNAT = 11264, NSWP = 2048;
constexpr int C_QA = 0, C_KA = 1024, C_VA = 2048, C_GR = 3072, C_GA = 5120, C_GT = 7168;
constexpr float EPS = 1e-6f;
constexpr int NPH = 12;
constexpr int NPHASES = DEPTH * NPH;

constexpr size_t MiB = 1u << 20;
constexpr size_t WS_CTL = 0, CTL_ZERO_BYTES = 128 * 1024;
constexpr size_t WS_KMEAN = 1 * MiB;
constexpr size_t WS_W0 = 2 * MiB, WS_W1 = 1232 * MiB;
constexpr size_t WS_WNAT = 0 * MiB, WS_WSWP = 44 * MiB, WS_WOA = 56 * MiB, WS_WOUT = 68 * MiB, WS_WFI = 76 * MiB, WS_WFO = 120 * MiB;
constexpr size_t WS_H = 144 * MiB;
constexpr size_t WS_PROJ = 208 * MiB;
constexpr size_t WS_OA = 496 * MiB, WS_ORR = 528 * MiB, WS_MRG = 592 * MiB, WS_T = 656 * MiB, WS_RET = 784 * MiB;
constexpr size_t WS_ST = WS_T;
constexpr size_t WS_AQ = 912 * MiB;
constexpr size_t WS_BQ = 976 * MiB;
constexpr size_t WS_KB = 1104 * MiB, WS_KTB = 1136 * MiB, WS_QKN = 1168 * MiB, WS_LIST = 1376 * MiB, WS_PL = 1384 * MiB, WS_PS = 1386 * MiB, WS_RS = 1394 * MiB, WS_END = 1395 * MiB;
constexpr size_t WS_P01 = 720 * MiB, WS_P23 = 592 * MiB;
constexpr int CW_BAR = 4096, CW_ATTQ = 8192, CW_DBG = 12288, CW_CVQ = 16384, CW_SCQ = 16384 + 256, CW_LCNT = 20480;

constexpr int RING_OFF = 0, RING_BYTES = 131072;
constexpr int LDS_BYTES = 163840;
constexpr int LDSCTL_OFF = LDS_BYTES - 1024, MISC_OFF = LDSCTL_OFF + 320;

#define GAS __attribute__((address_space(1)))
#define LAS __attribute__((address_space(3)))
typedef unsigned short bf16;
typedef unsigned v4u __attribute__((ext_vector_type(4)));
typedef float f32x4 __attribute__((ext_vector_type(4)));
typedef short bf16x8 __attribute__((ext_vector_type(8)));
typedef GAS unsigned gu32;
typedef GAS unsigned long long gu64;
#define RLX_AGENT __ATOMIC_RELAXED, __HIP_MEMORY_SCOPE_AGENT
#define LDS_WAIT() asm volatile("s_waitcnt lgkmcnt(0)" ::: "memory")
#define VM_WAIT() asm volatile("s_waitcnt vmcnt(0)" ::: "memory")
__device__ __forceinline__ unsigned long long rt() { return __builtin_amdgcn_s_memrealtime(); }
__device__ __forceinline__ unsigned f2bf(float f) { unsigned u = __builtin_bit_cast(unsigned, f); return (u + 0x7fffu + ((u >> 16) & 1u)) >> 16; }
__device__ __forceinline__ unsigned pk2(float lo, float hi) { return f2bf(lo) | (f2bf(hi) << 16); }

#define XB_TMO      128
#define XB_XCNT(j)  (256  + 64 * (j))
#define XB_XSUB(j)  (1280 + 64 * (j))
#define XB_XGEN(j)  (2304 + 64 * (j))
#define XB_TOP      3328
#define XB_TOPGEN   3392
#define XCD_BAR_WORDS 3456
#define XB_SPIN_CAP (1u << 22)

__device__ __forceinline__ unsigned xb_ld(unsigned* p)              { return __hip_atomic_load(p, __ATOMIC_RELAXED, __HIP_MEMORY_SCOPE_AGENT); }
__device__ __forceinline__ unsigned xb_add(unsigned* p, unsigned v) { return __hip_atomic_fetch_add(p, v, __ATOMIC_RELAXED, __HIP_MEMORY_SCOPE_AGENT); }
__device__ __forceinline__ unsigned xb_xcc_id() { return (unsigned)__builtin_amdgcn_s_getreg((3 << 11) | 20) & 0xFu; }
#define XB_SPIN(cond, bar) do { unsigned _sp = 0; while (cond) { __builtin_amdgcn_s_sleep(1); \
    if ((++_sp & 255u) == 0u) { if (xb_ld(&(bar)[XB_TMO])) break; if (_sp > XB_SPIN_CAP) { atomicAdd(&(bar)[XB_TMO], 1u); break; } } } } while (0)

struct XcdBarrier {
    unsigned* bar; unsigned x;
    volatile LAS unsigned* st;
};

__device__ __forceinline__ XcdBarrier xcd_barrier_post(unsigned* bar, volatile LAS unsigned* st) {
    XcdBarrier b; b.bar = bar; b.x = xb_xcc_id(); b.st = st;
    if (threadIdx.x == 0) (void)xb_add(&bar[XB_XCNT(b.x)], 1u);
    return b;
}
__device__ __forceinline__ void xcd_barrier_complete(unsigned* bar, unsigned x, unsigned& nloc, unsigned& nx) {
    const unsigned G = gridDim.x * gridDim.y * gridDim.z;
    unsigned sum, cnt, mine, sp = 0u;
    for (;;) {
        sum = 0u; cnt = 0u; mine = 0u;
#pragma unroll
        for (unsigned j = 0; j < 16; ++j) { const unsigned c = xb_ld(&bar[XB_XCNT(j)]); sum += c; cnt += (c > 0u) ? 1u : 0u; mine = (j == x) ? c : mine; }
        if (sum == G) break;
        __builtin_amdgcn_s_sleep(1);
        if ((++sp & 255u) == 0u) { if (xb_ld(&bar[XB_TMO])) break; if (sp > XB_SPIN_CAP) { atomicAdd(&bar[XB_TMO], 1u); break; } }
    }
    nloc = mine > 0u ? mine : 1u; nx = cnt > 0u ? cnt : 1u;
}

__device__ __forceinline__ void xcd_barrier(const XcdBarrier& b) {
    asm volatile("s_waitcnt vmcnt(0)" ::: "memory");
    __syncthreads();
    if (threadIdx.x == 0) {
        unsigned* bar = b.bar;
        __builtin_amdgcn_s_waitcnt(0);
        unsigned nloc = b.st[0], nx = b.st[1];
        if (nloc == 0u) { xcd_barrier_complete(bar, b.x, nloc, nx); b.st[0] = nloc; b.st[1] = nx; }
        const unsigned old = xb_add(&bar[XB_XSUB(b.x)], 1u);
        const unsigned gen = old / nloc;
        if (old + 1u == (gen + 1u) * nloc) {
            __builtin_amdgcn_fence(__ATOMIC_RELEASE, "agent");
            asm volatile("s_waitcnt vmcnt(0)" ::: "memory");
            const unsigned og = xb_add(&bar[XB_TOP], 1u);
            const unsigned tg = og / nx;
            if (og + 1u == (tg + 1u) * nx) xb_add(&bar[XB_TOPGEN], 1u);
            else XB_SPIN(xb_ld(&bar[XB_TOPGEN]) == tg, bar);
            __builtin_amdgcn_fence(__ATOMIC_ACQUIRE, "agent");
            xb_add(&bar[XB_XGEN(b.x)], 1u);
            asm volatile("s_waitcnt vmcnt(0)" ::: "memory");
        } else {
            XB_SPIN(xb_ld(&bar[XB_XGEN(b.x)]) == gen, bar);
            __builtin_amdgcn_fence(__ATOMIC_ACQUIRE, "agent");
            asm volatile("s_waitcnt vmcnt(0)" ::: "memory");
        }
    }
    __syncthreads();
}

struct Frame {
    LAS unsigned char* lds;
    volatile LAS unsigned* MISC;
    gu32* ctl;
    int tid, lane, wave;
    int vcu, G;
};
#define SWZ_XOR(v, m) __builtin_amdgcn_ds_swizzle((v), ((m) << 10) | 0x1f)
__device__ __forceinline__ float wave_sum(float v) {
    v += __int_as_float(SWZ_XOR(__float_as_int(v), 1)); v += __int_as_float(SWZ_XOR(__float_as_int(v), 2)); v += __int_as_float(SWZ_XOR(__float_as_int(v), 4));
    v += __int_as_float(SWZ_XOR(__float_as_int(v), 8)); v += __int_as_float(SWZ_XOR(__float_as_int(v), 16));
    const auto rr = __builtin_amdgcn_permlane32_swap(__float_as_uint(v), __float_as_uint(v), false, false);
    return __uint_as_float(rr[0]) + __uint_as_float(rr[1]);
}
__device__ __forceinline__ float wave_max(float v) {
    v = fmaxf(v, __int_as_float(SWZ_XOR(__float_as_int(v), 1))); v = fmaxf(v, __int_as_float(SWZ_XOR(__float_as_int(v), 2))); v = fmaxf(v, __int_as_float(SWZ_XOR(__float_as_int(v), 4)));
    v = fmaxf(v, __int_as_float(SWZ_XOR(__float_as_int(v), 8))); v = fmaxf(v, __int_as_float(SWZ_XOR(__float_as_int(v), 16)));
    const auto rr = __builtin_amdgcn_permlane32_swap(__float_as_uint(v), __float_as_uint(v), false, false);
    return fmaxf(__uint_as_float(rr[0]), __uint_as_float(rr[1]));
}
__device__ __forceinline__ unsigned wave_or(unsigned v) {
    v |= (unsigned)SWZ_XOR((int)v, 1); v |= (unsigned)SWZ_XOR((int)v, 2); v |= (unsigned)SWZ_XOR((int)v, 4); v |= (unsigned)SWZ_XOR((int)v, 8); v |= (unsigned)SWZ_XOR((int)v, 16);
    const auto rr = __builtin_amdgcn_permlane32_swap(v, v, false, false);
    return rr[0] | rr[1];
}
__device__ __forceinline__ float bf2f(bf16 b) { return __uint_as_float(((unsigned)b) << 16); }
__device__ __forceinline__ float blo(unsigned w) { return __uint_as_float(w << 16); }
__device__ __forceinline__ float bhi(unsigned w) { return __uint_as_float(w & 0xffff0000u); }

__device__ __forceinline__ void transpose_item(const GAS float* W, int K, int N, int k0, int n0, GAS bf16* WT, int dst_row0, GAS bf16* WT2, int dst2_row0, int ldw, int kofs, LAS float* scr, int lane, const GAS float* gain) {
    const int lr = lane >> 4, lc = (lane & 15) * 4;
    f32x4 v[16];
    const GAS float* src = W + (size_t)(k0 + lr) * N + n0 + lc;
#pragma unroll
    for (int i = 0; i < 16; ++i) v[i] = *(const GAS f32x4*)(src + (size_t)(4 * i) * N);
    if (gain) {
#pragma unroll
        for (int i = 0; i < 16; ++i) { const float gk = gain[k0 + lr + 4 * i]; v[i] = v[i] * gk; } }
#pragma unroll
    for (int i = 0; i < 16; ++i) { LAS float* d = scr + (4 * i + lr) * 65 + lc; d[0] = v[i].x; d[1] = v[i].y; d[2] = v[i].z; d[3] = v[i].w; }
    LDS_WAIT(); asm volatile("" ::: "memory");
    const int kc = lane & 7;
#pragma unroll
    for (int j = 0; j < 8; ++j) { const int n = (lane >> 3) + 8 * j; const LAS float* s = scr + (8 * kc) * 65 + n;
        v4u o; o.x = pk2(s[0 * 65], s[1 * 65]); o.y = pk2(s[2 * 65], s[3 * 65]); o.z = pk2(s[4 * 65], s[5 * 65]); o.w = pk2(s[6 * 65], s[7 * 65]);
        if (WT) *(GAS v4u*)(WT + (size_t)(dst_row0 + n) * ldw + kofs + k0 + 8 * kc) = o;
        if (WT2) *(GAS v4u*)(WT2 + (size_t)(dst2_row0 + n) * ldw + kofs + k0 + 8 * kc) = o; }
    LDS_WAIT(); asm volatile("" ::: "memory");
}
constexpr int I_IN = (DM / 64) * (NIN / 64), I_OA = (AW / 64) * (DM / 64), I_OR = (2048 / 64) * (DM / 64), I_OUT = (DM / 64) * (DM / 64), I_FI = (DM / 64) * (2 * DFF / 64), I_FO = (DFF / 64) * (DM / 64);
constexpr int NCONV = I_IN + I_OA + I_OR + I_OUT + I_FI + I_FO;
static_assert(NCONV % 8 == 0, "conversion items are dealt eight at a time");
__device__ __forceinline__ void convert_item(Frame& F, const float* const* in, int lw, unsigned char* wset, int it) {
    LAS float* scr = (LAS float*)(F.lds + RING_OFF + F.wave * 16896);
    const GAS float* W; int K, N, mode = 0, ldw, kofs = 0; GAS bf16* WT; GAS bf16* WT2 = nullptr; const GAS float* gain = nullptr;
    if (it < I_IN) { W = (const GAS float*)in[1] + (size_t)lw * DM * NIN; K = DM; N = NIN; mode = 2; gain = (const GAS float*)in[7] + (size_t)lw * DM; WT = (GAS bf16*)(wset + WS_WNAT); WT2 = (GAS bf16*)(wset + WS_WSWP); ldw = DM; }
    else if ((it -= I_IN) < I_OA) { W = (const GAS float*)in[2] + (size_t)lw * AW * DM; K = AW; N = DM; WT = (GAS bf16*)(wset + WS_WOA); ldw = 3072; }
    else if ((it -= I_OA) < I_OR) { W = (const GAS float*)in[3] + (size_t)lw * 2048 * DM; K = 2048; N = DM; WT = (GAS bf16*)(wset + WS_WOA); ldw = 3072; kofs = 1024; }
    else if ((it -= I_OR) < I_OUT) { W = (const GAS float*)in[4] + (size_t)lw * DM * DM; K = DM; N = DM; WT = (GAS bf16*)(wset + WS_WOUT); ldw = DM; }
    else if ((it -= I_OUT) < I_FI) { W = (const GAS float*)in[9] + (size_t)lw * DM * 2 * DFF; K = DM; N = 2 * DFF; mode = 1; gain = (const GAS float*)in[8] + (size_t)lw * DM; WT = (GAS bf16*)(wset + WS_WFI); ldw = DM; }
    else { it -= I_FI; W = (const GAS float*)in[10] + (size_t)lw * DFF * DM; K = DFF; N = DM; WT = (GAS bf16*)(wset + WS_WFO); ldw = DFF; }
    const int nblk = N / 64, kb = it / nblk, nb = it % nblk, k0 = 64 * kb, n0 = 64 * nb;
    int dst = n0, dst2 = 0; GAS bf16* w1 = WT; GAS bf16* w2 = nullptr;
    if (mode == 1) { const int isu = n0 >= DFF ? 1 : 0; const int j = n0 - isu * DFF; dst = (j / 128) * 256 + isu * 128 + (j % 128); }
    if (mode == 2) {
        if (n0 < 3072) dst = n0; else if (n0 < 4096) dst = n0 - 3072 + 9216; else if (n0 < 5120) dst = n0 - 4096 + 10240;
        else if (n0 < 7168) { w1 = nullptr; w2 = WT2; dst2 = n0 - 5120; } else dst = n0 - 7168 + 3072; }
    transpose_item(W, K, N, k0, n0, w1, dst, w2, dst2, ldw, kofs, scr, F.lane, gain);
}
__device__ __forceinline__ void rmsnorm_phase(Frame& F, const GAS float* x, const GAS float* g, GAS bf16* out) {
    const int gw = F.vcu * NWAVES + F.wave, NGW = F.G * NWAVES;
    for (int m = gw; m < M; m += 2 * NGW) {
        const bool two = m + NGW < M; const int m1 = two ? m + NGW : m;
        const GAS f32x4* xr0 = (const GAS f32x4*)(x + (size_t)m * DM) + F.lane; const GAS f32x4* xr1 = (const GAS f32x4*)(x + (size_t)m1 * DM) + F.lane;
        f32x4 v0[8], v1[8]; float s0 = 0.f, s1 = 0.f;
#pragma unroll
        for (int j = 0; j < 8; ++j) v0[j] = xr0[64 * j];
#pragma unroll
        for (int j = 0; j < 8; ++j) v1[j] = xr1[64 * j];
#pragma unroll
        for (int j = 0; j < 8; ++j) { s0 += (v0[j].x * v0[j].x + v0[j].y * v0[j].y) + (v0[j].z * v0[j].z + v0[j].w * v0[j].w); s1 += (v1[j].x * v1[j].x + v1[j].y * v1[j].y) + (v1[j].z * v1[j].z + v1[j].w * v1[j].w); }
        const float rstd0 = 1.0f / sqrtf(wave_sum(s0) * (1.f / DM) + EPS), rstd1 = 1.0f / sqrtf(wave_sum(s1) * (1.f / DM) + EPS);
        GAS unsigned long long* o0 = (GAS unsigned long long*)(out + (size_t)m * DM) + F.lane; GAS unsigned long long* o1 = (GAS unsigned long long*)(out + (size_t)m1 * DM) + F.lane;
#pragma unroll
        for (int j = 0; j < 8; ++j) { const f32x4 gg = ((const GAS f32x4*)g)[F.lane + 64 * j];
            o0[64 * j] = (unsigned long long)pk2(v0[j].x * rstd0 * gg.x, v0[j].y * rstd0 * gg.y) | ((unsigned long long)pk2(v0[j].z * rstd0 * gg.z, v0[j].w * rstd0 * gg.w) << 32);
            if (two) o1[64 * j] = (unsigned long long)pk2(v1[j].x * rstd1 * gg.x, v1[j].y * rstd1 * gg.y) | ((unsigned long long)pk2(v1[j].z * rstd1 * gg.z, v1[j].w * rstd1 * gg.w) << 32); }
    }
}
__device__ __forceinline__ float rms_ssq4(const v4u (&w)[4]) { float s = 0.f;
#pragma unroll
    for (int j = 0; j < 4; ++j) s += (blo(w[j].x) * blo(w[j].x) + bhi(w[j].x) * bhi(w[j].x)) + (blo(w[j].y) * blo(w[j].y) + bhi(w[j].y) * bhi(w[j].y)) + (blo(w[j].z) * blo(w[j].z) + bhi(w[j].z) * bhi(w[j].z)) + (blo(w[j].w) * blo(w[j].w) + bhi(w[j].w) * bhi(w[j].w));
    return s; }
__device__ __forceinline__ void rms_store4(const v4u (&w)[4], float rstd, const GAS float* g, GAS bf16* orow, int lane) {
    GAS v4u* o = (GAS v4u*)orow + lane;
#pragma unroll
    for (int j = 0; j < 4; ++j) { const f32x4 g0 = ((const GAS f32x4*)g)[2 * (lane + 64 * j)], g1 = ((const GAS f32x4*)g)[2 * (lane + 64 * j) + 1];
        v4u r; r.x = pk2(blo(w[j].x) * rstd * g0.x, bhi(w[j].x) * rstd * g0.y); r.y = pk2(blo(w[j].y) * rstd * g0.z, bhi(w[j].y) * rstd * g0.w);
        r.z = pk2(blo(w[j].z) * rstd * g1.x, bhi(w[j].z) * rstd * g1.y); r.w = pk2(blo(w[j].w) * rstd * g1.z, bhi(w[j].w) * rstd * g1.w);
        o[64 * j] = r; }
}
__device__ __forceinline__ void rmsnorm_bf16_phase(Frame& F, const GAS bf16* x, const GAS float* g, GAS bf16* out) {
    const int gw = F.vcu * NWAVES + F.wave, NGW = F.G * NWAVES;
    for (int m = gw; m < M; m += 2 * NGW) {
        const bool two = m + NGW < M; const int m1 = two ? m + NGW : m;
        const GAS v4u* xr0 = (const GAS v4u*)(x + (size_t)m * DM) + F.lane; const GAS v4u* xr1 = (const GAS v4u*)(x + (size_t)m1 * DM) + F.lane;
        v4u w0[4], w1[4];
#pragma unroll
        for (int j = 0; j < 4; ++j) w0[j] = xr0[64 * j];
#pragma unroll
        for (int j = 0; j < 4; ++j) w1[j] = xr1[64 * j];
        const float r0 = 1.0f / sqrtf(wave_sum(rms_ssq4(w0)) * (1.f / DM) + EPS), r1 = 1.0f / sqrtf(wave_sum(rms_ssq4(w1)) * (1.f / DM) + EPS);
        rms_store4(w0, r0, g, out + (size_t)m * DM, F.lane);
        if (two) rms_store4(w1, r1, g, out + (size_t)m1 * DM, F.lane);
    }
}
__device__ __forceinline__ void rstd_phase(Frame& F, const GAS float* PS, GAS float* RS) {
    const int sub = F.lane & 7;
    for (int row = (F.vcu * NWAVES * 64 + F.tid) >> 3; row < M; row += F.G * NWAVES * 8) {
        float q = 0.f;
#pragma unroll
        for (int t_ = 0; t_ < 4; ++t_) { const f32x4 p = ((const GAS f32x4*)(PS + (size_t)row * 128))[sub * 4 + t_]; q += (p.x + p.y) + (p.z + p.w); }
        q += __int_as_float(SWZ_XOR(__float_as_int(q), 1)); q += __int_as_float(SWZ_XOR(__float_as_int(q), 2)); q += __int_as_float(SWZ_XOR(__float_as_int(q), 4));
        if (sub == 0) RS[row] = 1.0f / sqrtf(q * (1.f / DM) + EPS);
    }
}
__device__ __forceinline__ void rs_prefill_lds(Frame& F, const GAS float* PS, int panel) {
    LAS float* dst = (LAS float*)(F.lds + RING_OFF + pg8::STAGE_BYTES);
    const int row = F.tid >> 1, half = F.tid & 1;
    const GAS f32x4* p = (const GAS f32x4*)(PS + ((size_t)panel * 256 + row) * 128 + half * 64);
    f32x4 v[16];
#pragma unroll
    for (int j = 0; j < 16; ++j) v[j] = p[j];
    float q = 0.f;
#pragma unroll
    for (int j = 0; j < 16; ++j) q += (v[j].x + v[j].y) + (v[j].z + v[j].w);
    q += __int_as_float(SWZ_XOR(__float_as_int(q), 1));
    const float r = 1.0f / sqrtf(q * (1.f / DM) + EPS);
    if (half == 0) { dst[row] = r; dst[256 + row] = r; }
    __syncthreads();
}
__device__ __forceinline__ void cast_rstd_phase(Frame& F, const GAS float* x, GAS bf16* out, GAS float* RS) {
    const int gw = F.vcu * NWAVES + F.wave, NGW = F.G * NWAVES;
    for (int m = gw; m < M; m += 2 * NGW) {
        const bool two = m + NGW < M; const int m1 = two ? m + NGW : m;
        const GAS f32x4* xr0 = (const GAS f32x4*)(x + (size_t)m * DM) + F.lane; const GAS f32x4* xr1 = (const GAS f32x4*)(x + (size_t)m1 * DM) + F.lane;
        f32x4 v0[8], v1[8]; float s0 = 0.f, s1 = 0.f;
#pragma unroll
        for (int j = 0; j < 8; ++j) v0[j] = xr0[64 * j];
#pragma unroll
        for (int j = 0; j < 8; ++j) v1[j] = xr1[64 * j];
#pragma unroll
        for (int j = 0; j < 8; ++j) { s0 += (v0[j].x * v0[j].x + v0[j].y * v0[j].y) + (v0[j].z * v0[j].z + v0[j].w * v0[j].w); s1 += (v1[j].x * v1[j].x + v1[j].y * v1[j].y) + (v1[j].z * v1[j].z + v1[j].w * v1[j].w); }
        const float rstd0 = 1.0f / sqrtf(wave_sum(s0) * (1.f / DM) + EPS), rstd1 = 1.0f / sqrtf(wave_sum(s1) * (1.f / DM) + EPS);
        GAS unsigned long long* o0 = (GAS unsigned long long*)(out + (size_t)m * DM) + F.lane; GAS unsigned long long* o1 = (GAS unsigned long long*)(out + (size_t)m1 * DM) + F.lane;
#pragma unroll
        for (int j = 0; j < 8; ++j) {
            o0[64 * j] = (unsigned long long)pk2(v0[j].x, v0[j].y) | ((unsigned long long)pk2(v0[j].z, v0[j].w) << 32);
            if (two) o1[64 * j] = (unsigned long long)pk2(v1[j].x, v1[j].y) | ((unsigned long long)pk2(v1[j].z, v1[j].w) << 32); }
        if (F.lane == 0) { RS[m] = rstd0; if (two) RS[m1] = rstd1; }
    }
}
__device__ __forceinline__ void qknorm_phase(Frame& F, const GAS bf16* PROJ, GAS bf16* QKN, const GAS float* qg, const GAS float* kg, GAS float* kmean) {
    LAS float* red = (LAS float*)(F.lds + RING_OFF);
    const int nunits = 2 * BATCH * AH * NBLK;
    const int l16 = F.lane & 15, rs = F.lane >> 4;
    v4u wn[8];
#define QK_SRC(u_) (PROJ + ((size_t)((((u_) >> 1) / NBLK) / AH) * SEQ + (((u_) >> 1) % NBLK) * MB + F.wave * 32 + rs) * LDP + (((u_) & 1) ? C_KA : C_QA) + ((((u_) >> 1) / NBLK) % AH) * AD + l16 * 8)
    if (F.vcu < nunits) { const GAS bf16* src0 = QK_SRC(F.vcu);
#pragma unroll
        for (int st = 0; st < 8; ++st) wn[st] = *(const GAS v4u*)(src0 + (size_t)(4 * st) * LDP); }
    for (int u = F.vcu; u < nunits; u += F.G) {
        const int isk = u & 1, r = u >> 1, n = r % NBLK, bh = r / NBLK, h = bh % AH, b = bh / AH;
        const GAS float* gain = (isk ? kg : qg) + l16 * 8;
        const f32x4 ga = *(const GAS f32x4*)gain, gb = *(const GAS f32x4*)(gain + 4);
        const size_t row0 = (size_t)b * SEQ + n * MB + F.wave * 32 + rs;
        GAS bf16* dst = QKN + row0 * 2048 + (isk ? 1024 : 0) + h * AD + l16 * 8;
        v4u w[8];
#pragma unroll
        for (int st = 0; st < 8; ++st) w[st] = wn[st];
        if (u + F.G < nunits) { const GAS bf16* src1 = QK_SRC(u + F.G);
#pragma unroll
            for (int st = 0; st < 8; ++st) wn[st] = *(const GAS v4u*)(src1 + (size_t)(4 * st) * LDP); }
        float a[8] = {0.f, 0.f, 0.f, 0.f, 0.f, 0.f, 0.f, 0.f};
#pragma unroll
        for (int st = 0; st < 8; ++st) {
            const float x0 = blo(w[st].x), x1 = bhi(w[st].x), x2 = blo(w[st].y), x3 = bhi(w[st].y), x4 = blo(w[st].z), x5 = bhi(w[st].z), x6 = blo(w[st].w), x7 = bhi(w[st].w);
            float q = ((x0 * x0 + x1 * x1) + (x2 * x2 + x3 * x3)) + ((x4 * x4 + x5 * x5) + (x6 * x6 + x7 * x7));
            q += __int_as_float(SWZ_XOR(__float_as_int(q), 1)); q += __int_as_float(SWZ_XOR(__float_as_int(q), 2)); q += __int_as_float(SWZ_XOR(__float_as_int(q), 4)); q += __int_as_float(SWZ_XOR(__float_as_int(q), 8));
            const float rstd = 1.0f / sqrtf(q * (1.f / AD) + EPS);
            v4u o; o.x = pk2(x0 * rstd * ga.x, x1 * rstd * ga.y); o.y = pk2(x2 * rstd * ga.z, x3 * rstd * ga.w); o.z = pk2(x4 * rstd * gb.x, x5 * rstd * gb.y); o.w = pk2(x6 * rstd * gb.z, x7 * rstd * gb.w);
            *(GAS v4u*)(dst + (size_t)(4 * st) * 2048) = o;
            a[0] += blo(o.x); a[1] += bhi(o.x); a[2] += blo(o.y); a[3] += bhi(o.y); a[4] += blo(o.z); a[5] += bhi(o.z); a[6] += blo(o.w); a[7] += bhi(o.w);
        }
        if (isk) {
#pragma unroll
            for (int k = 0; k < 8; ++k) { float v = a[k]; v += __int_as_float(SWZ_XOR(__float_as_int(v), 16));
                const auto rr = __builtin_amdgcn_permlane32_swap(__float_as_uint(v), __float_as_uint(v), false, false); a[k] = __uint_as_float(rr[0]) + __uint_as_float(rr[1]); }
            __syncthreads();
            if (F.lane < 16) {
#pragma unroll
                for (int k = 0; k < 8; ++k) red[F.wave * 128 + l16 * 8 + k] = a[k]; }
            __syncthreads();
            if (F.tid < 128) { float sm = 0.f;
#pragma unroll
                for (int w8 = 0; w8 < 8; ++w8) sm += red[w8 * 128 + F.tid];
                kmean[(size_t)(bh * NBLK + n) * AD + F.tid] = sm * (1.f / MB); }
        }
    }
#undef QK_SRC
}
__device__ __forceinline__ void attn_naive_phase(Frame& F, const GAS bf16* QKN, const GAS bf16* PROJ, const GAS float* kmean, GAS bf16* OA, int wg_lo) {
    LAS float* qf = (LAS float*)(F.lds + RING_OFF + F.wave * 8192);
    LAS float* pb = qf + 128;
    const int lane = F.lane;
    const int nw = (F.G - wg_lo) * NWAVES, w0 = (F.vcu - wg_lo) * NWAVES + F.wave;
    const float scale = 0.08838834764831845f;
    for (int u = w0; u < BATCH * AH * SEQ; u += nw) {
        const int t = u % SEQ, bh = u / SEQ, h = bh % AH, b = bh / AH, cur = t >> 8;
        const size_t m = (size_t)b * SEQ + t;
        const float slope = exp2f(-(float)(h + 1));
        { const unsigned qw = *((const GAS unsigned*)(QKN + m * 2048 + h * AD) + lane); qf[2 * lane] = blo(qw); qf[2 * lane + 1] = bhi(qw); }
        LDS_WAIT(); asm volatile("" ::: "memory");
        float g = -INFINITY;
        if (lane < cur) { const GAS float* km = kmean + (size_t)(bh * NBLK + lane) * AD; float a = 0.f;
            for (int d = 0; d < AD; d += 4) { const f32x4 kv = *(const GAS f32x4*)(km + d); a += qf[d] * kv.x + qf[d + 1] * kv.y + qf[d + 2] * kv.z + qf[d + 3] * kv.w; }
            g = a; }
        int sel0 = 0, sel1 = 0, sel2 = 0; bool val0 = false, val1 = false, val2 = false;
#pragma unroll
        for (int j = 0; j < 3; ++j) {
            const float mx = wave_max(g); const bool v = mx > -INFINITY;
            const unsigned long long bal = __ballot(g == mx);
            const int ln = v ? (__ffsll((long long)bal) - 1) : 0;
            if (v && lane == ln) g = -INFINITY;
            if (j == 0) { sel0 = ln; val0 = v; } else if (j == 1) { sel1 = ln; val1 = v; } else { sel2 = ln; val2 = v; }
        }
        float sc[4][4]; float mx = -INFINITY;
#pragma unroll
        for (int jb = 0; jb < 4; ++jb) {
            const bool v = jb == 0 ? val0 : jb == 1 ? val1 : jb == 2 ? val2 : true;
            const int blk = jb == 0 ? sel0 : jb == 1 ? sel1 : jb == 2 ? sel2 : cur;
#pragma unroll
            for (int i = 0; i < 4; ++i) {
                float s = -INFINITY;
                if (v) {
                    const int kpos = blk * MB + i * 64 + lane;
                    const GAS bf16* krow = QKN + ((size_t)b * SEQ + kpos) * 2048 + 1024 + h * AD;
                    float a = 0.f;
                    for (int d8 = 0; d8 < 16; ++d8) { const v4u kk = *(const GAS v4u*)(krow + d8 * 8); const LAS float* q8 = qf + d8 * 8;
                        a += q8[0] * blo(kk.x) + q8[1] * bhi(kk.x) + q8[2] * blo(kk.y) + q8[3] * bhi(kk.y) + q8[4] * blo(kk.z) + q8[5] * bhi(kk.z) + q8[6] * blo(kk.w) + q8[7] * bhi(kk.w); }
                    s = a * scale - slope * (float)(t - kpos);
                    if (jb == 3 && kpos > t) s = -INFINITY;
                }
                sc[jb][i] = s; mx = fmaxf(mx, s);
            }
        }
        mx = wave_max(mx);
        float sum = 0.f;
#pragma unroll
        for (int jb = 0; jb < 4; ++jb)
#pragma unroll
            for (int i = 0; i < 4; ++i) { const float p = __expf(sc[jb][i] - mx); sum += p; pb[jb * 256 + i * 64 + lane] = p; }
        sum = wave_sum(sum);
        LDS_WAIT(); asm volatile("" ::: "memory");
        float o0 = 0.f, o1 = 0.f;
#pragma unroll
        for (int jb = 0; jb < 4; ++jb) {
            const bool v = jb == 0 ? val0 : jb == 1 ? val1 : jb == 2 ? val2 : true;
            const int blk = jb == 0 ? sel0 : jb == 1 ? sel1 : jb == 2 ? sel2 : cur;
            if (v) {
                const int nk = jb == 3 ? (t - cur * MB + 1) : MB;
                const GAS bf16* vb = PROJ + ((size_t)b * SEQ + blk * MB) * LDP + C_VA + h * AD;
                for (int kk = 0; kk < nk; ++kk) { const float p = pb[jb * 256 + kk]; const unsigned vw = *((const GAS unsigned*)(vb + (size_t)kk * LDP) + lane); o0 += p * blo(vw); o1 += p * bhi(vw); }
            }
        }
        const float inv = 1.0f / sum;
        *((GAS unsigned*)(OA + m * AW + h * AD) + lane) = pk2(o0 * inv, o1 * inv);
        LDS_WAIT(); asm volatile("" ::: "memory");
    }
}
__device__ __forceinline__ void ktrans_phase(Frame& F, const GAS bf16* KB, GAS bf16* KTB, bool own) {
    LAS bf16* scr = (LAS bf16*)(F.lds + RING_OFF + F.wave * 9216);
    const int gw = own ? (int)blockIdx.x * 16 + F.wave : F.vcu * NWAVES + F.wave, NGW = own ? NWAVES : F.G * NWAVES, iend = own ? (int)blockIdx.x * 16 + 16 : 256 * 16, lr = F.lane >> 3, lc = F.lane & 7;
    for (int it = gw; it < iend; it += NGW) {
        const int c = it >> 4, jt = (it >> 2) & 3, dt = it & 3;
        const GAS bf16* src = KB + (size_t)c * 65536 + (size_t)(jt * 64) * 256 + dt * 64;
        GAS bf16* dst = KTB + (size_t)c * 65536 + (size_t)(dt * 64) * 256 + jt * 64;
        v4u v[8];
#pragma unroll
        for (int i = 0; i < 8; ++i) v[i] = *(const GAS v4u*)(src + (size_t)(lr + 8 * i) * 256 + lc * 8);
#pragma unroll
        for (int i = 0; i < 8; ++i) *(LAS v4u*)(scr + (lr + 8 * i) * 72 + lc * 8) = v[i];
        LDS_WAIT(); asm volatile("" ::: "memory");
#pragma unroll
        for (int i = 0; i < 8; ++i) { const int d = lr + 8 * i; const LAS bf16* p = scr + (lc * 8) * 72 + d;
            v4u o; o.x = (unsigned)p[0] | ((unsigned)p[72] << 16); o.y = (unsigned)p[2 * 72] | ((unsigned)p[3 * 72] << 16); o.z = (unsigned)p[4 * 72] | ((unsigned)p[5 * 72] << 16); o.w = (unsigned)p[6 * 72] | ((unsigned)p[7 * 72] << 16);
            *(GAS v4u*)(dst + (size_t)d * 256 + lc * 8) = o; }
        LDS_WAIT(); asm volatile("" ::: "memory");
    }
}
__device__ __forceinline__ void scan_item(Frame& F, const GAS bf16* ST, GAS bf16* BQ, int item) {
    { const int idx = item * 512 + F.tid;
        const int bh = idx >> 14, rem = idx & 16383, e = rem >> 5, d8 = rem & 31, h = bh & 3;
        const float gC = exp2f(256.0f * __log2f(1.0f - exp2f(-5.0f - (float)h)));
        float s[8];
#pragma unroll
        for (int k = 0; k < 8; ++k) s[k] = 0.f;
        const GAS bf16* sp = ST + (size_t)bh * 32 * 131072 + (size_t)e * 256 + 8 * d8;
        GAS bf16* bp = BQ + (size_t)bh * 32 * 262144 + (size_t)e * 512 + 256 + 8 * d8;
        for (int n0 = 0; n0 < 32; n0 += 16) {
            v4u kv[16];
#pragma unroll
            for (int k = 0; k < 16; ++k) kv[k] = *(const GAS v4u*)(sp + (size_t)(n0 + k) * 131072);
#pragma unroll
            for (int k = 0; k < 16; ++k) {
                v4u o; o.x = pk2(s[0], s[1]); o.y = pk2(s[2], s[3]); o.z = pk2(s[4], s[5]); o.w = pk2(s[6], s[7]);
                *(GAS v4u*)(bp + (size_t)(n0 + k) * 262144) = o;
                s[0] = s[0] * gC + blo(kv[k].x); s[1] = s[1] * gC + bhi(kv[k].x); s[2] = s[2] * gC + blo(kv[k].y); s[3] = s[3] * gC + bhi(kv[k].y);
                s[4] = s[4] * gC + blo(kv[k].z); s[5] = s[5] * gC + bhi(kv[k].z); s[6] = s[6] * gC + blo(kv[k].w); s[7] = s[7] * gC + bhi(kv[k].w); }
        }
    }
}
__device__ __forceinline__ void attn_phase(Frame& F, char* ldsg, const GAS bf16* QKN, const GAS bf16* PROJ, const GAS float* kmean, GAS bf16* OA, gu32* qctr, const GAS float* qg, const GAS float* kg) {
    const float gq = wave_max(fmaxf(fabsf(qg[2 * F.lane]), fabsf(qg[2 * F.lane + 1]))), gk = wave_max(fmaxf(fabsf(kg[2 * F.lane]), fabsf(kg[2 * F.lane + 1])));
    const float tv = 2.0f * 11.3138f * gq * gk + 25.0f;
    volatile int* misc = (volatile int*)(ldsg + att::OFF_MISC);
    __syncthreads();
    if (F.tid == 0) misc[3] = __float_as_int(tv);
    for (;;) {
        __syncthreads();
        if (F.tid == 0) misc[2] = (int)__hip_atomic_fetch_add(qctr, 1u, RLX_AGENT);
        __syncthreads();
        const int u = __builtin_amdgcn_readfirstlane(misc[2]);
        if (u >= BATCH * AH * NBLK) break;
        const int cur = 31 - (u >> 4), rem = u & 15, h = 7 - (rem >> 1), b = rem & 1;
        const float tnat = __int_as_float(__builtin_amdgcn_readfirstlane(misc[3]));
        const float wf = tnat * exp2f((float)(h + 1)) * (1.0f / 256.0f);
        const int wpast = wf >= 31.0f ? 31 : (int)wf + 1;
        int tl; asm volatile("v_mbcnt_lo_u32_b32 %0, -1, 0\n\tv_mbcnt_hi_u32_b32 %0, -1, %0" : "=v"(tl)); tl += F.wave * 64;
        const float smax2 = (tnat - 25.0f) * 0.5f * 1.02f * att::LOG2E;
        att::attn_unit(b, h, cur, QKN, 2048, 0, 1024, PROJ, LDP, C_VA, SEQ, kmean, OA, 3072, ldsg, tl, wpast, smax2);
    }
}
__device__ __forceinline__ int attn_wpast(float tnat, int h) { const float wf = tnat * exp2f((float)(h + 1)) * (1.0f / 256.0f); return wf >= 31.0f ? 31 : (int)wf + 1; }
__device__ __forceinline__ float attn_tnat(Frame& F, const GAS float* qg, const GAS float* kg) {
    const float gq = wave_max(fmaxf(fabsf(qg[2 * F.lane]), fabsf(qg[2 * F.lane + 1]))), gk = wave_max(fmaxf(fabsf(kg[2 * F.lane]), fabsf(kg[2 * F.lane + 1])));
    return 2.0f * 11.3138f * gq * gk + 25.0f;
}
__device__ __forceinline__ void attn_select_phase(Frame& F, const GAS bf16* QKN, const GAS float* kmean, GAS bf16* LIST, gu32* LCNT, GAS float* PL, const GAS float* qg, const GAS float* kg) {
    const float tnat = attn_tnat(F, qg, kg);
    const int gw = F.vcu * NWAVES + F.wave, NGW = F.G * NWAVES;
    for (int wu = gw; wu < BATCH * AH * (NBLK - 1) * 8; wu += NGW) {
        const int wv = wu & 7, r = wu >> 3, cur = 1 + r % (NBLK - 1), bh = r / (NBLK - 1), h = bh % AH, b = bh / AH;
        att::attn_select(b, h, cur, wv, QKN, 2048, SEQ, kmean, LIST, LCNT, PL, M, F.lane, attn_wpast(tnat, h));
    }
}
__device__ __forceinline__ void attn_gather_phase(Frame& F, char* ldsg, const GAS bf16* QKN, const GAS bf16* PROJ, const GAS bf16* LIST, gu32* LCNT, GAS bf16* P01, GAS bf16* P23, GAS float* PL, gu32* qctr, const GAS float* qg, const GAS float* kg) {
    const float tv = attn_tnat(F, qg, kg);
    volatile int* misc = (volatile int*)(ldsg + att::OFF_MISC);
    volatile int* pref = (volatile int*)(ldsg + att::OFF_PREF);
    volatile int* pcnt = (volatile int*)(ldsg + att::OFF_PREF + 516 * 4);
    __syncthreads();
    { const int c_ = (int)__hip_atomic_load(LCNT + F.tid, RLX_AGENT); pcnt[F.tid] = c_; pref[1 + F.tid] = (c_ + 255) >> 8; }
    if (F.tid == 0) misc[3] = __float_as_int(tv);
    __syncthreads();
    unsigned qn = 0u;
    if (F.tid == 0) { int s_ = 0; pref[0] = 0; for (int i = 1; i <= 512; ++i) { s_ += pref[i]; pref[i] = s_; }
        qn = __hip_atomic_fetch_add(qctr, 1u, RLX_AGENT); }
    for (;;) {
        if (F.tid == 0) { const int q = (int)qn; const int ug = pref[512];
            int li = -1, ch = 0;
            if (q < ug) { int lo_ = 0, hi_ = 512; while (hi_ - lo_ > 1) { const int mid = (lo_ + hi_) >> 1; if (pref[mid] <= q) lo_ = mid; else hi_ = mid; } li = lo_; ch = q - pref[lo_]; }
            else if (q < ug + BATCH * AH * NBLK) { li = 512 + (q - ug); }
            misc[2] = li; misc[5] = ch;
            if (li >= 0) qn = __hip_atomic_fetch_add(qctr, 1u, RLX_AGENT); }
        __syncthreads();
        const int li = __builtin_amdgcn_readfirstlane(misc[2]), ch = __builtin_amdgcn_readfirstlane(misc[5]);
        if (li < 0) break;
        const float tnat = __int_as_float(__builtin_amdgcn_readfirstlane(misc[3]));
        const float smax2 = (tnat - 25.0f) * 0.5f * 1.02f * att::LOG2E;
        int tl; asm volatile("v_mbcnt_lo_u32_b32 %0, -1, 0\n\tv_mbcnt_hi_u32_b32 %0, -1, %0" : "=v"(tl)); tl += F.wave * 64;
        if (li < 512) { const int n = li & 31, bh = li >> 5, h = bh & 7, b = bh >> 3; const int cnt = __builtin_amdgcn_readfirstlane(pcnt[li]);
            att::attn_block_unit(false, b, h, n, ch * 256, cnt, LIST, QKN, 2048, 1024, PROJ, LDP, C_VA, SEQ, P01, P23, PL, M, ldsg, tl, smax2); }
        else { const int u = li - 512, cur = u >> 4, rem = u & 15, h = rem >> 1, b = rem & 1;
            att::attn_block_unit(true, b, h, cur, 0, 256, LIST, QKN, 2048, 1024, PROJ, LDP, C_VA, SEQ, P01, P23, PL, M, ldsg, tl, smax2); }
    }
}
constexpr int SEGR = 1024;
__device__ __forceinline__ void attn_kv_phase(Frame& F, char* ldsg, const GAS bf16* QKN, const GAS bf16* PROJ, const GAS bf16* LIST, gu32* LCNT, GAS bf16* P01, GAS bf16* P23, GAS float* PL, gu32* qctr, const GAS float* qg, const GAS float* kg) {
    const float tv = attn_tnat(F, qg, kg);
    volatile int* pref = (volatile int*)(ldsg + att::KV4_END);
    volatile int* pcnt = (volatile int*)(ldsg + att::KV4_END + 516 * 4);
    volatile unsigned short* utab = (volatile unsigned short*)(ldsg + att::KV4_END + 516 * 4 + 512 * 4);
    volatile int* misc = (volatile int*)(ldsg + att::KV4_END + 516 * 4 + 512 * 4 + 4096);
    __syncthreads();
    unsigned qn = 0u;
    if (F.tid == 0) qn = __hip_atomic_fetch_add(qctr, 1u, RLX_AGENT);
    int pv_;
    { const int i = F.tid, n = i >> 4, r = i & 15, h = 7 - (r >> 1), b = r & 1, lid = (b * 8 + h) * 32 + n;
      const int c_ = n < 31 ? (int)__hip_atomic_load(LCNT + lid, RLX_AGENT) : 0; pcnt[i] = c_; const int ns = (c_ + SEGR - 1) / SEGR; pv_ = ns > 0 ? ns : 1; pref[1 + i] = pv_; }
    if (F.tid == 0) { misc[1] = __float_as_int(tv); pref[0] = 0; }
    for (int off = 1; off < 512; off <<= 1) {
        __syncthreads();
        const int add_ = F.tid >= off ? pref[1 + F.tid - off] : 0;
        __syncthreads();
        pv_ += add_; pref[1 + F.tid] = pv_;
    }
    __syncthreads();
    if (F.tid == 0) { const int s_ = pref[512]; misc[2] = s_ < 2048 ? s_ : 2048; }
    __syncthreads();
    { const int i = F.tid, u0 = pref[i], u1 = pref[i + 1]; for (int u = u0; u < u1 && u < 2048; ++u) utab[u] = (unsigned short)((i << 4) | (u - u0)); }
    __syncthreads();
    for (;;) {
        if (F.tid == 0) { const int q = (int)qn; int code = -1; if (q < misc[2]) { code = utab[q]; qn = __hip_atomic_fetch_add(qctr, 1u, RLX_AGENT); } misc[0] = code; }
        __syncthreads();
        const int code = __builtin_amdgcn_readfirstlane(misc[0]);
        if (code < 0) break;
        const int i = code >> 4, seg = code & 15, n = i >> 4, r = i & 15, h = 7 - (r >> 1), b = r & 1;
        const int cnt = __builtin_amdgcn_readfirstlane(pcnt[i]);
        const int seg0 = seg * SEGR; int segn = cnt - seg0; segn = segn > SEGR ? SEGR : (segn < 0 ? 0 : segn);
        const float tnat = __int_as_float(__builtin_amdgcn_readfirstlane(misc[1]));
        const float smax2 = (tnat - 25.0f) * 0.5f * 1.02f * att::LOG2E;
        int tl; asm volatile("v_mbcnt_lo_u32_b32 %0, -1, 0\n\tv_mbcnt_hi_u32_b32 %0, -1, %0" : "=v"(tl)); tl += F.wave * 64;
        att::attn_kv_unit(b, h, n, seg0, segn, seg == 0, LIST, QKN, 2048, 1024, PROJ, LDP, C_VA, SEQ, P01, P23, PL, M, ldsg, tl, smax2);
    }
}
__device__ __forceinline__ v4u combine_unit(float l0, float l1, float l2, float l3, const v4u w0, const v4u w1, const v4u w2, const v4u w3) {
    const float inv = 1.0f / (((l0 + l1) + l2) + l3);
    const float c0 = l0 * inv, c1 = l1 * inv, c2 = l2 * inv, c3 = l3 * inv;
#define CMB(f, c) ((l0 > 0.f ? c0 * f(w0.c) : 0.f) + (l1 > 0.f ? c1 * f(w1.c) : 0.f) + (l2 > 0.f ? c2 * f(w2.c) : 0.f) + c3 * f(w3.c))
    v4u o;
    o.x = pk2(CMB(blo, x), CMB(bhi, x)); o.y = pk2(CMB(blo, y), CMB(bhi, y)); o.z = pk2(CMB(blo, z), CMB(bhi, z)); o.w = pk2(CMB(blo, w), CMB(bhi, w));
#undef CMB
    return o;
}
__device__ __forceinline__ void attn_combine_phase(Frame& F, const GAS bf16* P01, const GAS bf16* P23, const GAS float* PL, GAS bf16* AC) {
    const int gw = F.vcu * NWAVES + F.wave, NGW = F.G * NWAVES, g4 = F.lane >> 4, l16 = F.lane & 15;
    for (int u4 = gw; u4 < M * AH / 4; u4 += 2 * NGW) {
        const bool two = u4 + NGW < M * AH / 4; const int u4b = two ? u4 + NGW : u4;
        const int ua = u4 * 4 + g4, ub = u4b * 4 + g4; const size_t ma = ua >> 3, mb = ub >> 3; const int ha = ua & 7, hb = ub & 7;
        const float la0 = PL[((size_t)0 * M + ma) * 8 + ha], la1 = PL[((size_t)1 * M + ma) * 8 + ha], la2 = PL[((size_t)2 * M + ma) * 8 + ha], la3 = PL[((size_t)3 * M + ma) * 8 + ha];
        const float lb0 = PL[((size_t)0 * M + mb) * 8 + hb], lb1 = PL[((size_t)1 * M + mb) * 8 + hb], lb2 = PL[((size_t)2 * M + mb) * 8 + hb], lb3 = PL[((size_t)3 * M + mb) * 8 + hb];
        const v4u wa0 = ((const GAS v4u*)(P01 + ((size_t)0 * M + ma) * 1024 + ha * 128))[l16], wa1 = ((const GAS v4u*)(P01 + ((size_t)1 * M + ma) * 1024 + ha * 128))[l16];
        const v4u wa2 = ((const GAS v4u*)(P23 + ((size_t)0 * M + ma) * 1024 + ha * 128))[l16], wa3 = ((const GAS v4u*)(P23 + ((size_t)1 * M + ma) * 1024 + ha * 128))[l16];
        const v4u wb0 = ((const GAS v4u*)(P01 + ((size_t)0 * M + mb) * 1024 + hb * 128))[l16], wb1 = ((const GAS v4u*)(P01 + ((size_t)1 * M + mb) * 1024 + hb * 128))[l16];
        const v4u wb2 = ((const GAS v4u*)(P23 + ((size_t)0 * M + mb) * 1024 + hb * 128))[l16], wb3 = ((const GAS v4u*)(P23 + ((size_t)1 * M + mb) * 1024 + hb * 128))[l16];
        ((GAS v4u*)(AC + ma * 3072 + ha * 128))[l16] = combine_unit(la0, la1, la2, la3, wa0, wa1, wa2, wa3);
        if (two) ((GAS v4u*)(AC + mb * 3072 + hb * 128))[l16] = combine_unit(lb0, lb1, lb2, lb3, wb0, wb1, wb2, wb3);
    }
}
__device__ __forceinline__ void groupnorm_unit(const v4u rw, const v4u gw4, GAS bf16* orow, int lane) {
    float y[8] = {blo(rw.x), bhi(rw.x), blo(rw.y), bhi(rw.y), blo(rw.z), bhi(rw.z), blo(rw.w), bhi(rw.w)};
    const float g[8] = {blo(gw4.x), bhi(gw4.x), blo(gw4.y), bhi(gw4.y), blo(gw4.z), bhi(gw4.z), blo(gw4.w), bhi(gw4.w)};
    const float mean = wave_sum(((y[0] + y[1]) + (y[2] + y[3])) + ((y[4] + y[5]) + (y[6] + y[7]))) * (1.f / RDV);
    float q = 0.f;
#pragma unroll
    for (int k = 0; k < 8; ++k) { y[k] -= mean; q += y[k] * y[k]; }
    const float rstd = 1.0f / sqrtf(wave_sum(q) * (1.f / RDV) + EPS);
    v4u o; o.x = pk2(y[0] * rstd * pg8::siluf_(g[0]), y[1] * rstd * pg8::siluf_(g[1])); o.y = pk2(y[2] * rstd * pg8::siluf_(g[2]), y[3] * rstd * pg8::siluf_(g[3]));
    o.z = pk2(y[4] * rstd * pg8::siluf_(g[4]), y[5] * rstd * pg8::siluf_(g[5])); o.w = pk2(y[6] * rstd * pg8::siluf_(g[6]), y[7] * rstd * pg8::siluf_(g[7]));
    ((GAS v4u*)orow)[lane] = o;
}
__device__ __forceinline__ void groupnorm_phase(Frame& F, const GAS bf16* RET, const GAS bf16* PROJ, GAS bf16* ORR) {
    const int gw = F.vcu * NWAVES + F.wave, NGW = F.G * NWAVES;
    for (int u0 = gw; u0 < M * RH; u0 += 4 * NGW) {
        v4u rw[4], gg[4]; int uu[4];
#pragma unroll
        for (int j = 0; j < 4; ++j) { const int u = u0 + j * NGW; uu[j] = u < M * RH ? u : u0; const size_t m = uu[j] >> 2; const int h = uu[j] & 3;
            rw[j] = ((const GAS v4u*)(RET + m * 2048 + h * RDV))[F.lane]; gg[j] = ((const GAS v4u*)(PROJ + m * LDP + C_GR + h * RDV))[F.lane]; }
#pragma unroll
        for (int j = 0; j < 4; ++j) { const size_t m = uu[j] >> 2; const int h = uu[j] & 3;
            if (j == 0 || u0 + j * NGW < M * RH) groupnorm_unit(rw[j], gg[j], ORR + m * 3072 + 1024 + h * RDV, F.lane); }
    }
}

__device__ __forceinline__ void groupnorm_own_chunks(Frame& F, const GAS bf16* RET, const GAS bf16* PROJ, GAS bf16* ORR) {
    for (int c = (int)blockIdx.x; c < BATCH * RH * (SEQ / 256); c += F.G) {
        const int b = c >> 7, h = (c >> 5) & 3, n = c & 31;
        for (int k0 = 0; k0 < 256 / NWAVES; k0 += 4) {
            v4u rw[4], gg[4];
#pragma unroll
            for (int j = 0; j < 4; ++j) { const size_t m = (size_t)b * SEQ + n * 256 + F.wave + NWAVES * (k0 + j);
                rw[j] = ((const GAS v4u*)(RET + m * 2048 + h * RDV))[F.lane]; gg[j] = ((const GAS v4u*)(PROJ + m * LDP + C_GR + h * RDV))[F.lane]; }
#pragma unroll
            for (int j = 0; j < 4; ++j) { const size_t m = (size_t)b * SEQ + n * 256 + F.wave + NWAVES * (k0 + j); groupnorm_unit(rw[j], gg[j], ORR + m * 3072 + 1024 + h * RDV, F.lane); }
        }
    }
}

struct Args { const float* in[11]; float* out; unsigned char* ws; int ph_lo, ph_hi; };
__global__ void __launch_bounds__(NWAVES * 64, 2) hybrid_fwd(Args args) {
    extern __shared__ __attribute__((aligned(16))) unsigned char lds[];
    Frame F;
    F.lds = (LAS unsigned char*)lds;
    F.MISC = (volatile LAS unsigned*)(F.lds + MISC_OFF);
    F.tid = threadIdx.x; F.lane = F.tid & 63; F.wave = __builtin_amdgcn_readfirstlane(F.tid >> 6);
    F.G = gridDim.x; { const int bx = blockIdx.x; F.vcu = (F.G % 8 == 0) ? (bx % 8) * (F.G / 8) + bx / 8 : bx; }
    unsigned char* ws = args.ws;
    F.ctl = (gu32*)(ws + WS_CTL);
    for (int u = F.tid; u < (LDS_BYTES - LDSCTL_OFF) / 4; u += NWAVES * 64) ((LAS unsigned*)(F.lds + LDSCTL_OFF))[u] = 0u;
    __syncthreads();
    XcdBarrier bar; bar.bar = (unsigned*)(F.ctl + CW_BAR); bar.x = 0; bar.st = nullptr;
    if (MK_ONE_LAUNCH) bar = xcd_barrier_post((unsigned*)(F.ctl + CW_BAR), F.MISC + 8);
    const int lo = args.ph_lo, hi = args.ph_hi;
#define IN(k) (lo <= (k) && (k) < hi)
#define SEAM(k) do { if (MK_ONE_LAUNCH && IN((k) + 1)) { XcdBarrier b2_ = bar; b2_.bar = (unsigned*)(WSP() + WS_CTL) + CW_BAR; { unsigned x_ = bar.x; asm volatile("" : "+s"(x_)); b2_.x = x_; } xcd_barrier(b2_); } } while (0)
#define WSP() ({ unsigned char* p_ = args.ws; asm volatile("" : "+s"(p_)); (unsigned char*)(GAS unsigned char*)p_; })
#define PTRS() { int ln_; asm volatile("v_mbcnt_lo_u32_b32 %0, -1, 0\n\tv_mbcnt_hi_u32_b32 %0, -1, %0" : "=v"(ln_)); F.lane = ln_; F.tid = F.wave * 64 + ln_; }     \
    unsigned char* const w_ = WSP(); \
    GAS float* const kmean = (GAS float*)(w_ + WS_KMEAN); \
    unsigned char* const wset_ = w_ + ((l & 1) ? WS_W1 : WS_W0); \
    GAS bf16*const Wnat_t = (GAS bf16*)(wset_ + WS_WNAT), *const Wswp_t = (GAS bf16*)(wset_ + WS_WSWP), *const Wcat_t = (GAS bf16*)(wset_ + WS_WOA), *const Wout_t = (GAS bf16*)(wset_ + WS_WOUT), *const Wfi_t = (GAS bf16*)(wset_ + WS_WFI), *const Wfo_t = (GAS bf16*)(wset_ + WS_WFO); \
    GAS bf16*const H = (GAS bf16*)(w_ + WS_H), *const PROJ = (GAS bf16*)(w_ + WS_PROJ), *const ACT = (GAS bf16*)(w_ + WS_PROJ), *const AC = (GAS bf16*)(w_ + WS_OA), *const MRG = (GAS bf16*)(w_ + WS_MRG); \
    GAS bf16*const RET = (GAS bf16*)(w_ + WS_RET), *const ST = (GAS bf16*)(w_ + WS_ST); \
    GAS bf16*const LIST = (GAS bf16*)(w_ + WS_LIST), *const P01 = (GAS bf16*)(w_ + WS_P01), *const P23 = (GAS bf16*)(w_ + WS_P23); GAS float*const PL = (GAS float*)(w_ + WS_PL); (void)LIST; (void)P01; (void)P23; (void)PL; \
    GAS float*const PS = (GAS float*)(w_ + WS_PS); GAS float*const RS = (GAS float*)(w_ + WS_RS); (void)PS; (void)RS; \
    GAS bf16*const QKN = (GAS bf16*)(w_ + WS_QKN); (void)QKN; GAS bf16*const XR = (GAS bf16*)(w_ + WS_RET + 64 * MiB); (void)XR;     \
    GAS bf16*const AQ = (GAS bf16*)(w_ + WS_AQ), *const BQ = (GAS bf16*)(w_ + WS_BQ), *const KB = (GAS bf16*)(w_ + WS_KB), *const KTB = (GAS bf16*)(w_ + WS_KTB); \
    (void)kmean; (void)Wnat_t; (void)Wswp_t; (void)Wcat_t; (void)Wout_t; (void)Wfi_t; (void)Wfo_t; (void)H; (void)PROJ; (void)ACT; (void)AC; (void)MRG; (void)RET; (void)ST; (void)AQ; (void)BQ; (void)KB; (void)KTB
    const bool own_panel = MK_ONE_LAUNCH && F.G == 256;
    const int team_panel = 8 * ((int)blockIdx.x & 7) + (((int)blockIdx.x >> 3) & 7);
    for (int l = 0; l < DEPTH; ++l) {
        const int pb = l * NPH;
        const GAS float* x_in = (const GAS float*)args.in[0]; GAS float* xres = (GAS float*)args.out;
        const GAS float* xcur = (l == 0) ? x_in : (const GAS float*)xres;
        if (IN(pb + 0) && l == 0) { PTRS();
            const int gw = F.vcu * NWAVES + F.wave, NGW = F.G * NWAVES;
            for (int it = gw; it < NCONV; it += NGW) convert_item(F, args.in, 0, wset_, it);
            __syncthreads();
        }
        if (IN(pb + 1)) { PTRS(); if (l == 0) { cast_rstd_phase(F, x_in, H, RS); SEAM(pb + 1); } else if (!own_panel) { rstd_phase(F, PS, RS); SEAM(pb + 1); } }
        if (IN(pb + 2)) { PTRS();
            const bool pre_ = own_panel && l > 0; if (pre_) rs_prefill_lds(F, PS, team_panel);
            { pg8::ProjDesc D{l == 0 ? (const GAS bf16*)H : (const GAS bf16*)XR, Wnat_t, Wswp_t, DM, DM, DM, {}, {}, 0}; D.On.init(M, NNAT, F.G, (int)blockIdx.x); D.Os.init(NSWP, M, F.G, (int)blockIdx.x, true); D.nnat = (D.On.nwg - (int)blockIdx.x + F.G - 1) / F.G;
              pg8::EpiProjBoth E{{PROJ, LDP, AQ, KB, pre_ ? (const GAS float*)nullptr : (const GAS float*)RS, QKN, (const GAS float*)args.in[5] + (size_t)l * AD, (const GAS float*)args.in[6] + (size_t)l * AD, kmean,
                                   (LAS float*)(F.lds + RING_OFF + pg8::STAGE_BYTES + 2048), EPS}, {KTB, BQ, RS}};
              pg8::gemm_phase<pg8::EpiProjBoth, pg8::ProjDesc, PG8_ALIGN, PG8_SP2>(F.lds + RING_OFF, D, E, F.tid); }
            SEAM(pb + 2);
        }
        if (IN(pb + 3)) { PTRS();
            const bool ownc_ = MK_ONE_LAUNCH && F.G == 256;
            ktrans_phase(F, KB, KTB, ownc_);
            VM_WAIT(); __syncthreads();
            if (MK_ONE_LAUNCH && !ownc_) { XcdBarrier b2_ = bar; b2_.bar = (unsigned*)(WSP() + WS_CTL) + CW_BAR; { unsigned x_ = bar.x; asm volatile("" : "+s"(x_)); b2_.x = x_; } xcd_barrier(b2_); }
            attn_select_phase(F, QKN, kmean, LIST, F.ctl + CW_LCNT + 512 * l, PL, (const GAS float*)args.in[5] + (size_t)l * AD, (const GAS float*)args.in[6] + (size_t)l * AD);
            __syncthreads();
            { const int c_ = (int)blockIdx.x; pg8::RetDesc D{AQ + 256, KB, BQ, KTB, 256, 512, 256, F.G, c_, c_ < 256 ? (256 - c_ + F.G - 1) / F.G : 0, ownc_ ? 1 : 0};
              pg8::EpiRetBoth E{{AQ}, {ST}};
              pg8::gemm_phase<pg8::EpiRetBoth, pg8::RetDesc, PG8_ALIGN, PG8_SP2>(F.lds + RING_OFF, D, E, F.tid); }
            SEAM(pb + 3);
        }
        if (IN(pb + 4)) { PTRS();
            attn_kv_phase(F, (char*)lds, QKN, PROJ, LIST, F.ctl + CW_LCNT + 512 * l, P01, P23, PL, F.ctl + CW_ATTQ + 64 * l, (const GAS float*)args.in[5] + (size_t)l * AD, (const GAS float*)args.in[6] + (size_t)l * AD);
            { int ln_; asm volatile("v_mbcnt_lo_u32_b32 %0, -1, 0\n\tv_mbcnt_hi_u32_b32 %0, -1, %0" : "=v"(ln_)); F.lane = ln_; F.tid = F.wave * 64 + ln_; }
            for (;;) {
                __syncthreads();
                if (F.tid == 0) F.MISC[16] = __hip_atomic_fetch_add(F.ctl + CW_SCQ + 64 * l, 1u, RLX_AGENT);
                __syncthreads();
                const int it = (int)__builtin_amdgcn_readfirstlane(F.MISC[16]);
                if (it >= BATCH * RH * RDV * 32 / 512) break;
                scan_item(F, ST, BQ, it);
            }
            if (l + 1 < DEPTH) {
                unsigned char* const wnext = w_ + (((l + 1) & 1) ? WS_W1 : WS_W0);
                unsigned qn_ = 0u;
                __syncthreads();
                if (F.tid == 0) qn_ = __hip_atomic_fetch_add(F.ctl + CW_CVQ + 64 * l, 1u, RLX_AGENT);
                for (int rnd = 0;; ++rnd) {
                    if (F.tid == 0) F.MISC[16 + (rnd & 1)] = qn_;
                    __syncthreads();
                    const int tk = (int)__builtin_amdgcn_readfirstlane(F.MISC[16 + (rnd & 1)]);
                    if (tk * 8 >= NCONV) break;
                    if (F.tid == 0) qn_ = __hip_atomic_fetch_add(F.ctl + CW_CVQ + 64 * l, 1u, RLX_AGENT);
                    convert_item(F, args.in, l + 1, wnext, tk * 8 + F.wave);
                }
            }
            SEAM(pb + 4);
        }
        if (IN(pb + 5)) { PTRS();
            pg8::BatchDesc D{AQ, BQ, 512, 512, 512, 131072, 262144, 0, 131072, 512, 2, F.G, (int)blockIdx.x, 1};
            pg8::EpiO E{RET, SEQ};
            pg8::gemm_phase<pg8::EpiO, pg8::BatchDesc, PG8_ALIGN, PG8_SP2>(F.lds + RING_OFF, D, E, F.tid);
            VM_WAIT(); __syncthreads();
            groupnorm_own_chunks(F, RET, PROJ, AC);
            attn_combine_phase(F, P01, P23, PL, AC);
            SEAM(pb + 5);
        }
        if (IN(pb + 7)) { PTRS();
            pg8::PlainDesc D{AC, Wcat_t, 3072, 3072, 3072, {}}; D.O.init(M, DM, F.G, (int)blockIdx.x);
            pg8::EpiMergeCat E{PROJ + C_GA, PROJ + C_GT, LDP, MRG, DM};
            pg8::gemm_phase<pg8::EpiMergeCat, pg8::PlainDesc, PG8_ALIGN, PG8_SP2>(F.lds + RING_OFF, D, E, F.tid);
            SEAM(pb + 7);
        }
        if (IN(pb + 8)) { PTRS();
            pg8::PlainDesc D{MRG, Wout_t, DM, DM, DM, {}}; D.O.init(M, DM, F.G, (int)blockIdx.x);
            pg8::EpiRes E{l == 0 ? (const GAS void*)x_in : (const GAS void*)XR, (GAS void*)XR, DM, l == 0, false, PS};
            pg8::gemm_phase<pg8::EpiRes, pg8::PlainDesc, PG8_ALIGN, PG8_SP2>(F.lds + RING_OFF, D, E, F.tid);
            SEAM(pb + 8);
        }
        if (IN(pb + 9) && !own_panel) { PTRS(); rstd_phase(F, PS, RS); SEAM(pb + 9); }
        if (IN(pb + 10)) { PTRS(); if (own_panel) rs_prefill_lds(F, PS, team_panel);
            pg8::PlainDesc D{XR, Wfi_t, DM, DM, DM, {}}; D.O.init(M, 2 * DFF, F.G, (int)blockIdx.x);
            pg8::EpiSwiGLU E{ACT, DFF, own_panel ? (const GAS float*)nullptr : (const GAS float*)RS};
            pg8::gemm_phase<pg8::EpiSwiGLU, pg8::PlainDesc, PG8_ALIGN, PG8_SP2>(F.lds + RING_OFF, D, E, F.tid);
            SEAM(pb + 10);
        }
        if (IN(pb + 11)) { PTRS();
            pg8::PlainDesc D{ACT, Wfo_t, DFF, DFF, DFF, {}}; D.O.init(M, DM, F.G, (int)blockIdx.x);
            pg8::EpiRes E{(const GAS void*)XR, l == DEPTH - 1 ? (GAS void*)xres : (GAS void*)XR, DM, false, l == DEPTH - 1, l == DEPTH - 1 ? (GAS float*)nullptr : PS};
            pg8::gemm_phase<pg8::EpiRes, pg8::PlainDesc, PG8_ALIGN, PG8_SP2>(F.lds + RING_OFF, D, E, F.tid);
            SEAM(pb + 11);
        }
    }
#undef IN
#undef PTRS
#undef WSP
#undef SEAM
}

extern "C" void kernel_launch(void* const* d_in, const int* in_sizes, int n_in, void* d_out, int out_size, void* d_ws, size_t ws_size, hipStream_t stream) {
    static int grid = 0;
    if (grid == 0) {
        if (n_in != 11 || in_sizes[0] != M * DM || out_size != M * DM || ws_size < WS_END) { fprintf(stderr, "kernel_launch: shape/workspace mismatch: n_in %d in0 %d out %d ws %zu (need %zu)\n", n_in, n_in > 0 ? in_sizes[0] : -1, out_size, ws_size, (size_t)WS_END); grid = -1; return; }
        int dev = 0, cus = 0, per_cu = 0;
        if (hipGetDevice(&dev) != hipSuccess || hipDeviceGetAttribute(&cus, hipDeviceAttributeMultiprocessorCount, dev) != hipSuccess) { grid = -1; return; }
        if (hipFuncSetAttribute((const void*)hybrid_fwd, hipFuncAttributeMaxDynamicSharedMemorySize, LDS_BYTES) != hipSuccess) { fprintf(stderr, "kernel_launch: hipFuncSetAttribute failed\n"); grid = -1; return; }
        if (hipOccupancyMaxActiveBlocksPerMultiprocessor(&per_cu, (const void*)hybrid_fwd, NWAVES * 64, LDS_BYTES) != hipSuccess || per_cu < 1)
            fprintf(stderr, "kernel_launch: note: occupancy query reports %d workgroups per CU\n", per_cu);
        (void)hipGetLastError();
        grid = cus;
    }
    if (grid < 0) return;
    if (hipMemsetAsync((char*)d_ws + WS_CTL, 0, CTL_ZERO_BYTES, stream) != hipSuccess) return;
    Args a{};
    for (int i = 0; i < 11; ++i) a.in[i] = (const float*)d_in[i];
    a.out = (float*)d_out; a.ws = (unsigned char*)d_ws;
#if MK_ONE_LAUNCH
    a.ph_lo = 0; a.ph_hi = NPHASES;
    hipLaunchKernelGGL(hybrid_fwd, dim3(grid), dim3(NWAVES * 64), LDS_BYTES, stream, a);
#else
    for (int p = 0; p < NPHASES; ++p) { a.ph_lo = p; a.ph_hi = p + 1; hipLaunchKernelGGL(hybrid_fwd, dim3(grid), dim3(NWAVES * 64), LDS_BYTES, stream, a); }
#endif
    const hipError_t le = hipPeekAtLastError();
    if (le != hipSuccess) fprintf(stderr, "kernel_launch: launch failed: %s\n", hipGetErrorName(le));
}
```
